# Optimizing an MI355X kernel written in HIP

```python
import math
import jax
import jax.numpy as jnp
from jax import lax
import numpy as np

D_MODEL = 1024
BATCH = 4
SEQ = 4096
DEPTH = 2

CTX_LEN = 256
GRID_W = 64
EPS = 1e-6
CHUNK = 16
F32 = jnp.float32

HG_HEADS = 4
HG_DK = 128
HG_DV = 128
HG_KW = HG_HEADS * HG_DK
HG_VW = HG_HEADS * HG_DV
GLA_HEADS = 4
GLA_DK = 64
GLA_DV = 128
GLA_KW = GLA_HEADS * GLA_DK
GLA_VW = GLA_HEADS * GLA_DV
GLA_RANK = 16
GLA_GATE_NORM = 16.0
S5_GROUP = 16
S5_GROUPS = 32
S5_WIDTH = S5_GROUP * S5_GROUPS
S5_STATE = 64
N_BRANCH = 3
BRANCH_W = 512
FFN_DIM = 3584
N_EXPERTS = 8
TOP_K = 2
N_DENSE = (DEPTH + 1) // 2
N_MOE = DEPTH // 2

IN_SPLITS = (HG_KW, HG_KW, HG_KW, HG_VW, HG_VW,
             GLA_KW, GLA_KW, GLA_VW, GLA_RANK, GLA_RANK, GLA_VW,
             S5_WIDTH, D_MODEL, D_MODEL, D_MODEL)
N_IN = 3 * HG_KW + 2 * HG_VW + 2 * GLA_KW + 2 * GLA_VW + 2 * GLA_RANK + S5_WIDTH + N_BRANCH * D_MODEL

kernel_name = 'hybrid_hgrn2_gla_s5_moe_dit'


def _rmsnorm(x, g):
    xf = x.astype(F32)
    y = xf * lax.rsqrt(jnp.mean(xf * xf, axis=-1, keepdims=True) + EPS)
    return (y * g.astype(F32)).astype(x.dtype)


def _modulate(xn, shift, scale):
    return xn * (1 + scale[:, None, :]) + shift[:, None, :]


def _grid_pos_embed(rows, dim, dtype):
    rr, cc = jnp.meshgrid(jnp.arange(rows, dtype=F32), jnp.arange(GRID_W, dtype=F32), indexing='ij')
    quarter = dim // 4
    omega = 1.0 / (10000.0 ** (jnp.arange(quarter, dtype=F32) / quarter))

    def emb(p):
        ang = p.reshape(-1)[:, None] * omega[None, :]
        return jnp.concatenate([jnp.sin(ang), jnp.cos(ang)], axis=-1)

    return jnp.concatenate([emb(rr), emb(cc)], axis=-1).astype(dtype)


def _split_cols(p):
    out = []
    start = 0
    for width in IN_SPLITS:
        out.append(p[..., start:start + width])
        start += width
    return out


def _heads(a, n_heads):
    bsz, t, w = a.shape
    return a.astype(F32).reshape(bsz, t, n_heads, w // n_heads).transpose(0, 2, 1, 3)


def _head_norm_gate(o, gain, gate):
    o = jnp.swapaxes(o, 1, 2)
    bsz, t, h, dv = o.shape
    o = o * lax.rsqrt(jnp.mean(o * o, axis=-1, keepdims=True) + EPS) * gain.astype(F32).reshape(h, dv)
    return o.reshape(bsz, t, h * dv) * jax.nn.silu(gate.astype(F32))


def _chunk_gated_linear(q, k, v, log_g, s0):
    bsz, h, l, dk = q.shape
    dv = v.shape[-1]
    n = l // CHUNK

    def chunks(a):
        return jnp.moveaxis(a.reshape(bsz, h, n, CHUNK, a.shape[-1]), 2, 0)

    lower = jnp.tril(jnp.ones((CHUNK, CHUNK), dtype=bool))[:, :, None]

    def step(s, inp):
        qc, kc, vc, gc = inp
        bc = jnp.cumsum(gc, axis=2)
        last = bc[:, :, -1:, :]
        rel = bc[:, :, :, None, :] - bc[:, :, None, :, :]
        decay = jnp.exp(jnp.where(lower, rel, -jnp.inf))
        scores = jnp.einsum('bhtd,bhsd,bhtsd->bhts', qc, kc, decay)
        o = (jnp.einsum('bhts,bhsv->bhtv', scores, vc)
             + jnp.einsum('bhtd,bhdv->bhtv', qc * jnp.exp(bc), s))
        s_new = (jnp.exp(last[:, :, 0, :])[..., None] * s
                 + jnp.einsum('bhsd,bhsv->bhdv', kc * jnp.exp(last - bc), vc))
        return s_new, o

    s_fin, o = lax.scan(step, s0, (chunks(q), chunks(k), chunks(v), chunks(log_g)))
    return jnp.moveaxis(o, 0, 2).reshape(bsz, h, l, dv), s_fin


def _bidir_prefix(q, k_f, k_b, v, g_f, g_b, n_ctx):
    bsz, h, _, dk = q.shape
    dv = v.shape[-1]
    zero = jnp.zeros((bsz, h, dk, dv), F32)

    def cx(a):
        return a[:, :, :n_ctx]

    def lt(a):
        return a[:, :, n_ctx:]

    def fl(a):
        return jnp.flip(a, axis=2)

    oc_f, sc_f = _chunk_gated_linear(cx(q), cx(k_f), cx(v), cx(g_f), zero)
    oc_b, sc_b = _chunk_gated_linear(fl(cx(q)), fl(cx(k_b)), fl(cx(v)), fl(cx(g_b)), zero)
    ol_f, _ = _chunk_gated_linear(lt(q), lt(k_f), lt(v), lt(g_f), sc_f)
    ol_b, _ = _chunk_gated_linear(fl(lt(q)), fl(lt(k_b)), fl(lt(v)), fl(lt(g_b)), sc_b)
    return jnp.concatenate([oc_f + fl(oc_b), ol_f + fl(ol_b)], axis=2)


def _hgrn2_branch(pq, pff, pfb, pi, pg, lb, norm_g, n_ctx):
    lb = lb.astype(F32)
    log_lb = jnp.log(lb)
    log_ub = jnp.log1p(-lb)

    def forget(z):
        z = z.astype(F32)
        log_f = jnp.logaddexp(log_lb, log_ub + jax.nn.log_sigmoid(z))
        one_minus_f = (1.0 - lb) * jax.nn.sigmoid(-z)
        return _heads(log_f, HG_HEADS), _heads(one_minus_f, HG_HEADS)

    g_f, k_f = forget(pff)
    g_b, k_b = forget(pfb)
    o = _bidir_prefix(_heads(pq, HG_HEADS), k_f, k_b, _heads(pi, HG_HEADS), g_f, g_b, n_ctx)
    return _head_norm_gate(o, norm_g, pg)


def _gla_branch(pq, pk, pv, pdf, pdb, pr, gate_up, gate_b, norm_g, n_ctx):
    up = gate_up.astype(F32)
    ub = gate_b.astype(F32)
    g_f = jax.nn.log_sigmoid(pdf.astype(F32) @ up[0] + ub[0]) / GLA_GATE_NORM
    g_b = jax.nn.log_sigmoid(pdb.astype(F32) @ up[1] + ub[1]) / GLA_GATE_NORM
    q = _heads(pq, GLA_HEADS) * (GLA_DK ** -0.5)
    k = _heads(pk, GLA_HEADS)
    o = _bidir_prefix(q, k, k, _heads(pv, GLA_HEADS), _heads(g_f, GLA_HEADS), _heads(g_b, GLA_HEADS), n_ctx)
    return _head_norm_gate(o, norm_g, pr)


def _complex_affine_combine(e1, e2):
    a1r, a1i, b1r, b1i = e1
    a2r, a2i, b2r, b2i = e2
    return (a2r * a1r - a2i * a1i,
            a2r * a1i + a2i * a1r,
            a2r * b1r - a2i * b1i + b2r,
            a2r * b1i + a2i * b1r + b2i)


def _s5_scan(abar_re, abar_im, bu_re, bu_im, s0_re, s0_im, reverse):
    if reverse:
        bu_re = jnp.flip(bu_re, axis=1)
        bu_im = jnp.flip(bu_im, axis=1)
    bu_re = bu_re.at[:, 0].add(abar_re * s0_re - abar_im * s0_im)
    bu_im = bu_im.at[:, 0].add(abar_re * s0_im + abar_im * s0_re)
    a_re = jnp.broadcast_to(abar_re, bu_re.shape)
    a_im = jnp.broadcast_to(abar_im, bu_im.shape)
    _, _, s_re, s_im = lax.associative_scan(_complex_affine_combine, (a_re, a_im, bu_re, bu_im), axis=1)
    fin_re, fin_im = s_re[:, -1], s_im[:, -1]
    if reverse:
        s_re = jnp.flip(s_re, axis=1)
        s_im = jnp.flip(s_im, axis=1)
    return s_re, s_im, fin_re, fin_im


def _s5_branch(u, n_ctx, a_re, a_im, log_step, b_re, b_im, c_re, c_im, d_skip, glu_w):
    uf = u.astype(F32)
    bsz, t, _ = uf.shape
    ug = uf.reshape(bsz, t, S5_GROUPS, S5_GROUP)
    y = uf * d_skip.astype(F32)
    zero = jnp.zeros((bsz, S5_GROUPS, S5_STATE), F32)
    for direction in range(2):
        lam_re = a_re[direction].astype(F32)
        lam_im = a_im[direction].astype(F32)
        step = jnp.exp(log_step[direction].astype(F32))[:, None]
        mag = jnp.exp(lam_re * step)
        abar_re = mag * jnp.cos(lam_im * step)
        abar_im = mag * jnp.sin(lam_im * step)
        den = lam_re * lam_re + lam_im * lam_im
        z_re = ((abar_re - 1.0) * lam_re + abar_im * lam_im) / den
        z_im = (abar_im * lam_re - (abar_re - 1.0) * lam_im) / den
        br = b_re[direction].astype(F32)
        bi = b_im[direction].astype(F32)
        bbar_re = z_re[..., None] * br - z_im[..., None] * bi
        bbar_im = z_re[..., None] * bi + z_im[..., None] * br
        bu_re = jnp.einsum('btgp,gnp->btgn', ug, bbar_re)
        bu_im = jnp.einsum('btgp,gnp->btgn', ug, bbar_im)
        rev = direction == 1
        sc_re, sc_im, f_re, f_im = _s5_scan(abar_re, abar_im, bu_re[:, :n_ctx], bu_im[:, :n_ctx], zero, zero, rev)
        sl_re, sl_im, _, _ = _s5_scan(abar_re, abar_im, bu_re[:, n_ctx:], bu_im[:, n_ctx:], f_re, f_im, rev)
        s_re = jnp.concatenate([sc_re, sl_re], axis=1)
        s_im = jnp.concatenate([sc_im, sl_im], axis=1)
        cr = c_re[direction].astype(F32)
        ci = c_im[direction].astype(F32)
        y = y + (jnp.einsum('btgn,gpn->btgp', s_re, cr)
                 - jnp.einsum('btgn,gpn->btgp', s_im, ci)).reshape(bsz, t, S5_WIDTH)
    y = jax.nn.gelu(y)
    return y * jax.nn.sigmoid(y @ glu_w.astype(F32))


def _mixer(h, n_ctx, w_in, lb, hg_norm_g, gla_gate_up, gla_gate_b, gla_norm_g, s5_a_re, s5_a_im,
           s5_log_step, s5_b_re, s5_b_im, s5_c_re, s5_c_im, s5_d, s5_glu_w, branch_proj, w_out):
    (hg_q, hg_ff, hg_fb, hg_i, hg_g, gl_q, gl_k, gl_v, gl_df, gl_db, gl_r, s5_u,
     gate_a, gate_b, gate_c) = _split_cols(h @ w_in)
    y_a = _hgrn2_branch(hg_q, hg_ff, hg_fb, hg_i, hg_g, lb, hg_norm_g, n_ctx)
    y_b = _gla_branch(gl_q, gl_k, gl_v, gl_df, gl_db, gl_r, gla_gate_up, gla_gate_b, gla_norm_g, n_ctx)
    y_c = _s5_branch(s5_u, n_ctx, s5_a_re, s5_a_im, s5_log_step, s5_b_re, s5_b_im, s5_c_re, s5_c_im,
                     s5_d, s5_glu_w)
    merged = jnp.zeros(h.shape, F32)
    for idx, (y_k, gate_k) in enumerate(((y_a, gate_a), (y_b, gate_b), (y_c, gate_c))):
        merged = merged + jax.nn.sigmoid(gate_k.astype(F32)) * (y_k.astype(h.dtype) @ branch_proj[idx]).astype(F32)
    return merged.astype(h.dtype) @ w_out


def _swiglu(h, w1, w3, w2):
    return (jax.nn.silu(h @ w1) * (h @ w3)) @ w2


def _moe(h, router_w, w1, w3, w2):
    probs = jax.nn.softmax((h @ router_w).astype(F32), axis=-1)
    top_p, top_i = lax.top_k(probs, TOP_K)
    top_p = top_p / jnp.sum(top_p, axis=-1, keepdims=True)
    combine = jnp.sum(jax.nn.one_hot(top_i, N_EXPERTS, dtype=F32) * top_p[..., None], axis=-2)
    out = jnp.zeros(h.shape, F32)
    for e in range(N_EXPERTS):
        out = out + combine[..., e:e + 1] * _swiglu(h, w1[e], w3[e], w2[e]).astype(F32)
    return out.astype(h.dtype)


def setup_inputs(seed: int = 0) -> dict:
    key = jax.random.key(seed)
    keys = iter(jax.random.split(key, 48))

    def nrm(shape, scale):
        return scale * jax.random.normal(next(keys), shape, F32)

    def gain(shape):
        return 1.0 + nrm(shape, 0.01)

    d = D_MODEL
    state_idx = jnp.arange(S5_STATE, dtype=F32)
    s5_shape = (DEPTH, 2, S5_GROUPS, S5_STATE)
    return {
        'x': nrm((BATCH, SEQ, d), 1.0),
        'c': nrm((BATCH, d), 1.0),
        'ctx': nrm((BATCH, CTX_LEN, d), 1.0),
        'c_ctx': nrm((d,), 1.0),
        'norm1_g': gain((DEPTH, d)),
        'norm2_g': gain((DEPTH, d)),
        'ada_w': nrm((DEPTH, d, 6 * d), 0.5 * d ** -0.5),
        'ada_b': nrm((DEPTH, 6 * d), 0.01),
        'w_in': nrm((DEPTH, d, N_IN), d ** -0.5),
        'hg_lb_logits': nrm((DEPTH, HG_KW), 0.1),
        'hg_norm_g': gain((DEPTH, HG_VW)),
        'gla_gate_up': nrm((DEPTH, 2, GLA_RANK, GLA_KW), GLA_RANK ** -0.5),
        'gla_gate_b': nrm((DEPTH, 2, GLA_KW), 0.01),
        'gla_norm_g': gain((DEPTH, GLA_VW)),
        's5_a_re': -0.5 + nrm(s5_shape, 0.01),
        's5_a_im': math.pi * state_idx + nrm(s5_shape, 0.01),
        's5_log_step': jax.random.uniform(next(keys), (DEPTH, 2, S5_GROUPS), F32, math.log(1e-3), math.log(1e-1)),
        's5_b_re': nrm((DEPTH, 2, S5_GROUPS, S5_STATE, S5_GROUP), (2 * S5_GROUP) ** -0.5),
        's5_b_im': nrm((DEPTH, 2, S5_GROUPS, S5_STATE, S5_GROUP), (2 * S5_GROUP) ** -0.5),
        's5_c_re': nrm((DEPTH, 2, S5_GROUPS, S5_GROUP, S5_STATE), S5_STATE ** -0.5),
        's5_c_im': nrm((DEPTH, 2, S5_GROUPS, S5_GROUP, S5_STATE), S5_STATE ** -0.5),
        's5_d': nrm((DEPTH, S5_WIDTH), 1.0),
        's5_glu_w': nrm((DEPTH, S5_WIDTH, S5_WIDTH), S5_WIDTH ** -0.5),
        'branch_proj': nrm((DEPTH, N_BRANCH, BRANCH_W, d), BRANCH_W ** -0.5),
        'w_out': nrm((DEPTH, d, d), d ** -0.5),
        'ffn_w1': nrm((N_DENSE, d, FFN_DIM), d ** -0.5),
        'ffn_w3': nrm((N_DENSE, d, FFN_DIM), d ** -0.5),
        'ffn_w2': nrm((N_DENSE, FFN_DIM, d), FFN_DIM ** -0.5),
        'router_w': nrm((N_MOE, d, N_EXPERTS), d ** -0.5),
        'moe_w1': nrm((N_MOE, N_EXPERTS, d, FFN_DIM), d ** -0.5),
        'moe_w3': nrm((N_MOE, N_EXPERTS, d, FFN_DIM), d ** -0.5),
        'moe_w2': nrm((N_MOE, N_EXPERTS, FFN_DIM, d), FFN_DIM ** -0.5),
        'final_norm_g': gain((d,)),
    }


def reference(x, c, ctx, c_ctx, norm1_g, norm2_g, ada_w, ada_b, w_in, hg_lb_logits, hg_norm_g,
              gla_gate_up, gla_gate_b, gla_norm_g, s5_a_re, s5_a_im, s5_log_step, s5_b_re, s5_b_im,
              s5_c_re, s5_c_im, s5_d, s5_glu_w, branch_proj, w_out, ffn_w1, ffn_w3, ffn_w2,
              router_w, moe_w1, moe_w3, moe_w2, final_norm_g):
    n_tok = x.shape[1]
    n_ctx = ctx.shape[1]
    rows = n_tok // GRID_W
    x = x + _grid_pos_embed(rows, D_MODEL, x.dtype)[None]
    lb_cum = jnp.cumsum(jax.nn.softmax(hg_lb_logits.astype(F32), axis=0), axis=0)
    lower_bounds = lb_cum - lb_cum[0:1]
    cond = jax.nn.silu(c)
    cond_ctx = jax.nn.silu(c_ctx)[None]
    for layer in range(DEPTH):
        last = layer == DEPTH - 1
        mod = cond @ ada_w[layer] + ada_b[layer]
        mod_c = cond_ctx @ ada_w[layer] + ada_b[layer]
        sh1, sc1, g1, sh2, sc2, g2 = jnp.split(mod, 6, axis=-1)
        csh1, csc1, cg1, csh2, csc2, cg2 = jnp.split(mod_c, 6, axis=-1)
        h = jnp.concatenate([_modulate(_rmsnorm(ctx, norm1_g[layer]), csh1, csc1),
                             _modulate(_rmsnorm(x, norm1_g[layer]), sh1, sc1)], axis=1)
        y = _mixer(h, n_ctx, w_in[layer], lower_bounds[layer], hg_norm_g[layer], gla_gate_up[layer],
                   gla_gate_b[layer], gla_norm_g[layer], s5_a_re[layer], s5_a_im[layer], s5_log_step[layer],
                   s5_b_re[layer], s5_b_im[layer], s5_c_re[layer], s5_c_im[layer], s5_d[layer],
                   s5_glu_w[layer], branch_proj[layer], w_out[layer])
        x = x + g1[:, None, :] * y[:, n_ctx:]
        if not last:
            ctx = ctx + cg1[:, None, :] * y[:, n_ctx * 0:n_ctx]
        h_lat = _modulate(_rmsnorm(x, norm2_g[layer]), sh2, sc2)
        if last:
            h = h_lat
        else:
            h = jnp.concatenate([_modulate(_rmsnorm(ctx, norm2_g[layer]), csh2, csc2), h_lat], axis=1)
        if layer % 2 == 0:
            f = _swiglu(h, ffn_w1[layer // 2], ffn_w3[layer // 2], ffn_w2[layer // 2])
        else:
            f = _moe(h, router_w[layer // 2], moe_w1[layer // 2], moe_w3[layer // 2], moe_w2[layer // 2])
        if last:
            x = x + g2[:, None, :] * f
        else:
            x = x + g2[:, None, :] * f[:, n_ctx:]
            ctx = ctx + cg2[:, None, :] * f[:, :n_ctx]
    return _rmsnorm(x, final_norm_g)
```

```cpp
#include <hip/hip_runtime.h>
#include <cstdio>
#include <cstdint>

#ifndef MK_N_LAUNCHES
#define MK_N_LAUNCHES 1
#endif

#define GAS __attribute__((address_space(1)))
#define LAS __attribute__((address_space(3)))
typedef unsigned short bf16_t;
typedef short bf16x8 __attribute__((ext_vector_type(8)));
typedef short bf16x4 __attribute__((ext_vector_type(4)));
typedef float f32x4 __attribute__((ext_vector_type(4)));
typedef float f32x2 __attribute__((ext_vector_type(2)));
typedef unsigned u32x4 __attribute__((ext_vector_type(4)));
typedef unsigned u32x2 __attribute__((ext_vector_type(2)));

constexpr int D = 1024, NB = 4, SEQ = 4096, CTX = 256, FFN = 3584, NE = 8;
constexpr int MCTX = NB * CTX;
constexpr int MLAT = NB * SEQ;
constexpr int M = MCTX + MLAT;
constexpr int NMIX = 5120, NGATE = 3072, LDP = 4608;
constexpr int N_IN = 7712;
constexpr int NSC = 17;
constexpr int S5L = 32, S5CH = M / S5L;
constexpr int S5ROWS = 768;
constexpr int S5K = 768;
constexpr float EPS = 1e-6f;
constexpr int MOE_ROWS = 2 * MLAT + NE * 256;
constexpr int MOE_TILES = MOE_ROWS / 256;

constexpr size_t MiB = (size_t)1 << 20;
constexpr size_t WS_CTL = 0, CTL_BYTES = 2 * MiB;
constexpr size_t WS_XW = 2 * MiB;
constexpr size_t WS_H = 70 * MiB;
constexpr size_t WS_WSM = 104 * MiB;
constexpr size_t WS_WMIX = WS_WSM;
constexpr size_t WS_WGATE = WS_WMIX + 20 * MiB;
constexpr size_t WS_WBR = WS_WGATE + 12 * MiB;
constexpr size_t WS_WOUT = WS_WBR + 6 * MiB;
constexpr size_t WS_WGLU = WS_WOUT + 4 * MiB;
constexpr size_t WS_W13 = WS_WGLU + 1 * MiB;
constexpr size_t WS_W2 = WS_W13 + 14 * MiB;
constexpr size_t WS_MW2 = WS_WSM;
constexpr size_t WS_S5C = 168 * MiB;
constexpr size_t WS_S5V = WS_S5C + 24 * MiB;
constexpr size_t WS_BIG = 200 * MiB;
constexpr size_t WS_P = WS_BIG;
constexpr size_t WS_Y = WS_BIG + 153 * MiB;
constexpr size_t WS_YPRE = WS_BIG + 204 * MiB;
constexpr size_t WS_UG = WS_BIG + 221 * MiB;
constexpr size_t WS_SLOC = WS_BIG + 257 * MiB;
constexpr size_t WS_GST = WS_BIG + 281 * MiB;
constexpr size_t WS_GST2 = WS_GST + 34 * MiB;
constexpr size_t WS_GDEC = WS_BIG + 332 * MiB;
constexpr size_t WS_HID = WS_BIG;
constexpr size_t WS_MW13 = WS_BIG;
constexpr size_t WS_MHID = WS_BIG + 112 * MiB;
constexpr size_t WS_SLAB = WS_BIG;
constexpr size_t WS_END = 578 * MiB;
static_assert(WS_MHID + (size_t)MOE_ROWS * FFN * 2 <= WS_END, "ws map");
static_assert(WS_GDEC + 1 * MiB <= WS_END, "ws map");

constexpr int CW_BAR = 0;
constexpr int CW_MOECNT = 4096;
constexpr int CW_WQ = 5120;
constexpr int CW_MOD = 8192;
constexpr int CW_LB = CW_MOD + 61440;
constexpr int CW_TOKE = CW_LB + 2048;
constexpr int CW_TOKR = CW_TOKE + 32768;
constexpr int CW_TOKW = CW_TOKR + 32768;
constexpr int CW_PERM = CW_TOKW + 32768;
constexpr int CW_END = CW_PERM + MOE_ROWS;
constexpr int CW_POS = 262144;
constexpr int CW_PERM2 = 327680;
static_assert(CW_END <= CW_POS && (size_t)(CW_POS + 64 * 512) * 4 <= CTL_BYTES, "ctl pos");
static_assert(CW_POS + 64 * 512 <= CW_PERM2 && (size_t)(CW_PERM2 + 8 * 16384) * 4 <= CTL_BYTES, "ctl perm2");
static_assert((size_t)CW_END * 4 <= CTL_BYTES, "ctl");

constexpr int NTHREADS = 512;
constexpr int LDS_BYTES = 161792;
constexpr int LDS_MISC = 160768;

__device__ __forceinline__ float bf2f(bf16_t v) { return __uint_as_float(((unsigned)v) << 16); }
__device__ __forceinline__ unsigned f2bf(float f) { unsigned u = __float_as_uint(f); return (u + 0x7fffu + ((u >> 16) & 1u)) >> 16; }
typedef __bf16 bf16v2_t __attribute__((ext_vector_type(2)));
__device__ __forceinline__ unsigned pk2(float lo, float hi) { const f32x2 v = {lo, hi}; return __builtin_bit_cast(unsigned, __builtin_convertvector(v, bf16v2_t)); }
__device__ __forceinline__ float fsigmoid(float x) { return __builtin_amdgcn_rcpf(1.0f + __expf(-x)); }
__device__ __forceinline__ float fsilu(float x) { return x * __builtin_amdgcn_rcpf(1.0f + __expf(-x)); }
__device__ __forceinline__ float flogsig(float x) { return fminf(x, 0.f) - __logf(1.0f + __expf(-fabsf(x))); }
__device__ __forceinline__ float wave_sum(float v) {
#pragma unroll
    for (int o = 1; o < 64; o <<= 1) v += __shfl_xor(v, o);
    return v;
}
#define LDS_WAIT() asm volatile("s_waitcnt lgkmcnt(0)" ::: "memory")
#define VM_WAIT() asm volatile("s_waitcnt vmcnt(0)" ::: "memory")

#define XB_TMO      128
#define XB_XCNT(j)  (256  + 64 * (j))
#define XB_XSUB(j)  (1280 + 64 * (j))
#define XB_XGEN(j)  (2304 + 64 * (j))
#define XB_TOP      3328
#define XB_TOPGEN   3392
#define XCD_BAR_WORDS 3456
#define XB_SPIN_CAP (1u << 22)
__device__ __forceinline__ unsigned xb_ld(unsigned* p)              { return __hip_atomic_load(p, __ATOMIC_RELAXED, __HIP_MEMORY_SCOPE_AGENT); }
__device__ __forceinline__ unsigned xb_add(unsigned* p, unsigned v) { return __hip_atomic_fetch_add(p, v, __ATOMIC_RELAXED, __HIP_MEMORY_SCOPE_AGENT); }
__device__ __forceinline__ unsigned xb_xcc_id() { return (unsigned)__builtin_amdgcn_s_getreg((3 << 11) | 20) & 0xFu; }
#define XB_SPIN(cond, bar) do { unsigned _sp = 0; while (cond) { __builtin_amdgcn_s_sleep(1); \
    if ((++_sp & 255u) == 0u) { if (xb_ld(&(bar)[XB_TMO])) break; if (_sp > XB_SPIN_CAP) { atomicAdd(&(bar)[XB_TMO], 1u); break; } } } } while (0)
struct XcdBarrier { unsigned* bar; unsigned x; volatile LAS unsigned* st; };
__device__ __forceinline__ XcdBarrier xcd_barrier_post(unsigned* bar, volatile LAS unsigned* st) {
    XcdBarrier b; b.bar = bar; b.x = xb_xcc_id(); b.st = st;
    if (threadIdx.x == 0) (void)xb_add(&bar[XB_XCNT(b.x)], 1u);
    return b;
}
__device__ __forceinline__ void xcd_barrier_complete(unsigned* bar, unsigned x, unsigned& nloc, unsigned& nx) {
    const unsigned G = gridDim.x * gridDim.y * gridDim.z;
    unsigned sum, cnt, mine, sp = 0u;
    for (;;) {
        sum = 0u; cnt = 0u; mine = 0u;
#pragma unroll
        for (unsigned j = 0; j < 16; ++j) { const unsigned c = xb_ld(&bar[XB_XCNT(j)]); sum += c; cnt += (c > 0u) ? 1u : 0u; mine = (j == x) ? c : mine; }
        if (sum == G) break;
        __builtin_amdgcn_s_sleep(1);
        if ((++sp & 255u) == 0u) { if (xb_ld(&bar[XB_TMO])) break; if (sp > XB_SPIN_CAP) { atomicAdd(&bar[XB_TMO], 1u); break; } }
    }
    nloc = mine > 0u ? mine : 1u; nx = cnt > 0u ? cnt : 1u;
}
__device__ __forceinline__ void xcd_barrier(const XcdBarrier& b) {
    asm volatile("s_waitcnt vmcnt(0)" ::: "memory");
    __syncthreads();
    if (threadIdx.x == 0) {
        unsigned* bar = b.bar;
        __builtin_amdgcn_s_waitcnt(0);
        unsigned nloc = b.st[0], nx = b.st[1];
        if (nloc == 0u) { xcd_barrier_complete(bar, b.x, nloc, nx); b.st[0] = nloc; b.st[1] = nx; }
        const unsigned old = xb_add(&bar[XB_XSUB(b.x)], 1u);
        const unsigned gen = old / nloc;
        if (old + 1u == (gen + 1u) * nloc) {
            __builtin_amdgcn_fence(__ATOMIC_RELEASE, "agent");
            asm volatile("s_waitcnt vmcnt(0)" ::: "memory");
            const unsigned og = xb_add(&bar[XB_TOP], 1u);
            const unsigned tg = og / nx;
            if (og + 1u == (tg + 1u) * nx) xb_add(&bar[XB_TOPGEN], 1u);
            else XB_SPIN(xb_ld(&bar[XB_TOPGEN]) == tg, bar);
            __builtin_amdgcn_fence(__ATOMIC_ACQUIRE, "agent");
            xb_add(&bar[XB_XGEN(b.x)], 1u);
            asm volatile("s_waitcnt vmcnt(0)" ::: "memory");
        } else {
            XB_SPIN(xb_ld(&bar[XB_XGEN(b.x)]) == gen, bar);
            __builtin_amdgcn_fence(__ATOMIC_ACQUIRE, "agent");
            asm volatile("s_waitcnt vmcnt(0)" ::: "memory");
        }
    }
    __syncthreads();
}
namespace pg8 {
constexpr int BM = 256, BK = 64, HALF = 128, HTB = HALF * BK * 2, STAGE_BYTES = 8 * HTB;
__host__ __device__ __forceinline__ int lds_byte(int r, int c) { const int st = (r >> 4) * 2 + (c >> 5), rr = r & 15, cc = c & 31, ob = rr * 64 + cc * 2; return st * 1024 + (ob ^ (((ob >> 9) & 1) << 5)); }
__host__ __device__ __forceinline__ void stage_rc(int b, int& R, int& C) { const int st = b / 1024, sb = b % 1024, swz = sb ^ (((sb >> 9) & 1) << 5); R = (st >> 1) * 16 + swz / 64; C = (st & 1) * 32 + (swz % 64) / 2; }
__host__ __device__ __forceinline__ int perm32(int rho) { const int n = rho >> 4, i = rho & 15; return 8 * (i >> 2) + 4 * n + (i & 3); }

struct GUnit { const char* A; const char* B; int i0, i1, i2, i3; };

template <class Sched, class Epi>
__device__ __forceinline__ void gemm_phase(LAS unsigned char* lds, const Sched& S, const Epi& E, const int lda, const int ldb, const int nt) {
    int tid_ = threadIdx.x; asm volatile("" : "+v"(tid_));
    const int tid = tid_, wid = __builtin_amdgcn_readfirstlane(tid >> 6), lane = tid & 63, wr = wid >> 2, wc = wid & 3, fr = lane & 15, fq = lane >> 4;
    constexpr bool GATHER = Sched::GATHER;
    unsigned voffA[2], voffB[2]; int RA[2], CA[2];
#pragma unroll
    for (int i = 0; i < 2; ++i) { int R, C; stage_rc(tid * 16 + i * 8192, R, C); const int Rb = Epi::PERM ? ((R & ~31) + perm32(R & 31)) : R;
        RA[i] = R; CA[i] = C; voffA[i] = (unsigned)(R * lda + C * 2); voffB[i] = (unsigned)(Rb * ldb + C * 2); }
    unsigned gAc[2], gAn[2];
    const size_t kstep = (size_t)(BK * 2);
    const size_t hstepA = GATHER ? 0 : (size_t)HALF * lda, hstepB = (size_t)HALF * ldb;
    const unsigned ldsw = (unsigned)wid * 1024u;
    const int aoff = lds_byte(wr * 64 + fr, fq * 8), boff = lds_byte(wc * 32 + fr, fq * 8);
#define PG8_SA(b, h) (((b) * 2 + (h)) * HTB)
#define PG8_SB(b, h) ((4 + (b) * 2 + (h)) * HTB)
#define PG8_STAGE(bufoff, gbase, voff) do { _Pragma("unroll") for (int _i = 0; _i < 2; ++_i) \
        __builtin_amdgcn_global_load_lds((const unsigned*)((const char*)(gbase) + (voff)[_i]), (LAS unsigned*)(lds + (bufoff) + ldsw + _i * 8192), 16, 0, 0); } while (0)
#define PG8_STAGE_A(bufoff, gbase, h, nx) do { if constexpr (GATHER) { const unsigned _pk = (nx) ? gAn[h] : gAc[h]; unsigned _vo[2]; _vo[0] = (_pk & 0xffffu) * (unsigned)lda + (unsigned)(CA[0] * 2); _vo[1] = (_pk >> 16) * (unsigned)lda + (unsigned)(CA[1] * 2); \
        PG8_STAGE(bufoff, gbase, _vo); } else PG8_STAGE(bufoff, (gbase) + (h) * hstepA, voffA); } while (0)
#define PG8_LDA(dst, b, h) do { _Pragma("unroll") for (int m = 0; m < 4; ++m) _Pragma("unroll") for (int k = 0; k < 2; ++k) dst[m][k] = *(const LAS bf16x8*)(lds + PG8_SA(b, h) + aoff + m * 2048 + k * 1024); } while (0)
#define PG8_LDB(dst, b, h) do { _Pragma("unroll") for (int n = 0; n < 2; ++n) _Pragma("unroll") for (int k = 0; k < 2; ++k) dst[n][k] = *(const LAS bf16x8*)(lds + PG8_SB(b, h) + boff + n * 2048 + k * 1024); } while (0)
#define PG8_MMA(ai, bj, At, Bt) do { __builtin_amdgcn_s_setprio(1); _Pragma("unroll") for (int m = 0; m < 4; ++m) _Pragma("unroll") for (int n = 0; n < 2; ++n) _Pragma("unroll") for (int k = 0; k < 2; ++k) \
        acc[ai][bj][m][n] = __builtin_amdgcn_mfma_f32_16x16x32_bf16(Bt[n][k], At[m][k], acc[ai][bj][m][n], 0, 0, 0); __builtin_amdgcn_s_setprio(0); } while (0)
#define PG8_WAIT_V(n) asm volatile("s_waitcnt vmcnt(" #n ")" ::: "memory")
#define PG8_WAIT_L(n) asm volatile("s_waitcnt lgkmcnt(" #n ")" ::: "memory")
#define PG8_BAR __builtin_amdgcn_s_barrier()
#define PG8_SCHED __builtin_amdgcn_sched_barrier(0)
#define PG8_GVOFF(dst, u) do { if constexpr (GATHER) { const int* _rt = S.rowtab(u); _Pragma("unroll") for (int _h = 0; _h < 2; ++_h) \
        dst[_h] = (unsigned)_rt[_h * HALF + RA[0]] | ((unsigned)_rt[_h * HALF + RA[1]] << 16); } } while (0)
    GUnit cur, nxt; int ui = 0;
    if (!S.next(0, cur)) return;
    f32x4 acc[2][2][4][2];
#pragma unroll
    for (int a = 0; a < 2; ++a)
#pragma unroll
        for (int b = 0; b < 2; ++b)
#pragma unroll
            for (int m = 0; m < 4; ++m)
#pragma unroll
                for (int n = 0; n < 2; ++n) acc[a][b][m][n] = (f32x4){0.f, 0.f, 0.f, 0.f};
    bf16x8 At[4][2], B0[2][2], B1[2][2];
    const char* cA = cur.A; const char* cB = cur.B;
    PG8_GVOFF(gAc, cur);
    PG8_STAGE(PG8_SB(0, 0), cB, voffB); PG8_STAGE_A(PG8_SA(0, 0), cA, 0, false); PG8_STAGE(PG8_SB(0, 1), cB + hstepB, voffB); PG8_STAGE_A(PG8_SA(0, 1), cA, 1, false);
    if (wr == 1) PG8_BAR;
    PG8_WAIT_V(4); PG8_BAR;
    PG8_STAGE(PG8_SB(1, 0), cB + kstep, voffB); PG8_STAGE_A(PG8_SA(1, 0), cA + kstep, 0, false); PG8_STAGE(PG8_SB(1, 1), cB + hstepB + kstep, voffB);
    PG8_WAIT_V(6); PG8_BAR;
    for (;;) {
        const bool has_next = S.next(ui + 1, nxt);
        const char* nA = has_next ? nxt.A : cA; const char* nB = has_next ? nxt.B : cB;
        if constexpr (GATHER) { if (has_next) { PG8_GVOFF(gAn, nxt); } else { gAn[0] = gAc[0]; gAn[1] = gAc[1]; } }
        for (int t = 0; t < nt; t += 2) {
            const bool last = (t == nt - 2);
            const char* a1 = cA + (size_t)(t + 1) * kstep;
            const char* a2 = last ? nA : cA + (size_t)(t + 2) * kstep; const char* b2 = last ? nB : cB + (size_t)(t + 2) * kstep;
            const char* a3 = a2 + kstep; const char* b3 = b2 + kstep;
            PG8_LDB(B0, 0, 0); PG8_SCHED; PG8_LDA(At, 0, 0); PG8_STAGE_A(PG8_SA(1, 1), a1, 1, false);
            PG8_WAIT_L(8); PG8_BAR; PG8_WAIT_L(0); PG8_MMA(0, 0, At, B0); PG8_BAR; PG8_SCHED;
            PG8_LDB(B1, 0, 1); PG8_STAGE(PG8_SB(0, 0), b2, voffB);
            PG8_BAR; PG8_WAIT_L(0); PG8_MMA(0, 1, At, B1); PG8_BAR;
            PG8_LDA(At, 0, 1); PG8_STAGE_A(PG8_SA(0, 0), a2, 0, last);
            PG8_BAR; PG8_WAIT_L(0); PG8_MMA(1, 0, At, B0); PG8_BAR; PG8_SCHED;
            PG8_STAGE(PG8_SB(0, 1), b2 + hstepB, voffB);
            PG8_WAIT_V(6); PG8_BAR; PG8_MMA(1, 1, At, B1); PG8_BAR;
            PG8_LDB(B0, 1, 0); PG8_SCHED; PG8_LDA(At, 1, 0); PG8_STAGE_A(PG8_SA(0, 1), a2, 1, last);
            PG8_WAIT_L(8); PG8_BAR; PG8_WAIT_L(0); PG8_MMA(0, 0, At, B0); PG8_BAR; PG8_SCHED;
            PG8_LDB(B1, 1, 1); PG8_STAGE(PG8_SB(1, 0), b3, voffB);
            PG8_BAR; PG8_WAIT_L(0); PG8_MMA(0, 1, At, B1); PG8_BAR;
            PG8_LDA(At, 1, 1); PG8_STAGE_A(PG8_SA(1, 0), a3, 0, last);
            PG8_BAR; PG8_WAIT_L(0); PG8_MMA(1, 0, At, B0); PG8_BAR; PG8_SCHED;
            PG8_STAGE(PG8_SB(1, 1), b3 + hstepB, voffB);
            PG8_WAIT_V(6); PG8_BAR; PG8_MMA(1, 1, At, B1); PG8_BAR;
        }
        E(acc, cur, wr, wc, fr, fq);
        if (!has_next) break;
#pragma unroll
        for (int a = 0; a < 2; ++a)
#pragma unroll
            for (int b = 0; b < 2; ++b)
#pragma unroll
                for (int m = 0; m < 4; ++m)
#pragma unroll
                    for (int n = 0; n < 2; ++n) acc[a][b][m][n] = (f32x4){0.f, 0.f, 0.f, 0.f};
        cur = nxt; cA = nA; cB = nB; ++ui;
        if constexpr (GATHER) { gAc[0] = gAn[0]; gAc[1] = gAn[1]; }
    }
    PG8_WAIT_V(0);
    if (wr == 0) PG8_BAR;
    PG8_BAR;
#undef PG8_SA
#undef PG8_SB
#undef PG8_STAGE
#undef PG8_STAGE_A
#undef PG8_LDA
#undef PG8_LDB
#undef PG8_MMA
#undef PG8_WAIT_V
#undef PG8_WAIT_L
#undef PG8_BAR
#undef PG8_SCHED
#undef PG8_GVOFF
}

struct DenseSched {
    static constexpr bool GATHER = false;
    const char* A; const char* B; int lda, ldb, nM, nN, pm0, nwg, G, c, lim;
    __device__ void init(const void* A_, const void* B_, int lda_, int ldb_, int nM_, int nN_, int pm0_, int G_, int c_) { A = (const char*)A_; B = (const char*)B_; lda = lda_; ldb = ldb_; nM = nM_; nN = nN_; pm0 = pm0_; nwg = nM * nN; G = G_; c = c_; lim = nwg; }
    __device__ __forceinline__ void tile_of(int L, int& pm, int& pn) const {
        int wgid = L; { const int q = nwg / 8, r = nwg % 8, xcd = wgid % 8, off = wgid / 8; wgid = (xcd < r ? xcd * (q + 1) : r * (q + 1) + (xcd - r) * q) + off; }
        const int nig = 8 * nN, gid = wgid / nig, fm = gid * 8, gsz = (nM - fm) < 8 ? (nM - fm) : 8;
        pm = fm + ((wgid % nig) % gsz) + pm0; pn = (wgid % nig) / gsz; }
    __device__ __forceinline__ bool next(int i, GUnit& u) const {
        const long L = (long)i * G + c; if (L >= lim) return false;
        int wgid = (int)L; { const int q = nwg / 8, r = nwg % 8, xcd = wgid % 8, off = wgid / 8; wgid = (xcd < r ? xcd * (q + 1) : r * (q + 1) + (xcd - r) * q) + off; }
        const int nig = 8 * nN, gid = wgid / nig, fm = gid * 8, gsz = (nM - fm) < 8 ? (nM - fm) : 8;
        const int pm = fm + ((wgid % nig) % gsz) + pm0, pn = (wgid % nig) / gsz;
        u.A = A + (size_t)pm * 256 * lda; u.B = B + (size_t)pn * 256 * ldb; u.i0 = pm; u.i1 = pn; u.i2 = 0; u.i3 = 0; return true;
    }
};
struct SplitSched {
    static constexpr bool GATHER = false;
    DenseSched D; int first, S, kbytes, c;
    __device__ __forceinline__ bool next(int i, GUnit& u) const {
        if (i > 0) return false; const int L = first + c / S, ks = c % S; if (L >= D.nwg) return false;
        int pm, pn; D.tile_of(L, pm, pn);
        u.A = D.A + (size_t)pm * 256 * D.lda + (size_t)ks * kbytes; u.B = D.B + (size_t)pn * 256 * D.ldb + (size_t)ks * kbytes; u.i0 = pm; u.i1 = pn; u.i2 = c; u.i3 = ks; return true; }
};
}
namespace epi {
using pg8::GUnit;
__device__ __forceinline__ void unpack8(const u32x4 w, float (&o)[8]) {
    o[0] = __uint_as_float(w.x << 16); o[1] = __uint_as_float(w.x & 0xffff0000u); o[2] = __uint_as_float(w.y << 16); o[3] = __uint_as_float(w.y & 0xffff0000u);
    o[4] = __uint_as_float(w.z << 16); o[5] = __uint_as_float(w.z & 0xffff0000u); o[6] = __uint_as_float(w.w << 16); o[7] = __uint_as_float(w.w & 0xffff0000u);
}
__device__ __forceinline__ u32x4 pack8(const float (&v)[8]) { u32x4 w; w.x = pk2(v[0], v[1]); w.y = pk2(v[2], v[3]); w.z = pk2(v[4], v[5]); w.w = pk2(v[6], v[7]); return w; }
#define EPI_ROWS_BEGIN(pmrow0) _Pragma("unroll") for (int ai = 0; ai < 2; ++ai) _Pragma("unroll") for (int m = 0; m < 4; ++m) { const int row = (pmrow0) + ai * 128 + wr * 64 + m * 16 + fr;
#define EPI_ROWS_END asm volatile("" ::: "memory"); }

struct EpiWin {
    static constexpr bool PERM = true;
    bf16_t* P; bf16_t* UG; const float* loglb; const float* logub; const float* gbias;
    template <int TYPE>
    __device__ __forceinline__ void body(const f32x4 (&acc)[2][2][4][2], const GUnit& u, int wr, int wc, int fr, int fq) const {
        const int pm = u.i0, pn = u.i1;
#pragma unroll
        for (int bj = 0; bj < 2; ++bj) {
            const int col = pn * 256 + bj * 128 + wc * 32 + 8 * fq;
            float pa[8], pb[8];
#pragma unroll
            for (int j = 0; j < 8; ++j) { pa[j] = 0.f; pb[j] = 0.f; }
            if (TYPE == 1) { const int ch = col & 511;
#pragma unroll
                for (int j = 0; j < 8; ++j) { pa[j] = loglb[ch + j]; pb[j] = logub[ch + j]; } }
            if (TYPE == 4) { const int n = col - 3584;
#pragma unroll
                for (int j = 0; j < 8; ++j) pa[j] = gbias[n + j]; }
            EPI_ROWS_BEGIN(pm * 256)
                float v[8];
#pragma unroll
                for (int j = 0; j < 4; ++j) { v[j] = acc[ai][bj][m][0][j]; v[4 + j] = acc[ai][bj][m][1][j]; }
                if (TYPE == 1) {
#pragma unroll
                    for (int j = 0; j < 8; ++j) { const float z = v[j], t = __expf(-fabsf(z)), rc = __builtin_amdgcn_rcpf(1.0f + t), sg = z >= 0.f ? rc : t * rc;
                        const bool pos = pa[j] > 0.f; const float L = __logf(pos ? pa[j] + pb[j] * sg : 1.0f + t); v[j] = pos ? L : fminf(z, 0.f) - L; }
                } else if (TYPE == 2) {
#pragma unroll
                    for (int j = 0; j < 8; ++j) v[j] = fsilu(v[j]);
                } else if (TYPE == 3) {
#pragma unroll
                    for (int j = 0; j < 8; ++j) v[j] *= 0.125f;
                } else if (TYPE == 4) {
#pragma unroll
                    for (int j = 0; j < 8; ++j) v[j] = flogsig(v[j] + pa[j]) * 0.0625f;
                }
                const u32x4 w = pack8(v);
                if (TYPE == 5) { const int c0 = col - 4608, g = c0 >> 4, p0 = c0 & 15, ck = row >> 5, mm = row & 31;
                    *(u32x4*)(UG + ((size_t)(g * S5ROWS + ck) * S5K + mm * 16 + p0)) = w; }
                else *(u32x4*)(P + (size_t)row * LDP + col) = w;
            EPI_ROWS_END
        }
    }
    __device__ __forceinline__ void operator()(const f32x4 (&acc)[2][2][4][2], const GUnit& u, int wr, int wc, int fr, int fq) const {
        const int pn = u.i1;
        if (pn >= 2 && pn <= 5) body<1>(acc, u, wr, wc, fr, fq);
        else if (pn == 8 || pn == 9 || pn == 16 || pn == 17) body<2>(acc, u, wr, wc, fr, fq);
        else if (pn == 10) body<3>(acc, u, wr, wc, fr, fq);
        else if (pn == 14 || pn == 15) body<4>(acc, u, wr, wc, fr, fq);
        else if (pn >= 18) body<5>(acc, u, wr, wc, fr, fq);
        else body<0>(acc, u, wr, wc, fr, fq);
    }
};
struct GateMap { bf16_t* G; bf16_t* SP; int mode;
    __device__ __forceinline__ bf16_t* loc(int pm, int pn) const {
        int g = -1;
        if (mode == 1) { if (pn >= 10) g = (11 - pn) * 64 + (pm - 4); else if (pn == 9 && pm < 52) g = 128 + (pm - 4); }
        else if (pm < 4) g = pm * 12 + pn;
        return g >= 0 ? SP + (size_t)g * 65536 : G + (size_t)(pm * 12 + pn) * 65536; } };
struct EpiGate {
    static constexpr bool PERM = true;
    GateMap GM;
    __device__ __forceinline__ void operator()(const f32x4 (&acc)[2][2][4][2], const GUnit& u, int wr, int wc, int fr, int fq) const {
        bf16_t* base = GM.loc(u.i0, u.i1);
#pragma unroll
        for (int bj = 0; bj < 2; ++bj) { const int col = bj * 128 + wc * 32 + 8 * fq;
            EPI_ROWS_BEGIN(0)
                float v[8];
#pragma unroll
                for (int j = 0; j < 4; ++j) { v[j] = fsigmoid(acc[ai][bj][m][0][j]); v[4 + j] = fsigmoid(acc[ai][bj][m][1][j]); }
                *(u32x4*)(base + row * 256 + col) = pack8(v);
            EPI_ROWS_END }
    }
};
struct EpiS5Loc {
    static constexpr bool PERM = false;
    float* SL;
    __device__ __forceinline__ void operator()(const f32x4 (&acc)[2][2][4][2], const GUnit& u, int wr, int wc, int fr, int fq) const {
        const int g = u.i0, mt = u.i1;
        EPI_ROWS_BEGIN(mt * 256)
            float* rp = SL + ((size_t)(g * S5ROWS + row)) * 256 + wc * 32 + 4 * fq;
#pragma unroll
            for (int bj = 0; bj < 2; ++bj)
#pragma unroll
                for (int n = 0; n < 2; ++n) *(f32x4*)(rp + bj * 128 + n * 16) = acc[ai][bj][m][n];
        EPI_ROWS_END
    }
};
struct EpiS5Out {
    static constexpr bool PERM = true;
    bf16_t* YP;
    __device__ __forceinline__ void operator()(const f32x4 (&acc)[2][2][4][2], const GUnit& u, int wr, int wc, int fr, int fq) const {
        const int g = u.i0, mt = u.i1, pn = u.i2;
#pragma unroll
        for (int bj = 0; bj < 2; ++bj) { const int col = pn * 256 + bj * 128 + wc * 32 + 8 * fq, mm = col >> 4, p0 = col & 15;
            EPI_ROWS_BEGIN(mt * 256)
                if (row < S5CH) {
                    float v[8];
#pragma unroll
                    for (int j = 0; j < 4; ++j) { v[j] = acc[ai][bj][m][0][j]; v[4 + j] = acc[ai][bj][m][1][j]; }
#pragma unroll
                    for (int j = 0; j < 8; ++j) { const float x = v[j]; v[j] = x * fsigmoid(1.5957691216057308f * (x + 0.044715f * x * x * x)); }
                    *(u32x4*)(YP + (size_t)(row * S5L + mm) * 512 + g * 16 + p0) = pack8(v);
                }
            EPI_ROWS_END }
    }
};
struct EpiGlu {
    static constexpr bool PERM = true;
    const bf16_t* YP; bf16_t* Y;
    __device__ __forceinline__ void operator()(const f32x4 (&acc)[2][2][4][2], const GUnit& u, int wr, int wc, int fr, int fq) const {
        const int col0 = u.i1 * 256 + wc * 32 + 8 * fq;
#pragma unroll
        for (int ai = 0; ai < 2; ++ai) { u32x4 yv[4][2];
#pragma unroll
            for (int m = 0; m < 4; ++m)
#pragma unroll
                for (int bj = 0; bj < 2; ++bj) yv[m][bj] = *(const u32x4*)(YP + (size_t)(u.i0 * 256 + ai * 128 + wr * 64 + m * 16 + fr) * 512 + col0 + bj * 128);
#pragma unroll
            for (int m = 0; m < 4; ++m)
#pragma unroll
                for (int bj = 0; bj < 2; ++bj) { const int row = u.i0 * 256 + ai * 128 + wr * 64 + m * 16 + fr; float y[8], v[8]; unpack8(yv[m][bj], y);
#pragma unroll
                    for (int j = 0; j < 4; ++j) { v[j] = y[j] * fsigmoid(acc[ai][bj][m][0][j]); v[4 + j] = y[4 + j] * fsigmoid(acc[ai][bj][m][1][j]); }
                    *(u32x4*)(Y + (size_t)row * 1536 + 1024 + col0 + bj * 128) = pack8(v); }
            asm volatile("" ::: "memory"); }
    }
};
struct EpiMerge {
    static constexpr bool PERM = true;
    GateMap GM; bf16_t* MG;
    __device__ __forceinline__ void operator()(const f32x4 (&acc)[2][2][4][2], const GUnit& u, int wr, int wc, int fr, int fq) const {
        const int k = u.i2, col0 = u.i1 * 256 + wc * 32 + 8 * fq;
        const bf16_t* gb = GM.loc(u.i0, k * 4 + u.i1) + wc * 32 + 8 * fq;
#pragma unroll
        for (int ai = 0; ai < 2; ++ai) { u32x4 gv[4][2], pv[4][2];
#pragma unroll
            for (int m = 0; m < 4; ++m)
#pragma unroll
                for (int bj = 0; bj < 2; ++bj) { const size_t row = (size_t)(u.i0 * 256 + ai * 128 + wr * 64 + m * 16 + fr);
                    gv[m][bj] = *(const u32x4*)(gb + (ai * 128 + wr * 64 + m * 16 + fr) * 256 + bj * 128);
                    pv[m][bj] = k > 0 ? *(const u32x4*)(MG + row * 1024 + col0 + bj * 128) : (u32x4){0u, 0u, 0u, 0u}; }
#pragma unroll
            for (int m = 0; m < 4; ++m)
#pragma unroll
                for (int bj = 0; bj < 2; ++bj) { const size_t row = (size_t)(u.i0 * 256 + ai * 128 + wr * 64 + m * 16 + fr); float gt[8], pr[8], v[8]; unpack8(gv[m][bj], gt); unpack8(pv[m][bj], pr);
#pragma unroll
                    for (int j = 0; j < 4; ++j) { v[j] = gt[j] * acc[ai][bj][m][0][j] + pr[j]; v[4 + j] = gt[4 + j] * acc[ai][bj][m][1][j] + pr[4 + j]; }
                    *(u32x4*)(MG + row * 1024 + col0 + bj * 128) = pack8(v); }
            asm volatile("" ::: "memory"); }
    }
};
struct EpiResid {
    static constexpr bool PERM = false;
    float* XW; const float* modacc; const float* adab;
    __device__ __forceinline__ void operator()(const f32x4 (&acc)[2][2][4][2], const GUnit& u, int wr, int wc, int fr, int fq) const {
        const int pm = u.i0, bidx = pm < 4 ? 4 : ((pm - 4) >> 4);
        const int col0 = u.i1 * 256 + wc * 32 + 4 * fq;
        f32x4 gv[2][2];
#pragma unroll
        for (int bj = 0; bj < 2; ++bj)
#pragma unroll
            for (int n = 0; n < 2; ++n) gv[bj][n] = *(const f32x4*)(modacc + bidx * 6144 + col0 + bj * 128 + n * 16) + *(const f32x4*)(adab + col0 + bj * 128 + n * 16);
#pragma unroll
        for (int ai = 0; ai < 2; ++ai) { f32x4 xv[4][2][2];
#pragma unroll
            for (int m = 0; m < 4; ++m) { const float* rp = XW + (size_t)(pm * 256 + ai * 128 + wr * 64 + m * 16 + fr) * 1024 + col0;
#pragma unroll
                for (int bj = 0; bj < 2; ++bj)
#pragma unroll
                    for (int n = 0; n < 2; ++n) xv[m][bj][n] = *(const f32x4*)(rp + bj * 128 + n * 16); }
#pragma unroll
            for (int m = 0; m < 4; ++m) { float* rp = XW + (size_t)(pm * 256 + ai * 128 + wr * 64 + m * 16 + fr) * 1024 + col0;
#pragma unroll
                for (int bj = 0; bj < 2; ++bj)
#pragma unroll
                    for (int n = 0; n < 2; ++n) *(f32x4*)(rp + bj * 128 + n * 16) = xv[m][bj][n] + gv[bj][n] * acc[ai][bj][m][n]; }
            asm volatile("" ::: "memory"); }
    }
};
struct EpiSwiglu {
    static constexpr bool PERM = true;
    bf16_t* HID;
    __device__ __forceinline__ void operator()(const f32x4 (&acc)[2][2][4][2], const GUnit& u, int wr, int wc, int fr, int fq) const {
        const int col = u.i1 * 128 + wc * 32 + 8 * fq;
        EPI_ROWS_BEGIN(u.i0 * 256)
            float v[8];
#pragma unroll
            for (int j = 0; j < 4; ++j) { v[j] = fsilu(acc[ai][0][m][0][j]) * acc[ai][1][m][0][j]; v[4 + j] = fsilu(acc[ai][0][m][1][j]) * acc[ai][1][m][1][j]; }
            *(u32x4*)(HID + (size_t)row * FFN + col) = pack8(v);
        EPI_ROWS_END
    }
};
struct EpiStoreBf16 {
    static constexpr bool PERM = true;
    bf16_t* O; int ld;
    __device__ __forceinline__ void operator()(const f32x4 (&acc)[2][2][4][2], const GUnit& u, int wr, int wc, int fr, int fq) const {
#pragma unroll
        for (int bj = 0; bj < 2; ++bj) { const int col = u.i1 * 256 + bj * 128 + wc * 32 + 8 * fq;
            EPI_ROWS_BEGIN(u.i0 * 256)
                float v[8];
#pragma unroll
                for (int j = 0; j < 4; ++j) { v[j] = acc[ai][bj][m][0][j]; v[4 + j] = acc[ai][bj][m][1][j]; }
                *(u32x4*)(O + (size_t)row * ld + col) = pack8(v);
            EPI_ROWS_END }
    }
};
#ifdef PROBE_GEMM
struct EpiNull {
    static constexpr bool PERM = false;
    float* O;
    __device__ __forceinline__ void operator()(const f32x4 (&acc)[2][2][4][2], const GUnit& u, int wr, int wc, int fr, int fq) const {
        f32x4 t = acc[0][0][0][0];
#pragma unroll
        for (int ai = 0; ai < 2; ++ai)
#pragma unroll
            for (int bj = 0; bj < 2; ++bj)
#pragma unroll
                for (int m = 0; m < 4; ++m) { t += acc[ai][bj][m][0]; t += acc[ai][bj][m][1]; }
        if (t[0] + t[1] + t[2] + t[3] == 12345.678f) O[fq] = t[0];
    }
};
#endif
struct EpiSlab {
    static constexpr bool PERM = false;
    float* SLB;
    __device__ __forceinline__ void operator()(const f32x4 (&acc)[2][2][4][2], const GUnit& u, int wr, int wc, int fr, int fq) const {
        float* base = SLB + (size_t)u.i2 * 65536 + wc * 32 + 4 * fq;
#pragma unroll
        for (int ai = 0; ai < 2; ++ai)
#pragma unroll
            for (int m = 0; m < 4; ++m) { float* rp = base + (ai * 128 + wr * 64 + m * 16 + fr) * 256;
#pragma unroll
                for (int bj = 0; bj < 2; ++bj)
#pragma unroll
                    for (int n = 0; n < 2; ++n) *(f32x4*)(rp + bj * 128 + n * 16) = acc[ai][bj][m][n]; }
    }
};
}
struct Args { const float* in[33]; float* out; unsigned char* ws; int ph_lo, ph_hi; };
typedef const __attribute__((address_space(4))) Args* ArgsP;
struct Frame {
    LAS unsigned char* lds;
    unsigned* ctl; unsigned char* ws;
    int tid, lane, wave, G, c;
    ArgsP ap;
};
enum { I_X = 0, I_C, I_CTX, I_CCTX, I_N1G, I_N2G, I_ADAW, I_ADAB, I_WIN, I_LBL, I_HGNG, I_GUP, I_GB, I_GLNG, I_SARE, I_SAIM, I_SLOG, I_SBRE, I_SBIM, I_SCRE, I_SCIM, I_SD, I_SGLU, I_BRP, I_WOUT,
       I_FW1, I_FW3, I_FW2, I_RW, I_MW1, I_MW3, I_MW2, I_FNG };

__device__ __forceinline__ void tr_load(const float* W, int ldw, int scol0, int k0, int lane, float (&r)[32]) {
#pragma unroll
    for (int i = 0; i < 32; ++i) r[i] = W[(size_t)(k0 + 2 * i + (lane >> 5)) * ldw + scol0 + (lane & 31)];
}
__device__ __forceinline__ void tr_store(const float (&r)[32], bf16_t* WT, int K, int drow0, int k0, LAS float* scr, int lane) {
#pragma unroll
    for (int i = 0; i < 32; ++i) scr[(2 * i + (lane >> 5)) * 33 + (lane & 31)] = r[i];
    LDS_WAIT(); asm volatile("" ::: "memory");
    const int c = lane & 7;
#pragma unroll
    for (int j = 0; j < 4; ++j) { const int n = (lane >> 3) + 8 * j; const LAS float* s = scr + (8 * c) * 33 + n;
        u32x4 o; o.x = pk2(s[0 * 33], s[1 * 33]); o.y = pk2(s[2 * 33], s[3 * 33]); o.z = pk2(s[4 * 33], s[5 * 33]); o.w = pk2(s[6 * 33], s[7 * 33]);
        *(u32x4*)(WT + (size_t)(drow0 + n) * K + k0 + 8 * c) = o; }
    LDS_WAIT(); asm volatile("" ::: "memory");
}
__device__ __forceinline__ void tr_job(Frame& F, int& base, const float* W, int ldw, int scol0, int ncols, int K, bf16_t* WT, int drow0, int dmap) {
    const int gw = F.c * 8 + F.wave, NGW = F.G * 8, nblk = ncols / 32, nitems = (K / 64) * nblk;
    LAS float* scr = (LAS float*)(F.lds + F.wave * 16384);
    int first = gw - (base % NGW); if (first < 0) first += NGW;
    float ra[32], rb[32];
    int it = first;
    if (it < nitems) tr_load(W, ldw, scol0 + (it % nblk) * 32, (it / nblk) * 64, F.lane, ra);
    while (it < nitems) {
        const int nx = it + NGW;
        if (nx < nitems) tr_load(W, ldw, scol0 + (nx % nblk) * 32, (nx / nblk) * 64, F.lane, rb);
        { const int n0 = (it % nblk) * 32; const int dr = dmap == 0 ? drow0 + n0 : drow0 + (n0 >> 7) * 256 + (n0 & 127); tr_store(ra, WT, K, dr, (it / nblk) * 64, scr, F.lane); }
        it = nx;
        if (it >= nitems) break;
        const int nx2 = it + NGW;
        if (nx2 < nitems) tr_load(W, ldw, scol0 + (nx2 % nblk) * 32, (nx2 / nblk) * 64, F.lane, ra);
        { const int n0 = (it % nblk) * 32; const int dr = dmap == 0 ? drow0 + n0 : drow0 + (n0 >> 7) * 256 + (n0 & 127); tr_store(rb, WT, K, dr, (it / nblk) * 64, scr, F.lane); }
        it = nx2;
    }
    base += nitems;
}

struct cplx { float re, im; };
__device__ __forceinline__ cplx cmul(cplx a, cplx b) { return {a.re * b.re - a.im * b.im, a.re * b.im + a.im * b.re}; }
__device__ __forceinline__ cplx s5_pow(float are, float aim, float dt, int j) {
    const float mag = __expf((float)j * are * dt);
    double ang = (double)j * (double)aim * (double)dt; ang -= 6.283185307179586476925 * rint(ang * 0.15915494309189533577);
    const float sn = sinf((float)ang), cs = cosf((float)ang);
    return {mag * cs, mag * sn};
}
__device__ __forceinline__ cplx s5_z(float are, float aim, float dt) {
    const float x = are * dt; double ang = (double)aim * (double)dt; ang -= 6.283185307179586476925 * rint(ang * 0.15915494309189533577);
    const float th = (float)ang, sh = sinf(0.5f * th), em1 = expm1f(x), ex = em1 + 1.0f;
    const float cm1 = -2.0f * sh * sh;
    const float nre = em1 * (1.0f + cm1) + cm1, nim = ex * sinf(th);
    const float den = are * are + aim * aim;
    return {(nre * are + nim * aim) / den, (nim * are - nre * aim) / den};
}
constexpr size_t WS_S5PW = WS_BIG + 334 * MiB;
constexpr size_t WS_S5KT = WS_BIG + 338 * MiB;
constexpr size_t WS_S5BB = WS_BIG + 342 * MiB;
static_assert(WS_S5BB + 1 * MiB <= WS_END, "ws");

__device__ __forceinline__ void s5_tables(Frame& F) {
    float* PW = (float*)(F.ws + WS_S5PW); float* KT = (float*)(F.ws + WS_S5KT);
    LAS float* spw = (LAS float*)F.lds;
    LAS float* sbb = spw + 9 * 128;
    LAS float* scc = sbb + 2048;
    for (int it = F.c; it < 2 * 2 * 32 * 4; it += F.G) {
        const int jq = it & 3, g = (it >> 2) & 31, d = (it >> 7) & 1, l = it >> 8, ldg = (l * 2 + d) * 32 + g, j0 = jq * 8;
        const float dt = __expf(F.ap->in[I_SLOG][ldg]);
        __syncthreads();
        for (int u = F.tid; u < 9 * 64; u += NTHREADS) { const int j = j0 + u / 64, n = u % 64; if (j <= 32) { const cplx p = s5_pow(F.ap->in[I_SARE][ldg * 64 + n], F.ap->in[I_SAIM][ldg * 64 + n], dt, j);
            spw[u * 2] = p.re; spw[u * 2 + 1] = p.im; PW[((size_t)ldg * 33 + j) * 128 + n * 2] = p.re; PW[((size_t)ldg * 33 + j) * 128 + n * 2 + 1] = p.im; } }
        for (int u = F.tid; u < 1024; u += NTHREADS) { const int n = u >> 4, p = u & 15; const cplx z = s5_z(F.ap->in[I_SARE][ldg * 64 + n], F.ap->in[I_SAIM][ldg * 64 + n], dt);
            const cplx b = {F.ap->in[I_SBRE][(size_t)ldg * 1024 + u], F.ap->in[I_SBIM][(size_t)ldg * 1024 + u]}; const cplx bb = cmul(z, b); sbb[u * 2] = bb.re; sbb[u * 2 + 1] = bb.im; if (jq == 0) { float* BB = (float*)(F.ws + WS_S5BB); BB[((size_t)ldg * 1024 + u) * 2] = bb.re; BB[((size_t)ldg * 1024 + u) * 2 + 1] = bb.im; }
            const int pp = u >> 6, nn = u & 63; scc[u * 2] = F.ap->in[I_SCRE][(size_t)ldg * 1024 + pp * 64 + nn]; scc[u * 2 + 1] = F.ap->in[I_SCIM][(size_t)ldg * 1024 + pp * 64 + nn]; }
        __syncthreads();
#pragma unroll
        for (int e = 0; e < 4; ++e) { const int u = F.tid + e * NTHREADS, jj = u >> 8, p = (u >> 4) & 15, q = u & 15; float s = 0.f;
            for (int n = 0; n < 64; ++n) { const cplx c = {scc[(p * 64 + n) * 2], scc[(p * 64 + n) * 2 + 1]}, w = {spw[(jj * 64 + n) * 2], spw[(jj * 64 + n) * 2 + 1]}, b = {sbb[(n * 16 + q) * 2], sbb[(n * 16 + q) * 2 + 1]};
                const cplx cw = cmul(c, w); s += cw.re * b.re - cw.im * b.im; }
            KT[((size_t)ldg * 32 + j0 + jj) * 256 + p * 16 + q] = s; }
    }
    __syncthreads();
}
__device__ __forceinline__ void s5_task_T(Frame& F, const int l, const unsigned t) {
    const float* KT = (const float*)(F.ws + WS_S5KT); bf16_t* BC = (bf16_t*)(F.ws + WS_S5C);
    const int qh = (int)(t & 1), m2 = (int)((t >> 1) & 31), row = (int)((t >> 6) & 511), g = (int)(t >> 15), m = row >> 4, p = row & 15;
    float v[8];
#pragma unroll
    for (int j = 0; j < 8; ++j) v[j] = 0.f;
    if (m2 <= m) { const float* k = KT + ((size_t)((l * 2 + 0) * 32 + g) * 32 + (m - m2)) * 256 + p * 16 + qh * 8;
#pragma unroll
        for (int j = 0; j < 8; ++j) v[j] += k[j]; }
    if (m2 >= m) { const float* k = KT + ((size_t)((l * 2 + 1) * 32 + g) * 32 + (m2 - m)) * 256 + p * 16 + qh * 8;
#pragma unroll
        for (int j = 0; j < 8; ++j) v[j] += k[j]; }
    if (m2 == m && (p >> 3) == qh) v[p & 7] += F.ap->in[I_SD][l * 512 + g * 16 + p];
    *(u32x4*)(BC + ((size_t)(g * 512 + row)) * 768 + m2 * 16 + qh * 8) = epi::pack8(v);
}
__device__ __forceinline__ void s5_task_W(Frame& F, const int l, const unsigned t) {
    const float* PW = (const float*)(F.ws + WS_S5PW); bf16_t* BC = (bf16_t*)(F.ws + WS_S5C);
    const int n8 = (int)(t & 7), c = (int)((t >> 3) & 1), d = (int)((t >> 4) & 1), row = (int)((t >> 5) & 511), g = (int)(t >> 14), m = row >> 4, p = row & 15;
    const int ldg = (l * 2 + d) * 32 + g, e = d == 0 ? m + 1 : 32 - m; float v[8];
#pragma unroll
    for (int j = 0; j < 8; ++j) { const int n = n8 * 8 + j; const cplx cc = {F.ap->in[I_SCRE][(size_t)ldg * 1024 + p * 64 + n], F.ap->in[I_SCIM][(size_t)ldg * 1024 + p * 64 + n]};
        const cplx w = {PW[((size_t)ldg * 33 + e) * 128 + n * 2], PW[((size_t)ldg * 33 + e) * 128 + n * 2 + 1]}; const cplx cw = cmul(cc, w); v[j] = c == 0 ? cw.re : -cw.im; }
    *(u32x4*)(BC + ((size_t)(g * 512 + row)) * 768 + 512 + d * 128 + c * 64 + n8 * 8) = epi::pack8(v);
}
__device__ __forceinline__ void s5_task_V(Frame& F, const int l, const unsigned t) {
    const float* PW = (const float*)(F.ws + WS_S5PW); const float* BB = (const float*)(F.ws + WS_S5BB); bf16_t* VT = (bf16_t*)(F.ws + WS_S5V);
    const int qh = (int)(t & 1), m2 = (int)((t >> 1) & 31), vr = (int)((t >> 6) & 255), g = (int)(t >> 14), d = vr >> 7, c = (vr >> 6) & 1, n = vr & 63;
    const int ldg = (l * 2 + d) * 32 + g, e = d == 0 ? 31 - m2 : m2;
    const cplx w = {PW[((size_t)ldg * 33 + e) * 128 + n * 2], PW[((size_t)ldg * 33 + e) * 128 + n * 2 + 1]}; float v[8];
    const float* bp = BB + ((size_t)ldg * 1024 + n * 16 + qh * 8) * 2;
#pragma unroll
    for (int j = 0; j < 8; ++j) { const cplx b = {bp[j * 2], bp[j * 2 + 1]}; const cplx r = cmul(w, b); v[j] = c == 0 ? r.re : r.im; }
    *(u32x4*)(VT + ((size_t)(g * 256 + vr)) * 512 + m2 * 16 + qh * 8) = epi::pack8(v);
}
template <int L>
__device__ __forceinline__ void bg_s5fill(Frame& F) {
    volatile LAS unsigned* slot = (volatile LAS unsigned*)(F.lds + LDS_MISC + 64);
    for (;;) {
        __syncthreads();
        if (F.tid == 0) slot[0] = __hip_atomic_fetch_add(F.ctl + CW_WQ + 64 * (7 + L), 1u, __ATOMIC_RELAXED, __HIP_MEMORY_SCOPE_AGENT);
        __syncthreads();
        const unsigned blk = slot[0]; if (blk >= 1024u) break;
        if (blk < 512u) { for (int u = 0; u < 4; ++u) s5_task_T(F, L, (blk * 4 + u) * NTHREADS + F.tid); }
        else if (blk < 768u) { for (int u = 0; u < 4; ++u) s5_task_W(F, L, ((blk - 512u) * 4 + u) * NTHREADS + F.tid); }
        else { for (int u = 0; u < 4; ++u) s5_task_V(F, L, ((blk - 768u) * 4 + u) * NTHREADS + F.tid); }
    }
    __syncthreads();
}

struct ConvItem { const float* W; bf16_t* WT; int ldw, scol, ldo, drow, k0; };
__device__ __forceinline__ ConvItem small_item(Frame& F, int l, int it) {
    ConvItem m; const float* win = F.ap->in[I_WIN] + (size_t)l * D * N_IN; bf16_t* wm = (bf16_t*)(F.ws + WS_WMIX) + (size_t)l * NMIX * D; int nblk, loc;
    if (it < 1792) { loc = it; nblk = 112; m.W = win; m.ldw = N_IN; m.scol = 0; m.WT = wm; m.ldo = D; m.drow = 0; }
    else if (it < 2048) { loc = it - 1792; nblk = 16; m.W = win; m.ldw = N_IN; m.scol = 3616; m.WT = wm; m.ldo = D; m.drow = 4096; }
    else if (it < 2304) { loc = it - 2048; nblk = 16; m.W = win; m.ldw = N_IN; m.scol = 4128; m.WT = wm; m.ldo = D; m.drow = 4608; }
    else if (it < 3840) { loc = it - 2304; nblk = 96; m.W = win; m.ldw = N_IN; m.scol = 4640; m.WT = (bf16_t*)(F.ws + WS_WGATE) + (size_t)l * NGATE * D; m.ldo = D; m.drow = 0; }
    else if (it < 4608) { const int k = (it - 3840) >> 8; loc = (it - 3840) & 255; nblk = 32; m.W = F.ap->in[I_BRP] + (size_t)(l * 3 + k) * 512 * D; m.ldw = D; m.scol = 0; m.WT = (bf16_t*)(F.ws + WS_WBR) + (size_t)(l * 3 + k) * D * 512; m.ldo = 512; m.drow = 0; }
    else if (it < 5120) { loc = it - 4608; nblk = 32; m.W = F.ap->in[I_WOUT] + (size_t)l * D * D; m.ldw = D; m.scol = 0; m.WT = (bf16_t*)(F.ws + WS_WOUT) + (size_t)l * D * D; m.ldo = D; m.drow = 0; }
    else { loc = it - 5120; nblk = 16; m.W = F.ap->in[I_SGLU] + (size_t)l * 512 * 512; m.ldw = 512; m.scol = 0; m.WT = (bf16_t*)(F.ws + WS_WGLU) + (size_t)l * 512 * 512; m.ldo = 512; m.drow = 0; }
    const int nb = loc % nblk, kb = loc / nblk; m.scol += nb * 32; m.drow += nb * 32; m.k0 = kb * 64; return m;
}
__device__ __forceinline__ ConvItem ffn_item(Frame& F, int it) {
    ConvItem m; const int mat = it / 1792, loc = it % 1792;
    if (mat < 2) { const int nb = loc % 112, kb = loc / 112, n0 = nb * 32; m.W = F.ap->in[mat == 0 ? I_FW1 : I_FW3]; m.ldw = FFN; m.scol = n0; m.WT = (bf16_t*)(F.ws + WS_W13); m.ldo = D; m.drow = (n0 >> 7) * 256 + (n0 & 127) + (mat == 0 ? 0 : 128); m.k0 = kb * 64; }
    else { const int nb = loc % 32, kb = loc / 32; m.W = F.ap->in[I_FW2]; m.ldw = D; m.scol = nb * 32; m.WT = (bf16_t*)(F.ws + WS_W2); m.ldo = FFN; m.drow = nb * 32; m.k0 = kb * 64; }
    return m;
}
__device__ __forceinline__ ConvItem moe2_item(Frame& F, int it) {
    ConvItem m; const int e = it / 1792, loc = it % 1792, nb = loc % 32, kb = loc / 32;
    m.W = F.ap->in[I_MW2] + (size_t)e * FFN * D; m.ldw = D; m.scol = nb * 32; m.WT = (bf16_t*)(F.ws + WS_MW2) + (size_t)e * D * FFN; m.ldo = FFN; m.drow = nb * 32; m.k0 = kb * 64; return m;
}
template <int SET>
__device__ __forceinline__ void bg_drain(Frame& F) {
    constexpr int NITEMS = SET == 1 ? 8320 : (SET == 2 ? 5248 : 14336), NBLK = NITEMS / 8;
    LAS float* scr = (LAS float*)(F.lds + F.wave * 16384);
    volatile LAS unsigned* slot = (volatile LAS unsigned*)(F.lds + LDS_MISC + 64);
    float ra[32];
    int lane = F.lane; asm volatile("" : "+v"(lane));
    for (;;) {
        __syncthreads();
        if (F.tid == 0) slot[0] = __hip_atomic_fetch_add(F.ctl + CW_WQ + 64 * (3 + SET), 1u, __ATOMIC_RELAXED, __HIP_MEMORY_SCOPE_AGENT);
        __syncthreads();
        const int blk = (int)slot[0]; if (blk >= NBLK) break;
        const int it = blk * 8 + F.wave; ConvItem m;
        if (SET == 1) m = it < 2944 ? small_item(F, 0, 2304 + it) : ffn_item(F, it - 2944); else if (SET == 2) m = small_item(F, 1, it); else m = moe2_item(F, it);
        tr_load(m.W, m.ldw, m.scol, m.k0, lane, ra); tr_store(ra, m.WT, m.ldo, m.drow, m.k0, scr, lane);
    }
    __syncthreads();
}

__device__ __forceinline__ void phase_pre(Frame& F) {
    { const int gw = F.c * 8 + F.wave, NGW = F.G * 8; LAS float* scr = (LAS float*)(F.lds + F.wave * 16384); float ra[32];
        for (int it = gw; it < 2304; it += NGW) { const ConvItem m = small_item(F, 0, it); tr_load(m.W, m.ldw, m.scol, m.k0, F.lane, ra); tr_store(ra, m.WT, m.ldo, m.drow, m.k0, scr, F.lane); } }
    __syncthreads();
    const size_t gt = (size_t)F.c * NTHREADS + F.tid, NT = (size_t)F.G * NTHREADS;
    for (size_t t = gt; t < (size_t)2 * 2 * 256 * 128; t += NT) {
        const int k8 = (int)(t & 127), n = (int)((t >> 7) & 255), dir = (int)((t >> 15) & 1), l = (int)(t >> 16);
        const float* win = F.ap->in[I_WIN] + (size_t)l * D * N_IN + 3584 + 16 * dir; const float* up = F.ap->in[I_GUP] + (size_t)((l * 2 + dir) * 16) * 256 + n;
        float upv[16];
#pragma unroll
        for (int r = 0; r < 16; ++r) upv[r] = up[r * 256];
        float v[8];
#pragma unroll
        for (int j = 0; j < 8; ++j) { const float* wr = win + (size_t)(k8 * 8 + j) * N_IN; float s = 0.f;
#pragma unroll
            for (int r = 0; r < 16; ++r) s += wr[r] * upv[r];
            v[j] = s; }
        *(u32x4*)((bf16_t*)(F.ws + WS_WMIX) + ((size_t)l * NMIX + 3584 + 256 * dir + n) * D + k8 * 8) = epi::pack8(v);
    }
    {
        LAS float* cond = (LAS float*)F.lds;
        for (int u = F.tid; u < 5 * 1024; u += NTHREADS) { const int b = u >> 10, k = u & 1023; const float c = b < 4 ? F.ap->in[I_C][b * 1024 + k] : F.ap->in[I_CCTX][k]; cond[u] = fsilu(c); }
        __syncthreads();
        float* modacc = (float*)(F.ctl + CW_MOD);
        LAS float* red = cond + 5 * 1024;
        for (int blk = F.c; blk < 256; blk += F.G) {
            const int l = blk >> 7, col0 = (blk & 127) * 48;
            if (F.tid < 384) { const int cj = F.tid % 48, ks = F.tid / 48;
                const float* w = F.ap->in[I_ADAW] + (size_t)l * D * 6144 + (size_t)(ks * 128) * 6144 + col0 + cj; float a[5] = {0.f, 0.f, 0.f, 0.f, 0.f};
                for (int k0 = 0; k0 < 128; k0 += 32) { float wv[32];
#pragma unroll
                    for (int k = 0; k < 32; ++k) wv[k] = w[(size_t)(k0 + k) * 6144];
#pragma unroll
                    for (int k = 0; k < 32; ++k)
#pragma unroll
                        for (int b = 0; b < 5; ++b) a[b] += cond[b * 1024 + ks * 128 + k0 + k] * wv[k]; }
#pragma unroll
                for (int b = 0; b < 5; ++b) red[(ks * 48 + cj) * 5 + b] = a[b]; }
            __syncthreads();
            if (F.tid < 240) { const int cj = F.tid % 48, b = F.tid / 48; float sacc = 0.f;
#pragma unroll
                for (int ks = 0; ks < 8; ++ks) sacc += red[(ks * 48 + cj) * 5 + b];
                modacc[(l * 5 + b) * 6144 + col0 + cj] = sacc; }
            __syncthreads();
        }
        __syncthreads();
    }
    if (F.c == 0) { float* lbp = (float*)(F.ctl + CW_LB);
        for (int ch = F.tid; ch < 512; ch += NTHREADS) { const float l0 = F.ap->in[I_LBL][ch], l1 = F.ap->in[I_LBL][512 + ch];
            lbp[ch] = 0.f; lbp[1024 + ch] = 1.0f;
            lbp[512 + ch] = fsigmoid(l1 - l0); lbp[1024 + 512 + ch] = fsigmoid(l0 - l1); } }
    { float* PT = (float*)(F.ctl + CW_POS);
        for (size_t t = gt; t < (size_t)64 * 512; t += NT) { const int pp = (int)(t >> 9), q = (int)(t & 511), i = q & 255; const float om = exp2f(-(float)i * (13.287712379549449f / 256.0f)), a = (float)pp * om; PT[t] = q < 256 ? sinf(a) : cosf(a); } }
    s5_tables(F);
}

template <int MODE>
__device__ __forceinline__ void norm_load(Frame& F, int row, f32x4 (&v)[4]) {
    const int lane = F.lane; const float* XW = (const float*)(F.ws + WS_XW);
    if (MODE == 0) {
        if (row < MCTX) {
#pragma unroll
            for (int j = 0; j < 4; ++j) v[j] = *(const f32x4*)(F.ap->in[I_CTX] + (size_t)row * D + 4 * lane + 256 * j);
        } else { const int rl = row - MCTX;
#pragma unroll
            for (int j = 0; j < 4; ++j) v[j] = *(const f32x4*)(F.ap->in[I_X] + (size_t)rl * D + 4 * lane + 256 * j); }
    } else {
#pragma unroll
        for (int j = 0; j < 4; ++j) v[j] = *(const f32x4*)(XW + (size_t)row * D + 4 * lane + 256 * j);
    }
}
template <int MODE>
__device__ __forceinline__ void norm_finish(Frame& F, int row, f32x4 (&v)[4]) {
    const int bidx = row < MCTX ? 4 : ((row - MCTX) >> 12); const LAS float* GA = (const LAS float*)F.lds + bidx * 2048;
    float* XW = (float*)(F.ws + WS_XW); bf16_t* H = (bf16_t*)(F.ws + WS_H);
    const int lane = F.lane;
    if (MODE == 0) {
        if (row >= MCTX) { const int rl = row - MCTX, t = rl & 4095; const float* PT = (const float*)(F.ctl + CW_POS);
#pragma unroll
            for (int j = 0; j < 4; ++j) v[j] = v[j] + *(const f32x4*)(PT + ((j < 2 ? (t >> 6) : (t & 63)) * 512 + (j & 1) * 256 + 4 * lane)); }
#pragma unroll
        for (int j = 0; j < 4; ++j) *(f32x4*)(XW + (size_t)row * D + 4 * lane + 256 * j) = v[j];
    }
    float ss = 0.f;
#pragma unroll
    for (int j = 0; j < 4; ++j) ss += (v[j][0] * v[j][0] + v[j][1] * v[j][1]) + (v[j][2] * v[j][2] + v[j][3] * v[j][3]);
    const float rstd = 1.0f / sqrtf(wave_sum(ss) * (1.0f / D) + EPS);
    float lg[8];
#pragma unroll
    for (int e = 0; e < 8; ++e) lg[e] = 0.f;
#pragma unroll
    for (int j = 0; j < 4; ++j) { const int d0 = 4 * lane + 256 * j;
        const f32x4 h = (v[j] * rstd) * *(const LAS f32x4*)(GA + d0) + *(const LAS f32x4*)(GA + 1024 + d0);
        u32x2 w; w.x = pk2(h[0], h[1]); w.y = pk2(h[2], h[3]);
        *(u32x2*)(H + (size_t)row * D + d0) = w;
        if (MODE == 2) {
#pragma unroll
            for (int e = 0; e < 4; ++e) { const f32x4 r0v = *(const f32x4*)(F.ap->in[I_RW] + (size_t)(d0 + e) * 8), r1v = *(const f32x4*)(F.ap->in[I_RW] + (size_t)(d0 + e) * 8 + 4);
                lg[0] += h[e] * r0v[0]; lg[1] += h[e] * r0v[1]; lg[2] += h[e] * r0v[2]; lg[3] += h[e] * r0v[3]; lg[4] += h[e] * r1v[0]; lg[5] += h[e] * r1v[1]; lg[6] += h[e] * r1v[2]; lg[7] += h[e] * r1v[3]; } }
    }
    if (MODE == 2) {
#pragma unroll
        for (int e = 0; e < 8; ++e) lg[e] = wave_sum(lg[e]);
        if (lane == 0) {
            int i1 = 0; float m1 = lg[0];
#pragma unroll
            for (int e = 1; e < 8; ++e) if (lg[e] > m1) { m1 = lg[e]; i1 = e; }
            int i2 = -1; float m2 = -3.0e38f;
#pragma unroll
            for (int e = 0; e < 8; ++e) if (e != i1 && lg[e] > m2) { m2 = lg[e]; i2 = e; }
            const float w1 = 1.0f / (1.0f + __expf(m2 - m1)), w2 = 1.0f - w1;
            const int tok = row - MCTX;
            const int rk1 = (int)atomicAdd(F.ctl + CW_MOECNT + 64 * i1, 1u), rk2 = (int)atomicAdd(F.ctl + CW_MOECNT + 64 * i2, 1u);
            int* te = (int*)(F.ctl + CW_TOKE); int* tr = (int*)(F.ctl + CW_TOKR); float* tw = (float*)(F.ctl + CW_TOKW);
            te[tok * 2] = i1; te[tok * 2 + 1] = i2; tr[tok * 2] = rk1; tr[tok * 2 + 1] = rk2; tw[tok * 2] = w1; tw[tok * 2 + 1] = w2;
            int* pm2 = (int*)(F.ctl + CW_PERM2); pm2[i1 * 16384 + rk1] = tok; pm2[i2 * 16384 + rk2] = tok;
        }
    }
}
template <int MODE>
__device__ __forceinline__ void norm_rows(Frame& F, int l, int moff  , const float* gain) {
    const float* modacc = (const float*)(F.ctl + CW_MOD) + (size_t)l * 5 * 6144; const float* adab = F.ap->in[I_ADAB] + (size_t)l * 6144;
    LAS float* GA = (LAS float*)F.lds;
    for (int u = F.tid; u < 5 * 1024; u += NTHREADS) { const int b = u >> 10, dd = u & 1023;
        const float sh = modacc[b * 6144 + moff + dd] + adab[moff + dd], sc = modacc[b * 6144 + moff + 1024 + dd] + adab[moff + 1024 + dd];
        GA[b * 2048 + dd] = gain[dd] * (sc + 1.0f); GA[b * 2048 + 1024 + dd] = sh; }
    __syncthreads();
    const int gw = F.c * 8 + F.wave, NGW = F.G * 8;
    const int r0 = MODE == 2 ? MCTX : 0;
    for (int row = r0 + gw; row < M; row += 2 * NGW) {
        const int rowB = row + NGW; const bool hasB = rowB < M;
        f32x4 va[4], vb[4];
        norm_load<MODE>(F, row, va);
        if (hasB) norm_load<MODE>(F, rowB, vb);
        norm_finish<MODE>(F, row, va);
        if (hasB) norm_finish<MODE>(F, rowB, vb);
    }
    __syncthreads();
}

struct MoeSeg { int cnt[NE], tstart[NE + 1]; };
__device__ __forceinline__ void moe_seg(Frame& F, MoeSeg& s) {
    int acc = 0;
#pragma unroll
    for (int e = 0; e < NE; ++e) { const int c = (int)__hip_atomic_load(F.ctl + CW_MOECNT + 64 * e, __ATOMIC_RELAXED, __HIP_MEMORY_SCOPE_AGENT); s.cnt[e] = c; s.tstart[e] = acc; acc += (c + 255) >> 8; }
    s.tstart[NE] = acc;
}
__device__ __forceinline__ void moe_scatter(Frame& F) {
    MoeSeg s; moe_seg(F, s);
    const int* te = (const int*)(F.ctl + CW_TOKE); const int* tr = (const int*)(F.ctl + CW_TOKR); int* perm = (int*)(F.ctl + CW_PERM);
    for (int t = F.c * NTHREADS + F.tid; t < 2 * MLAT; t += F.G * NTHREADS) { const int e = te[t], rk = tr[t]; int ts = 0;
#pragma unroll
        for (int k = 0; k < NE; ++k) ts = (e == k) ? s.tstart[k] : ts;
        perm[ts * 256 + rk] = t >> 1; }
}
struct MoeItem { const float* W; bf16_t* WT; int ldw, scol, K, drow, k0; };
__device__ __forceinline__ MoeItem moe_item(Frame& F, int it) {
    const int job = it / 1792, loc = it % 1792, e = job / 2, mat = job % 2; MoeItem m;
    if (mat < 2) { const int nb = loc % 112, kb = loc / 112, n0 = nb * 32; m.W = F.ap->in[mat == 0 ? I_MW1 : I_MW3] + (size_t)e * D * FFN; m.ldw = FFN; m.scol = n0; m.K = D; m.k0 = kb * 64;
        m.WT = (bf16_t*)(F.ws + WS_MW13) + (size_t)e * 7168 * D; m.drow = (n0 >> 7) * 256 + (n0 & 127) + (mat == 0 ? 0 : 128); }
    else { const int nb = loc % 32, kb = loc / 32; m.W = F.ap->in[I_MW2] + (size_t)e * FFN * D; m.ldw = D; m.scol = nb * 32; m.K = FFN; m.k0 = kb * 64; m.WT = (bf16_t*)(F.ws + WS_MW2) + (size_t)e * D * FFN; m.drow = nb * 32; }
    return m;
}
__device__ __forceinline__ void moe_convert(Frame& F) {
    const int gw = F.c * 8 + F.wave, NGW = F.G * 8, nitems = NE * 2 * 1792;
    LAS float* scr = (LAS float*)(F.lds + F.wave * 16384);
    float ra[32], rb[32];
    int it = gw;
    if (it < nitems) { const MoeItem m = moe_item(F, it); tr_load(m.W, m.ldw, m.scol, m.k0, F.lane, ra); }
    while (it < nitems) {
        const int nx = it + NGW;
        if (nx < nitems) { const MoeItem m = moe_item(F, nx); tr_load(m.W, m.ldw, m.scol, m.k0, F.lane, rb); }
        { const MoeItem m = moe_item(F, it); tr_store(ra, m.WT, m.K, m.drow, m.k0, scr, F.lane); }
        it = nx;
        if (it >= nitems) break;
        const int nx2 = it + NGW;
        if (nx2 < nitems) { const MoeItem m = moe_item(F, nx2); tr_load(m.W, m.ldw, m.scol, m.k0, F.lane, ra); }
        { const MoeItem m = moe_item(F, it); tr_store(rb, m.WT, m.K, m.drow, m.k0, scr, F.lane); }
        it = nx2;
    }
    __syncthreads();
}
__device__ __forceinline__ void phase_final(Frame& F) {
    MoeSeg s; moe_seg(F, s);
    const float* XW = (const float*)(F.ws + WS_XW); const bf16_t* SL = (const bf16_t*)(F.ws + WS_SLAB);
    const float* modacc = (const float*)(F.ctl + CW_MOD) + (size_t)1 * 5 * 6144; const float* adab = F.ap->in[I_ADAB] + (size_t)1 * 6144;
    const int* te = (const int*)(F.ctl + CW_TOKE); const int* tr = (const int*)(F.ctl + CW_TOKR); const float* tw = (const float*)(F.ctl + CW_TOKW);
    const int gw = F.c * 8 + F.wave, NGW = F.G * 8, lane = F.lane;
    for (int tok = gw; tok < MLAT; tok += NGW) {
        const int row = MCTX + tok, bidx = tok >> 12; int pos[2];
#pragma unroll
        for (int sl = 0; sl < 2; ++sl) { const int e = __hip_atomic_load(te + tok * 2 + sl, __ATOMIC_RELAXED, __HIP_MEMORY_SCOPE_AGENT); int ts = 0;
#pragma unroll
            for (int k = 0; k < NE; ++k) ts = (e == k) ? s.tstart[k] : ts;
            pos[sl] = ts * 256 + __hip_atomic_load(tr + tok * 2 + sl, __ATOMIC_RELAXED, __HIP_MEMORY_SCOPE_AGENT); }
        const float w0 = __hip_atomic_load(tw + tok * 2, __ATOMIC_RELAXED, __HIP_MEMORY_SCOPE_AGENT), w1 = __hip_atomic_load(tw + tok * 2 + 1, __ATOMIC_RELAXED, __HIP_MEMORY_SCOPE_AGENT);
        f32x4 v[4]; float ss = 0.f;
#pragma unroll
        for (int j = 0; j < 4; ++j) { const int d0 = 4 * lane + 256 * j;
            const f32x4 g2 = *(const f32x4*)(modacc + bidx * 6144 + 5120 + d0) + *(const f32x4*)(adab + 5120 + d0);
            const u32x2 a = *(const u32x2*)(SL + (size_t)pos[0] * D + d0), b = *(const u32x2*)(SL + (size_t)pos[1] * D + d0);
            f32x4 fa, fb; fa[0] = __uint_as_float(a.x << 16); fa[1] = __uint_as_float(a.x & 0xffff0000u); fa[2] = __uint_as_float(a.y << 16); fa[3] = __uint_as_float(a.y & 0xffff0000u);
            fb[0] = __uint_as_float(b.x << 16); fb[1] = __uint_as_float(b.x & 0xffff0000u); fb[2] = __uint_as_float(b.y << 16); fb[3] = __uint_as_float(b.y & 0xffff0000u);
            v[j] = *(const f32x4*)(XW + (size_t)row * D + d0) + g2 * (fa * w0 + fb * w1);
            ss += (v[j][0] * v[j][0] + v[j][1] * v[j][1]) + (v[j][2] * v[j][2] + v[j][3] * v[j][3]); }
        const float rstd = 1.0f / sqrtf(wave_sum(ss) * (1.0f / D) + EPS);
#pragma unroll
        for (int j = 0; j < 4; ++j) { const int d0 = 4 * lane + 256 * j; *(f32x4*)(F.ap->out + (size_t)tok * D + d0) = (v[j] * rstd) * *(const f32x4*)(F.ap->in[I_FNG] + d0); }
    }
}
constexpr int ML_QA = 0, ML_KA = 8704, ML_KBX = 17408, ML_KT = 21760, ML_VT = 32000, ML_AS = 42240, ML_PS = 44800, ML_EL = 46848, ML_E15 = 47360, ML_FLAG = 47872, ML_BC = 47888, ML_STG = 65296, ML_OS = 90896;
static_assert(ML_OS + 65536 <= LDS_MISC, "mixer LDS");


template <int NV> __device__ __forceinline__ void bfly_step(float (&a)[32], int lane, int xb) {
    const bool hi = (lane & xb) != 0;
#pragma unroll
    for (int i = 0; i < NV / 2; ++i) { const float keep = hi ? a[NV / 2 + i] : a[i], send = hi ? a[i] : a[NV / 2 + i]; a[i] = keep + __shfl_xor(send, xb); }
}

__device__ __forceinline__ int sc_row(int r0, int n, int dir) { return dir == 0 ? r0 + n : r0 + 255 - n; }

template <int DK, bool HG, bool OUT> struct Stg {
    static constexpr int KOFF = DK, VOFF = HG ? DK : 2 * DK, QOFF = VOFF + 128, SW = OUT ? QOFF + DK : QOFF, SWP = SW, NPC = SW / 8, NLD = (32 * NPC + NTHREADS - 1) / NTHREADS;
};
template <int DK, bool HG, bool OUT> struct ChunkIn { int unused; };
template <int DK, bool HG, bool OUT>
__device__ __forceinline__ void gla_load(Frame& F, const bf16_t* P, int r0, int c, int dir, int qcol, int gcol, int kcol, int vcol, ChunkIn<DK, HG, OUT>&) {
    typedef Stg<DK, HG, OUT> G;
#pragma unroll
    for (int j = 0; j < G::NLD; ++j) { const int pid = F.tid + NTHREADS * j;
        if (G::NLD * NTHREADS == 32 * G::NPC || F.wave * 64 + NTHREADS * j < 32 * G::NPC) {
            const int tau = pid / G::NPC, c8 = (pid % G::NPC) * 8;
            const int col = c8 < DK ? gcol + c8 : ((!HG && c8 < G::VOFF) ? kcol + c8 - G::KOFF : (c8 < G::QOFF ? vcol + c8 - G::VOFF : qcol + c8 - G::QOFF));
            __builtin_amdgcn_global_load_lds((const unsigned*)(P + (size_t)sc_row(r0, 32 * c + tau, dir) * LDP + col), (LAS unsigned*)(F.lds + ML_STG + (F.wave * 64 + NTHREADS * j) * 16), 16, 0, 0); } }
}
template <int DK, bool HG, bool OUT>
__device__ __forceinline__ void gla_stage(Frame& F, const ChunkIn<DK, HG, OUT>&) { asm volatile("s_waitcnt vmcnt(0)" ::: "memory"); }
template <int DK, bool HG, bool OUT, int VAR = 0>
__device__ __forceinline__ void gla_chunk(Frame& F, const bf16_t* P, ChunkIn<DK, HG, OUT>& N, bool have_next, int nr0, int nc, int ndir, int c, int dir, int qcol, int gcolf, int gcolb, int kcol, int vcol,
                                          f32x4 (&S)[DK / 16], float& gtot) {
    typedef Stg<DK, HG, OUT> G;
    LAS unsigned char* lds = F.lds;
    LAS float* BC = (LAS float*)(lds + ML_BC); LAS bf16_t* QA = (LAS bf16_t*)(lds + ML_QA); LAS bf16_t* KA = (LAS bf16_t*)(lds + ML_KA); LAS bf16_t* KBX = (LAS bf16_t*)(lds + ML_KBX); LAS bf16_t* STG = (LAS bf16_t*)(lds + ML_STG);
    LAS float* E15 = (LAS float*)(lds + ML_E15); volatile LAS unsigned* FLAG = (volatile LAS unsigned*)(lds + ML_FLAG);
    LAS unsigned char* KT = lds + ML_KT; LAS unsigned char* VT = lds + ML_VT; LAS unsigned char* AS = lds + ML_AS; LAS float* PS = (LAS float*)(lds + ML_PS); LAS float* EL = (LAS float*)(lds + ML_EL);
    LAS bf16_t* OS = (LAS bf16_t*)(lds + ML_OS);
    constexpr int NT = DK / 16, NPART = NTHREADS / DK, HS = DK + 8;
    const int tid = F.tid, lane = F.lane, w = F.wave;
    const int d = tid & (DK - 1), part = tid / DK, t0 = part * NT;
    float cs[NT], gg[NT], qq[NT], kk[NT];
    float off = 0.f, tot = 0.f, ref15 = 0.f;
    if (VAR != 4) {
#pragma unroll
        for (int pp = 0; pp < NPART; ++pp) { float ps = 0.f;
#pragma unroll
            for (int i = 0; i < NT; ++i) ps += bf2f(STG[(pp * NT + i) * G::SWP + d]);
            tot += ps; off += (pp < part) ? ps : 0.f; if (pp * NT < 16) ref15 += ps; }
        float run = 0.f;
#pragma unroll
        for (int i = 0; i < NT; ++i) { const LAS bf16_t* rp = STG + (t0 + i) * G::SWP;
            gg[i] = bf2f(rp[d]); if (OUT) qq[i] = bf2f(rp[G::QOFF + d]); if (!HG) kk[i] = bf2f(rp[G::KOFF + d]);
            run += gg[i]; cs[i] = run; }
        if (OUT && tid == 0) FLAG[(c + 1) & 1] = 0u;
        const int v = tid & 127, pv = tid >> 7; unsigned short vb[8];
#pragma unroll
        for (int i = 0; i < 8; ++i) vb[i] = STG[(8 * pv + i) * G::SWP + G::VOFF + v];
        u32x4 wv; wv.x = vb[0] | ((unsigned)vb[1] << 16); wv.y = vb[2] | ((unsigned)vb[3] << 16); wv.z = vb[4] | ((unsigned)vb[5] << 16); wv.w = vb[6] | ((unsigned)vb[7] << 16);
        *(LAS u32x4*)(VT + v * 80 + pv * 16) = wv;
    }
    float bcv[NT], kq[NT];
    if (VAR < 4) {
        float kh[NT];
        bool big = false;
        const float c0 = __expf(tot), c1 = __expf(tot - ref15), e15 = __expf(ref15);
        float qa[NT], ka[NT], kx[NT];
#pragma unroll
        for (int i = 0; i < NT; ++i) { const float bc = off + cs[i], f = __expf(gg[i]), k = HG ? 1.0f - f : kk[i]; const int tau = t0 + i; bcv[i] = bc; kq[i] = k;
            const bool hi = tau >= 16; const float X = (hi ? ref15 : 0.f) - bc;
            const float eX = __expf(fminf(X, 80.f)); ka[i] = k * eX;
            big |= X > 80.f;
            if (OUT && VAR < 2) { qa[i] = qq[i] * __builtin_amdgcn_rcpf(eX); kx[i] = ka[i] * e15; }
            kh[i] = ka[i] * (hi ? c1 : c0); }
        if (big) {
#pragma unroll
            for (int i = 0; i < NT; ++i) kh[i] = kq[i] * __expf(tot - bcv[i]); }
        if (OUT && VAR < 2) {
#pragma unroll
            for (int i = 0; i < NT; i += 2) { const int tau = t0 + i; const unsigned wq = pk2(qa[i], qa[i + 1]), wk2 = pk2(ka[i], ka[i + 1]);
                QA[tau * HS + d] = (bf16_t)(wq & 0xffffu); QA[(tau + 1) * HS + d] = (bf16_t)(wq >> 16); KA[tau * HS + d] = (bf16_t)(wk2 & 0xffffu); KA[(tau + 1) * HS + d] = (bf16_t)(wk2 >> 16);
                if (tau < 16) { const unsigned wx = pk2(kx[i], kx[i + 1]); KBX[tau * HS + d] = (bf16_t)(wx & 0xffffu); KBX[(tau + 1) * HS + d] = (bf16_t)(wx >> 16); } } }
        if (NT == 8) { u32x4 wk; wk.x = pk2(kh[0], kh[1]); wk.y = pk2(kh[2], kh[3]); wk.z = pk2(kh[4 % NT], kh[5 % NT]); wk.w = pk2(kh[6 % NT], kh[7 % NT]); *(LAS u32x4*)(KT + d * 80 + t0 * 2) = wk; }
        else { u32x2 wk; wk.x = pk2(kh[0], kh[1]); wk.y = pk2(kh[2], kh[3]); *(LAS u32x2*)(KT + d * 80 + t0 * 2) = wk; }
        if (OUT && big) FLAG[c & 1] = 1u;
        if (OUT && part == 0) E15[d] = __expf(ref15);
        if (part == 0) { EL[d] = __expf(tot); gtot += tot; }
    }
    __syncthreads();
    bool slow = false;
    if (OUT) slow = __builtin_amdgcn_readfirstlane((int)FLAG[c & 1]) != 0;
    if (OUT && slow) {
#pragma unroll
        for (int i = 0; i < NT; ++i) { const int tau = t0 + i; BC[tau * HS + d] = bcv[i] * 1.4426950408889634f; }
        __syncthreads();
        const int g4 = lane >> 4, r = lane & 15;
        for (int job = w; job < 11; job += 8) {
            const int lvl = job == 0 ? 4 : 3 - ((job - 1) >> 1), tt = job == 0 ? 1 : ((job - 1) & 1), ss = job == 0 ? 0 : tt;
            const int t = 16 * tt + r, sx = 16 * ss + r;
            bool va = true, vb = true; int reft = t, refs = sx;
            if (lvl >= 0) { const int bsz = 2 << lvl, hb = 1 << lvl; va = ((t >> lvl) & 1) != 0; vb = ((sx >> lvl) & 1) == 0; reft = (t & ~(bsz - 1)) + hb - 1; refs = (sx & ~(bsz - 1)) + hb - 1; }
            f32x4 acc = (f32x4){0.f, 0.f, 0.f, 0.f};
#pragma unroll
            for (int kk2 = 0; kk2 < DK / 32; ++kk2) { const int d0 = 32 * kk2 + 8 * g4;
                float qv[8], kv[8]; epi::unpack8(*(const LAS u32x4*)(STG + t * G::SWP + G::QOFF + d0), qv);
                if (HG) { epi::unpack8(*(const LAS u32x4*)(STG + sx * G::SWP + d0), kv);
#pragma unroll
                    for (int j = 0; j < 8; ++j) kv[j] = 1.0f - __expf(kv[j]); }
                else epi::unpack8(*(const LAS u32x4*)(STG + sx * G::SWP + G::KOFF + d0), kv);
                if (lvl >= 0) {
                    const f32x4 bt0 = *(const LAS f32x4*)(BC + t * HS + d0), bt1 = *(const LAS f32x4*)(BC + t * HS + d0 + 4), br0 = *(const LAS f32x4*)(BC + reft * HS + d0), br1 = *(const LAS f32x4*)(BC + reft * HS + d0 + 4);
                    const f32x4 bs0 = *(const LAS f32x4*)(BC + sx * HS + d0), bs1 = *(const LAS f32x4*)(BC + sx * HS + d0 + 4), bq0 = *(const LAS f32x4*)(BC + refs * HS + d0), bq1 = *(const LAS f32x4*)(BC + refs * HS + d0 + 4);
#pragma unroll
                    for (int j = 0; j < 4; ++j) { qv[j] = va ? qv[j] * __builtin_amdgcn_exp2f(bt0[j] - br0[j]) : 0.f; qv[4 + j] = va ? qv[4 + j] * __builtin_amdgcn_exp2f(bt1[j] - br1[j]) : 0.f;
                        kv[j] = vb ? kv[j] * __builtin_amdgcn_exp2f(bq0[j] - bs0[j]) : 0.f; kv[4 + j] = vb ? kv[4 + j] * __builtin_amdgcn_exp2f(bq1[j] - bs1[j]) : 0.f; }
                }
                const u32x4 af = epi::pack8(qv), bf = epi::pack8(kv);
                acc = __builtin_amdgcn_mfma_f32_16x16x32_bf16(__builtin_bit_cast(bf16x8, af), __builtin_bit_cast(bf16x8, bf), acc, 0, 0, 0);
            }
#pragma unroll
            for (int i = 0; i < 4; ++i) { const int to = 16 * tt + 4 * g4 + i, so = 16 * ss + r;
                bool valid; if (lvl >= 0) valid = (((to ^ so) >> (lvl + 1)) == 0) && (((to >> lvl) & 1) != 0) && (((so >> lvl) & 1) == 0); else valid = (to == so);
                if (valid) *(LAS bf16_t*)(AS + to * 80 + so * 2) = (bf16_t)f2bf(acc[i]);
                else if (lvl < 0 && so > to) *(LAS bf16_t*)(AS + to * 80 + so * 2) = (bf16_t)0;
                if (job == 0) *(LAS bf16_t*)(AS + (4 * g4 + i) * 80 + (16 + r) * 2) = (bf16_t)0;
            }
        }
        __syncthreads();
    }
    if (have_next && VAR < 4) gla_load<DK, HG, OUT>(F, P, nr0, nc, ndir, qcol, ndir == 0 ? gcolf : gcolb, kcol, vcol, N);
    {
        const int g4 = lane >> 4, r = lane & 15;
        const bf16x8 bV = *(const LAS bf16x8*)(VT + (16 * w + r) * 80 + g4 * 16);
        if (OUT && VAR < 1) {
            f32x4 o[2];
            if (!slow) {
                f32x4 t00 = (f32x4){0.f, 0.f, 0.f, 0.f}, t01 = t00, t11 = t00;
#pragma unroll
                for (int kk2 = 0; kk2 < DK / 32; ++kk2) { const int d0 = 32 * kk2 + 8 * g4;
                    const bf16x8 q0 = *(const LAS bf16x8*)(QA + r * HS + d0), q1 = *(const LAS bf16x8*)(QA + (16 + r) * HS + d0);
                    const bf16x8 k0 = *(const LAS bf16x8*)(KA + r * HS + d0), k1 = *(const LAS bf16x8*)(KA + (16 + r) * HS + d0), kx = *(const LAS bf16x8*)(KBX + r * HS + d0);
                    t00 = __builtin_amdgcn_mfma_f32_16x16x32_bf16(k0, q0, t00, 0, 0, 0); t01 = __builtin_amdgcn_mfma_f32_16x16x32_bf16(kx, q1, t01, 0, 0, 0); t11 = __builtin_amdgcn_mfma_f32_16x16x32_bf16(k1, q1, t11, 0, 0, 0); }
#pragma unroll
                for (int i = 0; i < 4; ++i) { const bool keep = (4 * g4 + i) <= r; t00[i] = keep ? t00[i] : 0.f; t11[i] = keep ? t11[i] : 0.f; }
                u32x4 a0, a1; a0.x = pk2(t00[0], t00[1]); a0.y = pk2(t00[2], t00[3]); a0.z = 0u; a0.w = 0u; a1.x = pk2(t01[0], t01[1]); a1.y = pk2(t01[2], t01[3]); a1.z = pk2(t11[0], t11[1]); a1.w = pk2(t11[2], t11[3]);
                const u32x2 vlo = *(const LAS u32x2*)(VT + (16 * w + r) * 80 + 8 * g4), vhi = *(const LAS u32x2*)(VT + (16 * w + r) * 80 + 32 + 8 * g4);
                u32x4 vp; vp.x = vlo.x; vp.y = vlo.y; vp.z = vhi.x; vp.w = vhi.y;
                o[0] = __builtin_amdgcn_mfma_f32_16x16x32_bf16(__builtin_bit_cast(bf16x8, a0), __builtin_bit_cast(bf16x8, vp), (f32x4){0.f, 0.f, 0.f, 0.f}, 0, 0, 0);
                o[1] = __builtin_amdgcn_mfma_f32_16x16x32_bf16(__builtin_bit_cast(bf16x8, a1), __builtin_bit_cast(bf16x8, vp), (f32x4){0.f, 0.f, 0.f, 0.f}, 0, 0, 0);
            } else {
#pragma unroll
                for (int tt = 0; tt < 2; ++tt) { const bf16x8 aS = *(const LAS bf16x8*)(AS + (16 * tt + r) * 80 + g4 * 16); o[tt] = __builtin_amdgcn_mfma_f32_16x16x32_bf16(aS, bV, (f32x4){0.f, 0.f, 0.f, 0.f}, 0, 0, 0); }
            }
#pragma unroll
            for (int kk2 = 0; kk2 < DK / 32; ++kk2) {
                const f32x4 e0 = *(const LAS f32x4*)(E15 + 32 * kk2 + 4 * g4), e1 = *(const LAS f32x4*)(E15 + 32 * kk2 + 16 + 4 * g4);
                u32x4 bs, bs2; bs.x = pk2(S[2 * kk2][0], S[2 * kk2][1]); bs.y = pk2(S[2 * kk2][2], S[2 * kk2][3]); bs.z = pk2(S[2 * kk2 + 1][0], S[2 * kk2 + 1][1]); bs.w = pk2(S[2 * kk2 + 1][2], S[2 * kk2 + 1][3]);
                bs2.x = pk2(S[2 * kk2][0] * e0[0], S[2 * kk2][1] * e0[1]); bs2.y = pk2(S[2 * kk2][2] * e0[2], S[2 * kk2][3] * e0[3]); bs2.z = pk2(S[2 * kk2 + 1][0] * e1[0], S[2 * kk2 + 1][1] * e1[1]); bs2.w = pk2(S[2 * kk2 + 1][2] * e1[2], S[2 * kk2 + 1][3] * e1[3]);
#pragma unroll
                for (int tt = 0; tt < 2; ++tt) { const u32x2 lo = *(const LAS u32x2*)(QA + (16 * tt + r) * HS + 32 * kk2 + 4 * g4), hi = *(const LAS u32x2*)(QA + (16 * tt + r) * HS + 32 * kk2 + 16 + 4 * g4);
                    u32x4 aq; aq.x = lo.x; aq.y = lo.y; aq.z = hi.x; aq.w = hi.y;
                    o[tt] = __builtin_amdgcn_mfma_f32_16x16x32_bf16(__builtin_bit_cast(bf16x8, aq), __builtin_bit_cast(bf16x8, tt == 0 ? bs : bs2), o[tt], 0, 0, 0); }
            }
#pragma unroll
            for (int tt = 0; tt < 2; ++tt)
#pragma unroll
                for (int i = 0; i < 4; ++i) { const int n = 32 * c + 16 * tt + 4 * g4 + i, nn = dir == 0 ? n : 255 - n; LAS bf16_t* op = OS + nn * 128 + 16 * w + r;
                    float val = o[tt][i]; if (dir == 1) val += bf2f(*op); *op = (bf16_t)f2bf(val); }
        }
#pragma unroll
        for (int dt = 0; dt < (VAR >= 3 ? 0 : DK / 16); ++dt) { const f32x4 el = *(const LAS f32x4*)(EL + 16 * dt + 4 * g4); const bf16x8 aK = *(const LAS bf16x8*)(KT + (16 * dt + r) * 80 + g4 * 16);
            S[dt] = __builtin_amdgcn_mfma_f32_16x16x32_bf16(aK, bV, S[dt] * el, 0, 0, 0); }
    }
    if (have_next && VAR < 4) gla_stage<DK, HG, OUT>(F, N);
    __syncthreads();
}

template <bool HG> struct MixCols {
    static __device__ __forceinline__ int q(int h) { return HG ? 128 * h : 2560 + 64 * h; }
    static __device__ __forceinline__ int g(int h, int dir) { return HG ? 512 + 512 * dir + 128 * h : 3584 + 256 * dir + 64 * h; }
    static __device__ __forceinline__ int k(int h) { return HG ? 0 : 2816 + 64 * h; }
    static __device__ __forceinline__ int v(int h) { return HG ? 1536 + 128 * h : 3072 + 128 * h; }
    static __device__ __forceinline__ int og(int h) { return HG ? 2048 + 128 * h : 4096 + 128 * h; }
};
__device__ __forceinline__ int sc_r0(int b, int sc) { return sc == 0 ? b * 256 : MCTX + b * 4096 + (sc - 1) * 256; }
__device__ __forceinline__ int sc_of_pos(int dir, int p) { return (dir == 0 || p == 0) ? p : 17 - p; }

template <int DK, bool HG>
__device__ __forceinline__ void gla_pass1_item(Frame& F, int b, int h, int dir, int p) {
    const bf16_t* P = (const bf16_t*)(F.ws + WS_P);
    constexpr int NDT = DK / 16, E = DK * 128;
    const int sc = sc_of_pos(dir, p), r0 = sc_r0(b, sc);
    float* ST = (float*)(F.ws + (HG ? WS_GST : WS_GST2)) + ((size_t)((b * 4 + h) * 2 + dir) * NSC + sc) * E;
    float* DEC = (float*)(F.ws + WS_GDEC) + (HG ? 0 : 4 * 4 * 2 * NSC * 128) + ((size_t)((b * 4 + h) * 2 + dir) * NSC + sc) * DK;
    f32x4 S[NDT];
#pragma unroll
    for (int i = 0; i < NDT; ++i) S[i] = (f32x4){0.f, 0.f, 0.f, 0.f};
    float gtot = 0.f;
    const int gcf = MixCols<HG>::g(h, 0), gcb = MixCols<HG>::g(h, 1), kc = MixCols<HG>::k(h), vc = MixCols<HG>::v(h);
    ChunkIn<DK, HG, false> N;
    gla_load<DK, HG, false>(F, P, r0, 0, dir, 0, dir == 0 ? gcf : gcb, kc, vc, N); gla_stage<DK, HG, false>(F, N); __syncthreads();
    for (int c = 0; c < 8; ++c) gla_chunk<DK, HG, false>(F, P, N, c < 7, r0, c + 1, dir, c, dir, 0, gcf, gcb, kc, vc, S, gtot);
#pragma unroll
    for (int dt = 0; dt < NDT; ++dt)
#pragma unroll
        for (int i = 0; i < 4; ++i) ST[((F.wave * NDT + dt) * 4 + i) * 64 + F.lane] = S[dt][i];
    if (F.tid < DK) DEC[F.tid] = __expf(gtot);
}
template <int DK, bool HG, int VAR = 0>
__device__ __forceinline__ void gla_pass3_item(Frame& F, int l, int b, int h, int sc) {
    const bf16_t* P = (const bf16_t*)(F.ws + WS_P); bf16_t* Y = (bf16_t*)(F.ws + WS_Y);
    constexpr int NDT = DK / 16, E = DK * 128;
    const int r0 = sc_r0(b, sc);
    const int qc = MixCols<HG>::q(h), gcf = MixCols<HG>::g(h, 0), gcb = MixCols<HG>::g(h, 1), kc = MixCols<HG>::k(h), vc = MixCols<HG>::v(h);
    ChunkIn<DK, HG, true> N;
    if (F.tid == 0) { volatile LAS unsigned* FLAG = (volatile LAS unsigned*)(F.lds + ML_FLAG); FLAG[0] = 0u; FLAG[1] = 0u; }
    gla_load<DK, HG, true>(F, P, r0, 0, 0, qc, gcf, kc, vc, N); gla_stage<DK, HG, true>(F, N); __syncthreads();
    for (int dir = 0; dir < 2; ++dir) {
        const float* ST = (const float*)(F.ws + (HG ? WS_GST : WS_GST2)) + ((size_t)((b * 4 + h) * 2 + dir) * NSC + sc) * E;
        f32x4 S[NDT];
#pragma unroll
        for (int dt = 0; dt < NDT; ++dt)
#pragma unroll
            for (int i = 0; i < 4; ++i) S[dt][i] = ST[((F.wave * NDT + dt) * 4 + i) * 64 + F.lane];
        float gtot = 0.f;
        for (int c = 0; c < 8; ++c) { const bool hn = !(dir == 1 && c == 7); const int nc = c < 7 ? c + 1 : 0, nd = c < 7 ? dir : 1;
            gla_chunk<DK, HG, true, VAR>(F, P, N, hn, r0, nc, nd, c, dir, qc, gcf, gcb, kc, vc, S, gtot); }
    }
    {
        const LAS bf16_t* OS = (const LAS bf16_t*)(F.lds + ML_OS);
        const int n = F.tid >> 1, hf = F.tid & 1; float o[64]; float ss = 0.f;
#pragma unroll
        for (int j = 0; j < 8; ++j) { float t8[8]; epi::unpack8(*(const LAS u32x4*)(OS + n * 128 + hf * 64 + j * 8), t8);
#pragma unroll
            for (int e = 0; e < 8; ++e) { o[j * 8 + e] = t8[e]; ss += t8[e] * t8[e]; } }
        ss += __shfl_xor(ss, 1);
        const float rstd = 1.0f / sqrtf(ss * (1.0f / 128.0f) + EPS);
        const float* gain = F.ap->in[HG ? I_HGNG : I_GLNG] + l * 512 + h * 128 + hf * 64;
        const bf16_t* og = P + (size_t)(r0 + n) * LDP + MixCols<HG>::og(h) + hf * 64;
        bf16_t* yo = Y + (size_t)(r0 + n) * 1536 + (HG ? 0 : 512) + h * 128 + hf * 64;
#pragma unroll
        for (int j = 0; j < 8; ++j) { float gt[8], v[8]; epi::unpack8(*(const u32x4*)(og + j * 8), gt);
#pragma unroll
            for (int e = 0; e < 8; ++e) v[e] = o[j * 8 + e] * rstd * gain[j * 8 + e] * gt[e];
            *(u32x4*)(yo + j * 8) = epi::pack8(v); }
    }
    __syncthreads();
}
__device__ __forceinline__ void gla_carry(Frame& F) {
    const size_t gt = (size_t)F.c * NTHREADS + F.tid, NTT = (size_t)F.G * NTHREADS;
    constexpr size_t EH = 16384, EG = 8192, NH = 32 * EH, NGL = 32 * EG;
    for (size_t t = gt; t < NH + NGL; t += NTT) {
        const bool hg = t < NH; const size_t tt = hg ? t : t - NH; const int E = hg ? (int)EH : (int)EG, DK = hg ? 128 : 64, NDT = DK / 16;
        const int chain = (int)(tt / E), e = (int)(tt % E), dir = chain & 1;
        const int ln = e & 63, i = (e >> 6) & 3, dt = (e >> 8) % NDT, dd = 16 * dt + 4 * (ln >> 4) + i;
        float* ST = (float*)(F.ws + (hg ? WS_GST : WS_GST2)) + (size_t)chain * NSC * E + e;
        const float* DEC = (const float*)(F.ws + WS_GDEC) + (hg ? 0 : 4 * 4 * 2 * NSC * 128) + (size_t)chain * NSC * DK + dd;
        float loc[16], dec[16];
#pragma unroll
        for (int p = 0; p < 16; ++p) { const int sc = sc_of_pos(dir, p); loc[p] = ST[(size_t)sc * E]; dec[p] = DEC[sc * DK]; }
        float S = 0.f;
#pragma unroll
        for (int p = 0; p < 16; ++p) { const int sc = sc_of_pos(dir, p); ST[(size_t)sc * E] = S; S = dec[p] * S + loc[p]; }
        ST[(size_t)sc_of_pos(dir, 16) * E] = S;
    }
}
__device__ __forceinline__ void s5_carry(Frame& F, int l) {
    const float* SL = (const float*)(F.ws + WS_SLOC); bf16_t* UG = (bf16_t*)(F.ws + WS_UG); const float* PW = (const float*)(F.ws + WS_S5PW);
    LAS float* EX = (LAS float*)F.lds;
    const int n = F.lane, j = F.wave;
    for (int it = F.c; it < NB * 32 * 2; it += F.G) {
        const int dir = it & 1, g = (it >> 1) & 31, b = it >> 6, ldg = (l * 2 + dir) * 32 + g;
        const cplx a = {PW[((size_t)ldg * 33 + 32) * 128 + n * 2], PW[((size_t)ldg * 33 + 32) * 128 + n * 2 + 1]};
        float lre[17], lim[17]; size_t rbs[17];
#pragma unroll
        for (int i = 0; i < 17; ++i) { const int p = 17 * j + i; int ck;
            if (p < 8) ck = 8 * b + (dir == 0 ? p : 7 - p); else ck = 32 + 128 * b + (dir == 0 ? p - 8 : 135 - p);
            rbs[i] = (size_t)(g * S5ROWS + ck); lre[i] = SL[rbs[i] * 256 + 128 * dir + n]; lim[i] = SL[rbs[i] * 256 + 128 * dir + 64 + n]; }
        float pre_re[17], pre_im[17]; cplx s = {0.f, 0.f};
#pragma unroll
        for (int i = 0; i < 17; ++i) { pre_re[i] = s.re; pre_im[i] = s.im; const cplx t = cmul(a, s); s.re = t.re + lre[i]; s.im = t.im + lim[i]; }
        __syncthreads();
        EX[(j * 64 + n) * 2] = s.re; EX[(j * 64 + n) * 2 + 1] = s.im;
        __syncthreads();
        cplx a2 = cmul(a, a), a4 = cmul(a2, a2), a8 = cmul(a4, a4), a16 = cmul(a8, a8), a17 = cmul(a16, a);
        cplx cin = {0.f, 0.f};
        for (int jj = 0; jj < j; ++jj) { const cplx t = cmul(a17, cin); cin.re = t.re + EX[(jj * 64 + n) * 2]; cin.im = t.im + EX[(jj * 64 + n) * 2 + 1]; }
        cplx wv = {1.f, 0.f};
#pragma unroll
        for (int i = 0; i < 17; ++i) { const cplx t = cmul(wv, cin); const float sre = pre_re[i] + t.re, sim = pre_im[i] + t.im;
            UG[rbs[i] * S5K + 512 + 128 * dir + n] = (bf16_t)f2bf(sre); UG[rbs[i] * S5K + 512 + 128 * dir + 64 + n] = (bf16_t)f2bf(sim);
            wv = cmul(wv, a); }
    }
    __syncthreads();
}
namespace pg8 {
struct S5LocSched { static constexpr bool GATHER = false; const char* UG; const char* VT; int G, c;
    __device__ __forceinline__ bool next(int i, GUnit& u) const { const int L = i * G + c; if (L >= 96) return false; const int g = L / 3, mt = L % 3;
        u.A = UG + ((size_t)(g * S5ROWS + mt * 256)) * (S5K * 2); u.B = VT + (size_t)g * 256 * 1024; u.i0 = g; u.i1 = mt; u.i2 = 0; u.i3 = 0; return true; } };
struct S5OutSched { static constexpr bool GATHER = false; const char* UG; const char* BC; int G, c;
    __device__ __forceinline__ bool next(int i, GUnit& u) const { const int L = i * G + c; if (L >= 192) return false; const int g = L / 6, rem = L % 6, mt = rem >> 1, pn = rem & 1;
        u.A = UG + ((size_t)(g * S5ROWS + mt * 256)) * (S5K * 2); u.B = BC + ((size_t)(g * 512 + pn * 256)) * (S5K * 2); u.i0 = g; u.i1 = mt; u.i2 = pn; u.i3 = 0; return true; } };
struct MergeSched { static constexpr bool GATHER = false; const char* Y; const char* WB; int nM, pm0, G, c, lim;
    __device__ __forceinline__ bool next(int i, GUnit& u) const { const int Lt = (i / 3) * G + c, k = i % 3; if (Lt >= lim) return false; const int pm = pm0 + (Lt >> 2), pn = Lt & 3;
        u.A = Y + (size_t)pm * 256 * 3072 + k * 1024; u.B = WB + ((size_t)(k * 1024 + pn * 256)) * 1024; u.i0 = pm; u.i1 = pn; u.i2 = k; u.i3 = 0; return true; } };
struct MergeTailSched { static constexpr bool GATHER = false; const char* Y; const char* WB; int nM, pm0, first, c;
    __device__ __forceinline__ bool next(int i, GUnit& u) const { if (i > 0) return false; const int Lt = first + c / 3, k = c % 3; if (Lt >= nM * 4) return false; const int pm = pm0 + (Lt >> 2), pn = Lt & 3;
        u.A = Y + (size_t)pm * 256 * 3072 + k * 1024; u.B = WB + ((size_t)(k * 1024 + pn * 256)) * 1024; u.i0 = pm; u.i1 = pn; u.i2 = c; u.i3 = k; return true; } };
struct GateEarlySched { static constexpr bool GATHER = false; const char* H; const char* W; int G, c;
    __device__ __forceinline__ bool next(int i, GUnit& u) const { if (c < 80 || G <= 80) return false; const int g = i * (G - 80) + c - 80; if (g >= 176) return false; const int pn = g < 128 ? 11 - (g >> 6) : 9, pm = 4 + (g < 128 ? (g & 63) : g - 128);
        u.A = H + (size_t)pm * 256 * 2048; u.B = W + (size_t)pn * 256 * 2048; u.i0 = pm; u.i1 = pn; u.i2 = 0; u.i3 = 0; return true; } };
struct GateCtxSched { static constexpr bool GATHER = false; const char* H; const char* W; int G, c;
    __device__ __forceinline__ bool next(int i, GUnit& u) const { const int w0 = G >= 144 ? 96 : 0; const int g = i * (G - w0) + c - w0; if (c < w0 || g >= 48) return false; const int pm = g / 12, pn = g % 12;
        u.A = H + (size_t)pm * 256 * 2048; u.B = W + (size_t)pn * 256 * 2048; u.i0 = pm; u.i1 = pn; u.i2 = 0; u.i3 = 0; return true; } };
struct GateRestSched { static constexpr bool GATHER = false; pg8::DenseSched D; int G, c;
    __device__ __forceinline__ bool next(int i, GUnit& u) const { const int L = i * G + c; if (L >= 592) return false; int pm, pn;
        if (L < 576) D.tile_of(L, pm, pn); else { pm = 52 + (L - 576); pn = 9; }
        u.A = D.A + (size_t)pm * 256 * 2048; u.B = D.B + (size_t)pn * 256 * 2048; u.i0 = pm; u.i1 = pn; u.i2 = 0; u.i3 = 0; return true; } };
struct MoeUpSched { static constexpr bool GATHER = true; const char* H; const char* W; const int* perm; int ntiles, ts[NE + 1], G, c;
    __device__ __forceinline__ bool next(int i, GUnit& u) const { const int L = i * G + c; if (L >= ntiles * 28) return false; const int tile = L / 28, pn = L % 28; int e = 0;
#pragma unroll
        for (int k = 1; k < NE; ++k) e += (tile >= ts[k]) ? 1 : 0;
        u.A = H; u.B = W + ((size_t)(e * 7168 + pn * 256)) * 2048; u.i0 = tile; u.i1 = pn; u.i2 = e; u.i3 = 0; return true; }
    __device__ __forceinline__ const int* rowtab(const GUnit& u) const { int t0 = 0;
#pragma unroll
        for (int k = 1; k < NE; ++k) t0 = (u.i2 == k) ? ts[k] : t0;
        return perm + u.i2 * 16384 + (u.i0 - t0) * 256; } };
struct MoeDownSched { static constexpr bool GATHER = false; const char* HID; const char* W; int ntiles, ts[NE + 1], G, c, lim;
    __device__ __forceinline__ bool next(int i, GUnit& u) const { const int L = i * G + c; if (L >= lim) return false; const int tile = L >> 2, pn = L & 3; int e = 0;
#pragma unroll
        for (int k = 1; k < NE; ++k) e += (tile >= ts[k]) ? 1 : 0;
        u.A = HID + (size_t)tile * 256 * 7168; u.B = W + ((size_t)(e * 1024 + pn * 256)) * 7168; u.i0 = tile; u.i1 = pn; u.i2 = e; u.i3 = 0; return true; } };
struct MoeDownTailSched { static constexpr bool GATHER = false; const char* HID; const char* W; int ntiles, ts[NE + 1], first, c;
    __device__ __forceinline__ bool next(int i, GUnit& u) const { if (i > 0) return false; const int L = first + (c >> 2), ks = c & 3; if (L >= ntiles * 4) return false; const int tile = L >> 2, pn = L & 3; int e = 0;
#pragma unroll
        for (int k = 1; k < NE; ++k) e += (tile >= ts[k]) ? 1 : 0;
        u.A = HID + (size_t)tile * 256 * 7168 + ks * 1792; u.B = W + ((size_t)(e * 1024 + pn * 256)) * 7168 + ks * 1792; u.i0 = tile; u.i1 = pn; u.i2 = c; u.i3 = ks; return true; } };
}

constexpr size_t WS_SLB_G = WS_BIG + 128 * MiB;
constexpr size_t WS_SLB_F = WS_BIG + 104 * MiB;
constexpr size_t WS_GSP = WS_BIG + 343 * MiB;
static_assert(WS_GSP + 22 * MiB <= WS_END, "ws");
constexpr size_t WS_SLB_M = WS_H;
__device__ __forceinline__ void combine_resid(Frame& F, const pg8::DenseSched& S, int first, int R, int SPL, const float* slab, const float* modacc, const float* adab) {
    float* XW = (float*)(F.ws + WS_XW);
    for (int t = F.c * NTHREADS + F.tid; t < R * 16384; t += F.G * NTHREADS) { const int r = t >> 14, e = t & 16383, row = e >> 6, c4 = (e & 63) * 4; int pm, pn; S.tile_of(first + r, pm, pn);
        f32x4 sum = (f32x4){0.f, 0.f, 0.f, 0.f};
        for (int ks = 0; ks < SPL; ++ks) sum += *(const f32x4*)(slab + (size_t)(r * SPL + ks) * 65536 + row * 256 + c4);
        const int bidx = pm < 4 ? 4 : ((pm - 4) >> 4), gcol = pn * 256 + c4; const f32x4 g = *(const f32x4*)(modacc + bidx * 6144 + gcol) + *(const f32x4*)(adab + gcol);
        f32x4* xp = (f32x4*)(XW + (size_t)(pm * 256 + row) * 1024 + gcol); *xp = *xp + g * sum; }
}
__device__ __forceinline__ void combine_merge(Frame& F, int nM, int pm0, int first, const float* slab) {
    const bf16_t* GT = (const bf16_t*)(F.ws + WS_P); bf16_t* MG = (bf16_t*)(F.ws + WS_H); const int R = nM * 4 - first;
    for (int t = F.c * NTHREADS + F.tid; t < R * 8192; t += F.G * NTHREADS) { const int r = t >> 13, e = t & 8191, row = e >> 5, c8 = (e & 31) * 8; const int Lt = first + r, pm = pm0 + (Lt >> 2), pn = Lt & 3;
        const size_t grow = (size_t)(pm * 256 + row); const int gcol = pn * 256 + c8; float v[8];
#pragma unroll
        for (int j = 0; j < 8; ++j) v[j] = 0.f;
#pragma unroll
        for (int k = 0; k < 3; ++k) { float gt[8]; epi::unpack8(*(const u32x4*)(GT + (size_t)(pm * 12 + k * 4 + pn) * 65536 + row * 256 + c8), gt); const float* sp = slab + (size_t)(r * 3 + k) * 65536 + row * 256 + c8;
            const f32x4 a = *(const f32x4*)sp, b = *(const f32x4*)(sp + 4);
#pragma unroll
            for (int j = 0; j < 4; ++j) { v[j] += gt[j] * a[j]; v[4 + j] += gt[4 + j] * b[j]; } }
        *(u32x4*)(MG + grow * 1024 + gcol) = epi::pack8(v); }
}
__device__ __forceinline__ void combine_moe(Frame& F, int first, int R, const float* slab) {
    bf16_t* SL = (bf16_t*)(F.ws + WS_SLAB);
    for (int t = F.c * NTHREADS + F.tid; t < R * 8192; t += F.G * NTHREADS) { const int r = t >> 13, e = t & 8191, row = e >> 5, c8 = (e & 31) * 8; const int L = first + r, tile = L >> 2, pn = L & 3; float v[8];
#pragma unroll
        for (int j = 0; j < 8; ++j) v[j] = 0.f;
#pragma unroll
        for (int ks = 0; ks < 4; ++ks) { const float* sp = slab + (size_t)(r * 4 + ks) * 65536 + row * 256 + c8; const f32x4 a = *(const f32x4*)sp, b = *(const f32x4*)(sp + 4);
#pragma unroll
            for (int j = 0; j < 4; ++j) { v[j] += a[j]; v[4 + j] += b[j]; } }
        *(u32x4*)(SL + (size_t)(tile * 256 + row) * 1024 + pn * 256 + c8) = epi::pack8(v); }
}

__device__ __forceinline__ int wq_pull(Frame& F, unsigned* head) {
    volatile LAS unsigned* slot = (volatile LAS unsigned*)(F.lds + LDS_MISC + 64);
    __syncthreads();
    if (F.tid == 0) slot[0] = __hip_atomic_fetch_add(head, 1u, __ATOMIC_RELAXED, __HIP_MEMORY_SCOPE_AGENT);
    __syncthreads();
    return (int)slot[0];
}
__device__ __forceinline__ bool launder(Frame& F) { unsigned char* w = F.ws; ArgsP a = F.ap; asm volatile("" : "+s"(w), "+s"(a)); F.ws = w; F.ap = a; F.ctl = (unsigned*)(w + WS_CTL); return true; }
constexpr int NPHASE = 26;
#define IN(k) (lo <= (k) && (k) < hi && launder(F))
#define SEAM(k) do { if ((k) + 1 < hi) xcd_barrier(bar); } while (0)
template <int l>
__device__ __forceinline__ void layer_phases(Frame& F, const XcdBarrier& bar, const int lo, const int hi) {
    const int G = F.G, c = F.c; LAS unsigned char* lds = F.lds;
    constexpr int pb = 1 + 12 * l;

        const int pm0 = l == 0 ? 0 : 4, nM = l == 0 ? 68 : 64;
        const float* modacc = (const float*)(F.ctl + CW_MOD) + (size_t)l * 5 * 6144; const float* adab = F.ap->in[I_ADAB] + (size_t)l * 6144;
        if (IN(pb + 0)) { if (l == 0) norm_rows<0>(F, 0, 0, F.ap->in[I_N1G]); else norm_rows<1>(F, 1, 0, F.ap->in[I_N1G] + D); SEAM(pb + 0); }
        if (IN(pb + 1)) {
            pg8::DenseSched S; S.init(F.ws + WS_H, F.ws + WS_WMIX + (size_t)l * NMIX * D * 2, 2048, 2048, 68, 20, 0, G, c);
            const float* lbp = (const float*)(F.ctl + CW_LB);
            epi::EpiWin E{(bf16_t*)(F.ws + WS_P), (bf16_t*)(F.ws + WS_UG), lbp + 512 * l, lbp + 1024 + 512 * l, F.ap->in[I_GB] + l * 512};
            pg8::gemm_phase(lds, S, E, 2048, 2048, 16);
            if (l == 0) { bg_drain<1>(F); bg_s5fill<0>(F); }
            else { pg8::GateEarlySched T{(const char*)(F.ws + WS_H), (const char*)(F.ws + WS_WGATE + (size_t)NGATE * D * 2), G, c}; epi::EpiGate EG{{(bf16_t*)(F.ws + WS_P), (bf16_t*)(F.ws + WS_GSP), 1}};
                pg8::gemm_phase(lds, T, EG, 2048, 2048, 16); }
            SEAM(pb + 1); }
        if (IN(pb + 2)) {
            { pg8::S5LocSched S{(const char*)(F.ws + WS_UG), (const char*)(F.ws + WS_S5V), G, c}; epi::EpiS5Loc E{(float*)(F.ws + WS_SLOC)}; pg8::gemm_phase(lds, S, E, S5K * 2, 1024, 8); }
            if (l == 0) { pg8::GateCtxSched T{(const char*)(F.ws + WS_H), (const char*)(F.ws + WS_WGATE), G, c}; epi::EpiGate EG{{(bf16_t*)(F.ws + WS_P), (bf16_t*)(F.ws + WS_GSP), 0}}; pg8::gemm_phase(lds, T, EG, 2048, 2048, 16); }
            __syncthreads();
            for (;;) { const int it = wq_pull(F, F.ctl + CW_WQ + 64 * (2 * l)); if (it >= 1024) break;
                const int br = it >> 9, r = it & 511, p = r & 15, dir = (r >> 4) & 1, h = (r >> 5) & 3, b = r >> 7;
                if (br == 0) gla_pass1_item<128, true>(F, b, h, dir, p); else gla_pass1_item<64, false>(F, b, h, dir, p); }
            SEAM(pb + 2); }
        if (IN(pb + 3)) { gla_carry(F); s5_carry(F, l); SEAM(pb + 3); }
        if (IN(pb + 4)) {
            { pg8::S5OutSched S{(const char*)(F.ws + WS_UG), (const char*)(F.ws + WS_S5C), G, (c + G - 64) % G}; epi::EpiS5Out E{(bf16_t*)(F.ws + WS_YPRE)}; pg8::gemm_phase(lds, S, E, S5K * 2, S5K * 2, 12); }
            __syncthreads();
            const int nsc = l == 0 ? 17 : 16, nit = 16 * nsc;
            for (;;) { const int q = wq_pull(F, F.ctl + CW_WQ + 64 * (2 * l + 1)); if (q >= 2 * nit) break;
                const int br = q >= nit, it = br ? q - nit : q, sc = (it % nsc) + (l == 0 ? 0 : 1), h = (it / nsc) & 3, b = it / (nsc * 4);
                if (br == 0) gla_pass3_item<128, true>(F, l, b, h, sc); else gla_pass3_item<64, false>(F, l, b, h, sc); }
            SEAM(pb + 4); }
        if (IN(pb + 5)) {
            if (l == 0) { pg8::DenseSched S; S.init(F.ws + WS_H, F.ws + WS_WGATE, 2048, 2048, 64, 12, 4, G, c); epi::EpiGate E{{(bf16_t*)(F.ws + WS_P), (bf16_t*)(F.ws + WS_GSP), 0}}; pg8::gemm_phase(lds, S, E, 2048, 2048, 16); }
            else { pg8::GateRestSched S; S.D.init(F.ws + WS_H, F.ws + WS_WGATE + (size_t)NGATE * D * 2, 2048, 2048, 64, 9, 4, G, c); S.G = G; S.c = c; epi::EpiGate E{{(bf16_t*)(F.ws + WS_P), (bf16_t*)(F.ws + WS_GSP), 1}}; pg8::gemm_phase(lds, S, E, 2048, 2048, 16); }
            { pg8::DenseSched S; S.init(F.ws + WS_YPRE, F.ws + WS_WGLU + (size_t)l * 512 * 512 * 2, 1024, 1024, nM, 2, pm0, G, (c + G - (l == 0 ? 768 : 592) % G) % G); epi::EpiGlu E{(const bf16_t*)(F.ws + WS_YPRE), (bf16_t*)(F.ws + WS_Y)}; pg8::gemm_phase(lds, S, E, 1024, 1024, 8); }
            if (l == 0) bg_drain<2>(F);
            SEAM(pb + 5); }
        if (IN(pb + 6)) {
            const int nT = nM * 4, fullT = (nT / G) * G; const bool split = (hi - lo > 1) && nT > fullT && (nT - fullT) * 3 <= G;
            pg8::MergeSched S{(const char*)(F.ws + WS_Y), (const char*)(F.ws + WS_WBR + (size_t)l * 3 * D * 512 * 2), nM, pm0, G, c, split ? fullT : nT}; epi::EpiMerge E{{(bf16_t*)(F.ws + WS_P), (bf16_t*)(F.ws + WS_GSP), l}, (bf16_t*)(F.ws + WS_H)};
            pg8::gemm_phase(lds, S, E, 3072, 1024, 8);
            if (split) { pg8::MergeTailSched T{(const char*)(F.ws + WS_Y), (const char*)(F.ws + WS_WBR + (size_t)l * 3 * D * 512 * 2), nM, pm0, fullT, c}; epi::EpiSlab ES{(float*)(F.ws + WS_SLB_F)};
                pg8::gemm_phase(lds, T, ES, 3072, 1024, 8); xcd_barrier(bar); combine_merge(F, nM, pm0, fullT, (const float*)(F.ws + WS_SLB_F)); }
            SEAM(pb + 6); }
        if (IN(pb + 7)) {
            pg8::DenseSched S; S.init(F.ws + WS_H, F.ws + WS_WOUT + (size_t)l * D * D * 2, 2048, 2048, nM, 4, pm0, G, c); epi::EpiResid E{(float*)(F.ws + WS_XW), modacc + 2048, adab + 2048};
            const int full = (S.nwg / G) * G; const bool split = (hi - lo > 1) && S.nwg > full && (S.nwg - full) * 4 <= G;
            if (split) S.lim = full;
            pg8::gemm_phase(lds, S, E, 2048, 2048, 16);
            if (split) { pg8::SplitSched T{S, full, 4, 512, c}; epi::EpiSlab ES{(float*)(F.ws + WS_SLB_G)}; pg8::gemm_phase(lds, T, ES, 2048, 2048, 4); xcd_barrier(bar);
                combine_resid(F, S, full, S.nwg - full, 4, (const float*)(F.ws + WS_SLB_G), modacc + 2048, adab + 2048); }
            SEAM(pb + 7); }
        if (IN(pb + 8)) { if (l == 0) norm_rows<1>(F, 0, 3072, F.ap->in[I_N2G]); else { norm_rows<2>(F, 1, 3072, F.ap->in[I_N2G] + D); moe_convert(F); } SEAM(pb + 8); }
        if (IN(pb + 10)) {
            if (l == 0) { pg8::DenseSched S; S.init(F.ws + WS_H, F.ws + WS_W13, 2048, 2048, 68, 28, 0, G, c); epi::EpiSwiglu E{(bf16_t*)(F.ws + WS_HID)}; pg8::gemm_phase(lds, S, E, 2048, 2048, 16); bg_s5fill<1>(F); }
            else { MoeSeg sg; moe_seg(F, sg); pg8::MoeUpSched S; S.H = (const char*)(F.ws + WS_H) + (size_t)MCTX * 2048; S.W = (const char*)(F.ws + WS_MW13); S.perm = (const int*)(F.ctl + CW_PERM2); S.ntiles = sg.tstart[NE]; S.G = G; S.c = c;
#pragma unroll
                for (int e = 0; e <= NE; ++e) S.ts[e] = sg.tstart[e];
                epi::EpiSwiglu E{(bf16_t*)(F.ws + WS_MHID)}; pg8::gemm_phase(lds, S, E, 2048, 2048, 16);
                bg_drain<3>(F); }
            SEAM(pb + 10); }
        if (IN(pb + 11)) {
            if (l == 0) { pg8::DenseSched S; S.init(F.ws + WS_HID, F.ws + WS_W2, 7168, 7168, 68, 4, 0, G, c); epi::EpiResid E{(float*)(F.ws + WS_XW), modacc + 5120, adab + 5120};
                const int full = (S.nwg / G) * G; const bool split = (hi - lo > 1) && S.nwg > full && (S.nwg - full) * 14 <= G;
                if (split) S.lim = full;
                pg8::gemm_phase(lds, S, E, 7168, 7168, 56);
                if (split) { pg8::SplitSched T{S, full, 14, 512, c}; epi::EpiSlab ES{(float*)(F.ws + WS_SLB_G)}; pg8::gemm_phase(lds, T, ES, 7168, 7168, 4); xcd_barrier(bar);
                    combine_resid(F, S, full, S.nwg - full, 14, (const float*)(F.ws + WS_SLB_G), modacc + 5120, adab + 5120); } }
            else { MoeSeg sg; moe_seg(F, sg); pg8::MoeDownSched S; S.HID = (const char*)(F.ws + WS_MHID); S.W = (const char*)(F.ws + WS_MW2); S.ntiles = sg.tstart[NE]; S.G = G; S.c = c;
#pragma unroll
                for (int e = 0; e <= NE; ++e) S.ts[e] = sg.tstart[e];
                const int nU = sg.tstart[NE] * 4, full = (nU / G) * G; const bool split = (hi - lo > 1) && nU > full && (nU - full) * 4 <= G;
                S.lim = split ? full : nU;
                epi::EpiStoreBf16 E{(bf16_t*)(F.ws + WS_SLAB), 1024}; pg8::gemm_phase(lds, S, E, 7168, 7168, 56);
                if (split) { pg8::MoeDownTailSched T; T.HID = S.HID; T.W = S.W; T.ntiles = S.ntiles; T.first = full; T.c = c;
#pragma unroll
                    for (int e = 0; e <= NE; ++e) T.ts[e] = sg.tstart[e];
                    epi::EpiSlab ES{(float*)(F.ws + WS_SLB_M)}; pg8::gemm_phase(lds, T, ES, 7168, 7168, 14); xcd_barrier(bar); combine_moe(F, full, nU - full, (const float*)(F.ws + WS_SLB_M)); } }
            SEAM(pb + 11); }
    }

__global__ void __launch_bounds__(NTHREADS, 2) fwd_kernel(Args args) {
    extern __shared__ __attribute__((aligned(16))) unsigned char lds_raw[];
    Frame F;
    F.lds = (LAS unsigned char*)lds_raw; F.ws = args.ws; F.ctl = (unsigned*)(args.ws + WS_CTL);
    F.tid = threadIdx.x; F.lane = F.tid & 63; F.wave = __builtin_amdgcn_readfirstlane(F.tid >> 6); F.G = gridDim.x; F.c = blockIdx.x;
    F.ap = (ArgsP)__builtin_amdgcn_kernarg_segment_ptr();
    volatile LAS unsigned* MISC = (volatile LAS unsigned*)(F.lds + LDS_MISC);
    for (int u = F.tid; u < (LDS_BYTES - LDS_MISC) / 4; u += NTHREADS) MISC[u] = 0u;
    __syncthreads();
    XcdBarrier bar; bar.bar = F.ctl + CW_BAR; bar.x = 0; bar.st = nullptr;
    const int lo = args.ph_lo, hi = args.ph_hi;
    if (hi - lo > 1) bar = xcd_barrier_post(F.ctl + CW_BAR, MISC + 8);

    if (IN(0)) { phase_pre(F); SEAM(0); }

    layer_phases<0>(F, bar, lo, hi);
    layer_phases<1>(F, bar, lo, hi);
    if (IN(25)) phase_final(F);
#ifdef PROBE_GEMM
    if (IN(40)) { pg8::DenseSched S; S.init(F.ws + PROBE_A, F.ws + PROBE_B, PROBE_LD, PROBE_LD, 68, 28, 0, F.G, F.c); S.lim = PROBE_LIM; PROBE_EPI; pg8::gemm_phase(F.lds, S, E, PROBE_LD, PROBE_LD, PROBE_NT); }
#endif
#ifdef PROBE_VARIANTS
#define PV_ITEMS(V) do { for (int it = F.c; it < 272; it += F.G) { const int sc = it % 17, h = (it / 17) & 3, b = it / 68; gla_pass3_item<128, true, V>(F, 0, b, h, sc); } \
        if (F.c >= 16) for (int it = F.c - 16; it < 272; it += 240) { const int sc = it % 17, h = (it / 17) & 3, b = it / 68; gla_pass3_item<64, false, V>(F, 0, b, h, sc); } } while (0)
    if (IN(30)) PV_ITEMS(0);
    if (IN(31)) PV_ITEMS(1);
    if (IN(32)) PV_ITEMS(2);
    if (IN(33)) PV_ITEMS(3);
    if (IN(34)) PV_ITEMS(4);
    if (IN(35)) PV_ITEMS(5);
#endif

#undef IN
#undef SEAM
}

extern "C" void kernel_launch(void* const* d_in, const int* in_sizes, int n_in, void* d_out, int out_size, void* d_ws, size_t ws_size, hipStream_t stream) {
    static int grid = 0;
    if (grid == 0) {
        if (n_in != 33 || ws_size < WS_END) { fprintf(stderr, "kernel_launch: need 33 inputs and %zu bytes of workspace (got %d, %zu)\n", (size_t)WS_END, n_in, ws_size); grid = -1; return; }
        int dev = 0, cus = 0, per_cu = 0;
        if (hipGetDevice(&dev) != hipSuccess || hipDeviceGetAttribute(&cus, hipDeviceAttributeMultiprocessorCount, dev) != hipSuccess) { grid = -1; return; }
        if (hipFuncSetAttribute((const void*)fwd_kernel, hipFuncAttributeMaxDynamicSharedMemorySize, LDS_BYTES) != hipSuccess) { fprintf(stderr, "kernel_launch: hipFuncSetAttribute failed\n"); grid = -1; return; }
        if (hipOccupancyMaxActiveBlocksPerMultiprocessor(&per_cu, (const void*)fwd_kernel, NTHREADS, LDS_BYTES) != hipSuccess || per_cu < 1) fprintf(stderr, "kernel_launch: occupancy query says %d\n", per_cu);
        (void)hipGetLastError();
        grid = cus;
    }
    if (grid < 0) return;
    (void)hipMemsetAsync((char*)d_ws + WS_CTL, 0, CTL_BYTES, stream);
    Args a{};
    for (int i = 0; i < 33; ++i) a.in[i] = (const float*)d_in[i];
    a.out = (float*)d_out; a.ws = (unsigned char*)d_ws;
#if MK_N_LAUNCHES == 1
    a.ph_lo = 0; a.ph_hi = NPHASE;
    hipLaunchKernelGGL(fwd_kernel, dim3(grid), dim3(NTHREADS), LDS_BYTES, stream, a);
#ifdef PROBE_PHASES
    { const int pl[] = {PROBE_PHASES}; for (int k : pl) { a.ph_lo = k; a.ph_hi = k + 1; hipLaunchKernelGGL(fwd_kernel, dim3(grid), dim3(NTHREADS), LDS_BYTES, stream, a); } }
#endif
#else
    for (int k = 0; k < NPHASE; ++k) { if (k == 10) continue; a.ph_lo = k; a.ph_hi = k + 1; hipLaunchKernelGGL(fwd_kernel, dim3(grid), dim3(NTHREADS), LDS_BYTES, stream, a); }
#endif
}
```

```cpp
#include <hip/hip_runtime.h>
#include <cstdio>
#include <cstdint>

#ifndef MK_N_LAUNCHES
#define MK_N_LAUNCHES 1
#endif

#define GAS __attribute__((address_space(1)))
#define LAS __attribute__((address_space(3)))
typedef unsigned short bf16_t;
typedef short bf16x8 __attribute__((ext_vector_type(8)));
typedef short bf16x4 __attribute__((ext_vector_type(4)));
typedef float f32x4 __attribute__((ext_vector_type(4)));
typedef float f32x2 __attribute__((ext_vector_type(2)));
typedef unsigned u32x4 __attribute__((ext_vector_type(4)));
typedef unsigned u32x2 __attribute__((ext_vector_type(2)));

constexpr int D = 1024, NB = 4, SEQ = 4096, CTX = 256, FFN = 3584, NE = 8;
constexpr int MCTX = NB * CTX;
constexpr int MLAT = NB * SEQ;
constexpr int M = MCTX + MLAT;
constexpr int NMIX = 5120, NGATE = 3072, LDP = 4608;
constexpr int N_IN = 7712;
constexpr int NSC = 17;
constexpr int S5L = 32, S5CH = M / S5L;
constexpr int S5ROWS = 768;
constexpr int S5K = 768;
constexpr float EPS = 1e-6f;
constexpr int MOE_ROWS = 2 * MLAT + NE * 256;
constexpr int MOE_TILES = MOE_ROWS / 256;

constexpr size_t MiB = (size_t)1 << 20;
constexpr size_t WS_CTL = 0, CTL_BYTES = 2 * MiB;
constexpr size_t WS_XW = 2 * MiB;
constexpr size_t WS_H = 70 * MiB;
constexpr size_t WS_WSM = 104 * MiB;
constexpr size_t WS_WMIX = WS_WSM;
constexpr size_t WS_WGATE = WS_WMIX + 20 * MiB;
constexpr size_t WS_WBR = WS_WGATE + 12 * MiB;
constexpr size_t WS_WOUT = WS_WBR + 6 * MiB;
constexpr size_t WS_WGLU = WS_WOUT + 4 * MiB;
constexpr size_t WS_W13 = WS_WGLU + 1 * MiB;
constexpr size_t WS_W2 = WS_W13 + 14 * MiB;
constexpr size_t WS_MW2 = WS_WSM;
constexpr size_t WS_S5C = 168 * MiB;
constexpr size_t WS_S5V = WS_S5C + 24 * MiB;
constexpr size_t WS_BIG = 200 * MiB;
constexpr size_t WS_P = WS_BIG;
constexpr size_t WS_Y = WS_BIG + 153 * MiB;
constexpr size_t WS_YPRE = WS_BIG + 204 * MiB;
constexpr size_t WS_UG = WS_BIG + 221 * MiB;
constexpr size_t WS_SLOC = WS_BIG + 257 * MiB;
constexpr size_t WS_GST = WS_BIG + 281 * MiB;
constexpr size_t WS_GST2 = WS_GST + 34 * MiB;
constexpr size_t WS_GDEC = WS_BIG + 332 * MiB;
constexpr size_t WS_HID = WS_BIG;
constexpr size_t WS_MW13 = WS_BIG;
constexpr size_t WS_MHID = WS_BIG + 112 * MiB;
constexpr size_t WS_SLAB = WS_BIG;
constexpr size_t WS_END = 578 * MiB;
static_assert(WS_MHID + (size_t)MOE_ROWS * FFN * 2 <= WS_END, "ws map");
static_assert(WS_GDEC + 1 * MiB <= WS_END, "ws map");

constexpr int CW_BAR = 0;
constexpr int CW_MOECNT = 4096;
constexpr int CW_WQ = 5120;
constexpr int CW_MOD = 8192;
constexpr int CW_LB = CW_MOD + 61440;
constexpr int CW_TOKE = CW_LB + 2048;
constexpr int CW_TOKR = CW_TOKE + 32768;
constexpr int CW_TOKW = CW_TOKR + 32768;
constexpr int CW_PERM = CW_TOKW + 32768;
constexpr int CW_END = CW_PERM + MOE_ROWS;
constexpr int CW_POS = 262144;
constexpr int CW_PERM2 = 327680;
static_assert(CW_END <= CW_POS && (size_t)(CW_POS + 64 * 512) * 4 <= CTL_BYTES, "ctl pos");
static_assert(CW_POS + 64 * 512 <= CW_PERM2 && (size_t)(CW_PERM2 + 8 * 16384) * 4 <= CTL_BYTES, "ctl perm2");
static_assert((size_t)CW_END * 4 <= CTL_BYTES, "ctl");

constexpr int NTHREADS = 512;
constexpr int LDS_BYTES = 161792;
constexpr int LDS_MISC = 160768;

__device__ __forceinline__ float bf2f(bf16_t v) { return __uint_as_float(((unsigned)v) << 16); }
__device__ __forceinline__ unsigned f2bf(float f) { unsigned u = __float_as_uint(f); return (u + 0x7fffu + ((u >> 16) & 1u)) >> 16; }
typedef __bf16 bf16v2_t __attribute__((ext_vector_type(2)));
__device__ __forceinline__ unsigned pk2(float lo, float hi) { const f32x2 v = {lo, hi}; return __builtin_bit_cast(unsigned, __builtin_convertvector(v, bf16v2_t)); }
__device__ __forceinline__ float fsigmoid(float x) { return __builtin_amdgcn_rcpf(1.0f + __expf(-x)); }
__device__ __forceinline__ float fsilu(float x) { return x * __builtin_amdgcn_rcpf(1.0f + __expf(-x)); }
__device__ __forceinline__ float flogsig(float x) { return fminf(x, 0.f) - __logf(1.0f + __expf(-fabsf(x))); }
__device__ __forceinline__ float wave_sum(float v) {
#pragma unroll
    for (int o = 1; o < 64; o <<= 1) v += __shfl_xor(v, o);
    return v;
}
#define LDS_WAIT() asm volatile("s_waitcnt lgkmcnt(0)" ::: "memory")
#define VM_WAIT() asm volatile("s_waitcnt vmcnt(0)" ::: "memory")

#define XB_TMO      128
#define XB_XCNT(j)  (256  + 64 * (j))
#define XB_XSUB(j)  (1280 + 64 * (j))
#define XB_XGEN(j)  (2304 + 64 * (j))
#define XB_TOP      3328
#define XB_TOPGEN   3392
#define XCD_BAR_WORDS 3456
#define XB_SPIN_CAP (1u << 22)
__device__ __forceinline__ unsigned xb_ld(unsigned* p)              { return __hip_atomic_load(p, __ATOMIC_RELAXED, __HIP_MEMORY_SCOPE_AGENT); }
__device__ __forceinline__ unsigned xb_add(unsigned* p, unsigned v) { return __hip_atomic_fetch_add(p, v, __ATOMIC_RELAXED, __HIP_MEMORY_SCOPE_AGENT); }
__device__ __forceinline__ unsigned xb_xcc_id() { return (unsigned)__builtin_amdgcn_s_getreg((3 << 11) | 20) & 0xFu; }
#define XB_SPIN(cond, bar) do { unsigned _sp = 0; while (cond) { __builtin_amdgcn_s_sleep(1); \
    if ((++_sp & 255u) == 0u) { if (xb_ld(&(bar)[XB_TMO])) break; if (_sp > XB_SPIN_CAP) { atomicAdd(&(bar)[XB_TMO], 1u); break; } } } } while (0)
struct XcdBarrier { unsigned* bar; unsigned x; volatile LAS unsigned* st; };
__device__ __forceinline__ XcdBarrier xcd_barrier_post(unsigned* bar, volatile LAS unsigned* st) {
    XcdBarrier b; b.bar = bar; b.x = xb_xcc_id(); b.st = st;
    if (threadIdx.x == 0) (void)xb_add(&bar[XB_XCNT(b.x)], 1u);
    return b;
}
__device__ __forceinline__ void xcd_barrier_complete(unsigned* bar, unsigned x, unsigned& nloc, unsigned& nx) {
    const unsigned G = gridDim.x * gridDim.y * gridDim.z;
    unsigned sum, cnt, mine, sp = 0u;
    for (;;) {
        sum = 0u; cnt = 0u; mine = 0u;
#pragma unroll
        for (unsigned j = 0; j < 16; ++j) { const unsigned c = xb_ld(&bar[XB_XCNT(j)]); sum += c; cnt += (c > 0u) ? 1u : 0u; mine = (j == x) ? c : mine; }
        if (sum == G) break;
        __builtin_amdgcn_s_sleep(1);
        if ((++sp & 255u) == 0u) { if (xb_ld(&bar[XB_TMO])) break; if (sp > XB_SPIN_CAP) { atomicAdd(&bar[XB_TMO], 1u); break; } }
    }
    nloc = mine > 0u ? mine : 1u; nx = cnt > 0u ? cnt : 1u;
}
__device__ __forceinline__ void xcd_barrier(const XcdBarrier& b) {
    asm volatile("s_waitcnt vmcnt(0)" ::: "memory");
    __syncthreads();
    if (threadIdx.x == 0) {
        unsigned* bar = b.bar;
        __builtin_amdgcn_s_waitcnt(0);
        unsigned nloc = b.st[0], nx = b.st[1];
        if (nloc == 0u) { xcd_barrier_complete(bar, b.x, nloc, nx); b.st[0] = nloc; b.st[1] = nx; }
        const unsigned old = xb_add(&bar[XB_XSUB(b.x)], 1u);
        const unsigned gen = old / nloc;
        if (old + 1u == (gen + 1u) * nloc) {
            __builtin_amdgcn_fence(__ATOMIC_RELEASE, "agent");
            asm volatile("s_waitcnt vmcnt(0)" ::: "memory");
            const unsigned og = xb_add(&bar[XB_TOP], 1u);
            const unsigned tg = og / nx;
            if (og + 1u == (tg + 1u) * nx) xb_add(&bar[XB_TOPGEN], 1u);
            else XB_SPIN(xb_ld(&bar[XB_TOPGEN]) == tg, bar);
            __builtin_amdgcn_fence(__ATOMIC_ACQUIRE, "agent");
            xb_add(&bar[XB_XGEN(b.x)], 1u);
            asm volatile("s_waitcnt vmcnt(0)" ::: "memory");
        } else {
            XB_SPIN(xb_ld(&bar[XB_XGEN(b.x)]) == gen, bar);
            __builtin_amdgcn_fence(__ATOMIC_ACQUIRE, "agent");
            asm volatile("s_waitcnt vmcnt(0)" ::: "memory");
        }
    }
    __syncthreads();
}
namespace pg8 {
constexpr int BM = 256, BK = 64, HALF = 128, HTB = HALF * BK * 2, STAGE_BYTES = 8 * HTB;
__host__ __device__ __forceinline__ int lds_byte(int r, int c) { const int st = (r >> 4) * 2 + (c >> 5), rr = r & 15, cc = c & 31, ob = rr * 64 + cc * 2; return st * 1024 + (ob ^ (((ob >> 9) & 1) << 5)); }
__host__ __device__ __forceinline__ void stage_rc(int b, int& R, int& C) { const int st = b / 1024, sb = b % 1024, swz = sb ^ (((sb >> 9) & 1) << 5); R = (st >> 1) * 16 + swz / 64; C = (st & 1) * 32 + (swz % 64) / 2; }
__host__ __device__ __forceinline__ int perm32(int rho) { const int n = rho >> 4, i = rho & 15; return 8 * (i >> 2) + 4 * n + (i & 3); }

struct GUnit { const char* A; const char* B; int i0, i1, i2, i3; };

template <class Sched, class Epi>
__device__ __forceinline__ void gemm_phase(LAS unsigned char* lds, const Sched& S, const Epi& E, const int lda, const int ldb, const int nt) {
    int tid_ = threadIdx.x; asm volatile("" : "+v"(tid_));
    const int tid = tid_, wid = __builtin_amdgcn_readfirstlane(tid >> 6), lane = tid & 63, wr = wid >> 2, wc = wid & 3, fr = lane & 15, fq = lane >> 4;
    constexpr bool GATHER = Sched::GATHER;
    unsigned voffA[2], voffB[2]; int RA[2], CA[2];
#pragma unroll
    for (int i = 0; i < 2; ++i) { int R, C; stage_rc(tid * 16 + i * 8192, R, C); const int Rb = Epi::PERM ? ((R & ~31) + perm32(R & 31)) : R;
        RA[i] = R; CA[i] = C; voffA[i] = (unsigned)(R * lda + C * 2); voffB[i] = (unsigned)(Rb * ldb + C * 2); }
    unsigned gAc[2], gAn[2];
    const size_t kstep = (size_t)(BK * 2);
    const size_t hstepA = GATHER ? 0 : (size_t)HALF * lda, hstepB = (size_t)HALF * ldb;
    const unsigned ldsw = (unsigned)wid * 1024u;
    const int aoff = lds_byte(wr * 64 + fr, fq * 8), boff = lds_byte(wc * 32 + fr, fq * 8);
#define PG8_SA(b, h) (((b) * 2 + (h)) * HTB)
#define PG8_SB(b, h) ((4 + (b) * 2 + (h)) * HTB)
#define PG8_STAGE(bufoff, gbase, voff) do { _Pragma("unroll") for (int _i = 0; _i < 2; ++_i) \
        __builtin_amdgcn_global_load_lds((const unsigned*)((const char*)(gbase) + (voff)[_i]), (LAS unsigned*)(lds + (bufoff) + ldsw + _i * 8192), 16, 0, 0); } while (0)
#define PG8_STAGE_A(bufoff, gbase, h, nx) do { if constexpr (GATHER) { const unsigned _pk = (nx) ? gAn[h] : gAc[h]; unsigned _vo[2]; _vo[0] = (_pk & 0xffffu) * (unsigned)lda + (unsigned)(CA[0] * 2); _vo[1] = (_pk >> 16) * (unsigned)lda + (unsigned)(CA[1] * 2); \
        PG8_STAGE(bufoff, gbase, _vo); } else PG8_STAGE(bufoff, (gbase) + (h) * hstepA, voffA); } while (0)
#define PG8_LDA(dst, b, h) do { _Pragma("unroll") for (int m = 0; m < 4; ++m) _Pragma("unroll") for (int k = 0; k < 2; ++k) dst[m][k] = *(const LAS bf16x8*)(lds + PG8_SA(b, h) + aoff + m * 2048 + k * 1024); } while (0)
#define PG8_LDB(dst, b, h) do { _Pragma("unroll") for (int n = 0; n < 2; ++n) _Pragma("unroll") for (int k = 0; k < 2; ++k) dst[n][k] = *(const LAS bf16x8*)(lds + PG8_SB(b, h) + boff + n * 2048 + k * 1024); } while (0)
#define PG8_MMA(ai, bj, At, Bt) do { __builtin_amdgcn_s_setprio(1); _Pragma("unroll") for (int m = 0; m < 4; ++m) _Pragma("unroll") for (int n = 0; n < 2; ++n) _Pragma("unroll") for (int k = 0; k < 2; ++k) \
        acc[ai][bj][m][n] = __builtin_amdgcn_mfma_f32_16x16x32_bf16(Bt[n][k], At[m][k], acc[ai][bj][m][n], 0, 0, 0); __builtin_amdgcn_s_setprio(0); } while (0)
#define PG8_WAIT_V(n) asm volatile("s_waitcnt vmcnt(" #n ")" ::: "memory")
#define PG8_WAIT_L(n) asm volatile("s_waitcnt lgkmcnt(" #n ")" ::: "memory")
#define PG8_BAR __builtin_amdgcn_s_barrier()
#define PG8_SCHED __builtin_amdgcn_sched_barrier(0)
#define PG8_GVOFF(dst, u) do { if constexpr (GATHER) { const int* _rt = S.rowtab(u); _Pragma("unroll") for (int _h = 0; _h < 2; ++_h) \
        dst[_h] = (unsigned)_rt[_h * HALF + RA[0]] | ((unsigned)_rt[_h * HALF + RA[1]] << 16); } } while (0)
    GUnit cur, nxt; int ui = 0;
    if (!S.next(0, cur)) return;
    f32x4 acc[2][2][4][2];
#pragma unroll
    for (int a = 0; a < 2; ++a)
#pragma unroll
        for (int b = 0; b < 2; ++b)
#pragma unroll
            for (int m = 0; m < 4; ++m)
#pragma unroll
                for (int n = 0; n < 2; ++n) acc[a][b][m][n] = (f32x4){0.f, 0.f, 0.f, 0.f};
    bf16x8 At[4][2], B0[2][2], B1[2][2];
    const char* cA = cur.A; const char* cB = cur.B;
    PG8_GVOFF(gAc, cur);
    PG8_STAGE(PG8_SB(0, 0), cB, voffB); PG8_STAGE_A(PG8_SA(0, 0), cA, 0, false); PG8_STAGE(PG8_SB(0, 1), cB + hstepB, voffB); PG8_STAGE_A(PG8_SA(0, 1), cA, 1, false);
    if (wr == 1) PG8_BAR;
    PG8_WAIT_V(4); PG8_BAR;
    PG8_STAGE(PG8_SB(1, 0), cB + kstep, voffB); PG8_STAGE_A(PG8_SA(1, 0), cA + kstep, 0, false); PG8_STAGE(PG8_SB(1, 1), cB + hstepB + kstep, voffB);
    PG8_WAIT_V(6); PG8_BAR;
    for (;;) {
        const bool has_next = S.next(ui + 1, nxt);
        const char* nA = has_next ? nxt.A : cA; const char* nB = has_next ? nxt.B : cB;
        if constexpr (GATHER) { if (has_next) { PG8_GVOFF(gAn, nxt); } else { gAn[0] = gAc[0]; gAn[1] = gAc[1]; } }
        for (int t = 0; t < nt; t += 2) {
            const bool last = (t == nt - 2);
            const char* a1 = cA + (size_t)(t + 1) * kstep;
            const char* a2 = last ? nA : cA + (size_t)(t + 2) * kstep; const char* b2 = last ? nB : cB + (size_t)(t + 2) * kstep;
            const char* a3 = a2 + kstep; const char* b3 = b2 + kstep;
            PG8_LDB(B0, 0, 0); PG8_SCHED; PG8_LDA(At, 0, 0); PG8_STAGE_A(PG8_SA(1, 1), a1, 1, false);
            PG8_WAIT_L(8); PG8_BAR; PG8_WAIT_L(0); PG8_MMA(0, 0, At, B0); PG8_BAR; PG8_SCHED;
            PG8_LDB(B1, 0, 1); PG8_STAGE(PG8_SB(0, 0), b2, voffB);
            PG8_BAR; PG8_WAIT_L(0); PG8_MMA(0, 1, At, B1); PG8_BAR;
            PG8_LDA(At, 0, 1); PG8_STAGE_A(PG8_SA(0, 0), a2, 0, last);
            PG8_BAR; PG8_WAIT_L(0); PG8_MMA(1, 0, At, B0); PG8_BAR; PG8_SCHED;
            PG8_STAGE(PG8_SB(0, 1), b2 + hstepB, voffB);
            PG8_WAIT_V(6); PG8_BAR; PG8_MMA(1, 1, At, B1); PG8_BAR;
            PG8_LDB(B0, 1, 0); PG8_SCHED; PG8_LDA(At, 1, 0); PG8_STAGE_A(PG8_SA(0, 1), a2, 1, last);
            PG8_WAIT_L(8); PG8_BAR; PG8_WAIT_L(0); PG8_MMA(0, 0, At, B0); PG8_BAR; PG8_SCHED;
            PG8_LDB(B1, 1, 1); PG8_STAGE(PG8_SB(1, 0), b3, voffB);
            PG8_BAR; PG8_WAIT_L(0); PG8_MMA(0, 1, At, B1); PG8_BAR;
            PG8_LDA(At, 1, 1); PG8_STAGE_A(PG8_SA(1, 0), a3, 0, last);
            PG8_BAR; PG8_WAIT_L(0); PG8_MMA(1, 0, At, B0); PG8_BAR; PG8_SCHED;
            PG8_STAGE(PG8_SB(1, 1), b3 + hstepB, voffB);
            PG8_WAIT_V(6); PG8_BAR; PG8_MMA(1, 1, At, B1); PG8_BAR;
        }
        E(acc, cur, wr, wc, fr, fq);
        if (!has_next) break;
#pragma unroll
        for (int a = 0; a < 2; ++a)
#pragma unroll
            for (int b = 0; b < 2; ++b)
#pragma unroll
                for (int m = 0; m < 4; ++m)
#pragma unroll
                    for (int n = 0; n < 2; ++n) acc[a][b][m][n] = (f32x4){0.f, 0.f, 0.f, 0.f};
        cur = nxt; cA = nA; cB = nB; ++ui;
        if constexpr (GATHER) { gAc[0] = gAn[0]; gAc[1] = gAn[1]; }
    }
    PG8_WAIT_V(0);
    if (wr == 0) PG8_BAR;
    PG8_BAR;
#undef PG8_SA
#undef PG8_SB
#undef PG8_STAGE
#undef PG8_STAGE_A
#undef PG8_LDA
#undef PG8_LDB
#undef PG8_MMA
#undef PG8_WAIT_V
#undef PG8_WAIT_L
#undef PG8_BAR
#undef PG8_SCHED
#undef PG8_GVOFF
}

struct DenseSched {
    static constexpr bool GATHER = false;
    const char* A; const char* B; int lda, ldb, nM, nN, pm0, nwg, G, c, lim;
    __device__ void init(const void* A_, const void* B_, int lda_, int ldb_, int nM_, int nN_, int pm0_, int G_, int c_) { A = (const char*)A_; B = (const char*)B_; lda = lda_; ldb = ldb_; nM = nM_; nN = nN_; pm0 = pm0_; nwg = nM * nN; G = G_; c = c_; lim = nwg; }
    __device__ __forceinline__ void tile_of(int L, int& pm, int& pn) const {
        int wgid = L; { const int q = nwg / 8, r = nwg % 8, xcd = wgid % 8, off = wgid / 8; wgid = (xcd < r ? xcd * (q + 1) : r * (q + 1) + (xcd - r) * q) + off; }
        const int nig = 8 * nN, gid = wgid / nig, fm = gid * 8, gsz = (nM - fm) < 8 ? (nM - fm) : 8;
        pm = fm + ((wgid % nig) % gsz) + pm0; pn = (wgid % nig) / gsz; }
    __device__ __forceinline__ bool next(int i, GUnit& u) const {
        const long L = (long)i * G + c; if (L >= lim) return false;
        int wgid = (int)L; { const int q = nwg / 8, r = nwg % 8, xcd = wgid % 8, off = wgid / 8; wgid = (xcd < r ? xcd * (q + 1) : r * (q + 1) + (xcd - r) * q) + off; }
        const int nig = 8 * nN, gid = wgid / nig, fm = gid * 8, gsz = (nM - fm) < 8 ? (nM - fm) : 8;
        const int pm = fm + ((wgid % nig) % gsz) + pm0, pn = (wgid % nig) / gsz;
        u.A = A + (size_t)pm * 256 * lda; u.B = B + (size_t)pn * 256 * ldb; u.i0 = pm; u.i1 = pn; u.i2 = 0; u.i3 = 0; return true;
    }
};
struct SplitSched {
    static constexpr bool GATHER = false;
    DenseSched D; int first, S, kbytes, c;
    __device__ __forceinline__ bool next(int i, GUnit& u) const {
        if (i > 0) return false; const int L = first + c / S, ks = c % S; if (L >= D.nwg) return false;
        int pm, pn; D.tile_of(L, pm, pn);
        u.A = D.A + (size_t)pm * 256 * D.lda + (size_t)ks * kbytes; u.B = D.B + (size_t)pn * 256 * D.ldb + (size_t)ks * kbytes; u.i0 = pm; u.i1 = pn; u.i2 = c; u.i3 = ks; return true; }
};
}
namespace epi {
using pg8::GUnit;
__device__ __forceinline__ void unpack8(const u32x4 w, float (&o)[8]) {
    o[0] = __uint_as_float(w.x << 16); o[1] = __uint_as_float(w.x & 0xffff0000u); o[2] = __uint_as_float(w.y << 16); o[3] = __uint_as_float(w.y & 0xffff0000u);
    o[4] = __uint_as_float(w.z << 16); o[5] = __uint_as_float(w.z & 0xffff0000u); o[6] = __uint_as_float(w.w << 16); o[7] = __uint_as_float(w.w & 0xffff0000u);
}
__device__ __forceinline__ u32x4 pack8(const float (&v)[8]) { u32x4 w; w.x = pk2(v[0], v[1]); w.y = pk2(v[2], v[3]); w.z = pk2(v[4], v[5]); w.w = pk2(v[6], v[7]); return w; }
#define EPI_ROWS_BEGIN(pmrow0) _Pragma("unroll") for (int ai = 0; ai < 2; ++ai) _Pragma("unroll") for (int m = 0; m < 4; ++m) { const int row = (pmrow0) + ai * 128 + wr * 64 + m * 16 + fr;
#define EPI_ROWS_END asm volatile("" ::: "memory"); }

struct EpiWin {
    static constexpr bool PERM = true;
    bf16_t* P; bf16_t* UG; const float* loglb; const float* logub; const float* gbias;
    template <int TYPE>
    __device__ __forceinline__ void body(const f32x4 (&acc)[2][2][4][2], const GUnit& u, int wr, int wc, int fr, int fq) const {
        const int pm = u.i0, pn = u.i1;
#pragma unroll
        for (int bj = 0; bj < 2; ++bj) {
            const int col = pn * 256 + bj * 128 + wc * 32 + 8 * fq;
            float pa[8], pb[8];
#pragma unroll
            for (int j = 0; j < 8; ++j) { pa[j] = 0.f; pb[j] = 0.f; }
            if (TYPE == 1) { const int ch = col & 511;
#pragma unroll
                for (int j = 0; j < 8; ++j) { pa[j] = loglb[ch + j]; pb[j] = logub[ch + j]; } }
            if (TYPE == 4) { const int n = col - 3584;
#pragma unroll
                for (int j = 0; j < 8; ++j) pa[j] = gbias[n + j]; }
            EPI_ROWS_BEGIN(pm * 256)
                float v[8];
#pragma unroll
                for (int j = 0; j < 4; ++j) { v[j] = acc[ai][bj][m][0][j]; v[4 + j] = acc[ai][bj][m][1][j]; }
                if (TYPE == 1) {
#pragma unroll
                    for (int j = 0; j < 8; ++j) { const float z = v[j], t = __expf(-fabsf(z)), rc = __builtin_amdgcn_rcpf(1.0f + t), sg = z >= 0.f ? rc : t * rc;
                        const bool pos = pa[j] > 0.f; const float L = __logf(pos ? pa[j] + pb[j] * sg : 1.0f + t); v[j] = pos ? L : fminf(z, 0.f) - L; }
                } else if (TYPE == 2) {
#pragma unroll
                    for (int j = 0; j < 8; ++j) v[j] = fsilu(v[j]);
                } else if (TYPE == 3) {
#pragma unroll
                    for (int j = 0; j < 8; ++j) v[j] *= 0.125f;
                } else if (TYPE == 4) {
#pragma unroll
                    for (int j = 0; j < 8; ++j) v[j] = flogsig(v[j] + pa[j]) * 0.0625f;
                }
                const u32x4 w = pack8(v);
                if (TYPE == 5) { const int c0 = col - 4608, g = c0 >> 4, p0 = c0 & 15, ck = row >> 5, mm = row & 31;
                    *(u32x4*)(UG + ((size_t)(g * S5ROWS + ck) * S5K + mm * 16 + p0)) = w; }
                else *(u32x4*)(P + (size_t)row * LDP + col) = w;
            EPI_ROWS_END
        }
    }
    __device__ __forceinline__ void operator()(const f32x4 (&acc)[2][2][4][2], const GUnit& u, int wr, int wc, int fr, int fq) const {
        const int pn = u.i1;
        if (pn >= 2 && pn <= 5) body<1>(acc, u, wr, wc, fr, fq);
        else if (pn == 8 || pn == 9 || pn == 16 || pn == 17) body<2>(acc, u, wr, wc, fr, fq);
        else if (pn == 10) body<3>(acc, u, wr, wc, fr, fq);
        else if (pn == 14 || pn == 15) body<4>(acc, u, wr, wc, fr, fq);
        else if (pn >= 18) body<5>(acc, u, wr, wc, fr, fq);
        else body<0>(acc, u, wr, wc, fr, fq);
    }
};
struct GateMap { bf16_t* G; bf16_t* SP; int mode;
    __device__ __forceinline__ bf16_t* loc(int pm, int pn) const {
        int g = -1;
        if (mode == 1) { if (pn >= 10) g = (11 - pn) * 64 + (pm - 4); else if (pn == 9 && pm < 52) g = 128 + (pm - 4); }
        else if (pm < 4) g = pm * 12 + pn;
        return g >= 0 ? SP + (size_t)g * 65536 : G + (size_t)(pm * 12 + pn) * 65536; } };
struct EpiGate {
    static constexpr bool PERM = true;
    GateMap GM;
    __device__ __forceinline__ void operator()(const f32x4 (&acc)[2][2][4][2], const GUnit& u, int wr, int wc, int fr, int fq) const {
        bf16_t* base = GM.loc(u.i0, u.i1);
#pragma unroll
        for (int bj = 0; bj < 2; ++bj) { const int col = bj * 128 + wc * 32 + 8 * fq;
            EPI_ROWS_BEGIN(0)
                float v[8];
#pragma unroll
                for (int j = 0; j < 4; ++j) { v[j] = fsigmoid(acc[ai][bj][m][0][j]); v[4 + j] = fsigmoid(acc[ai][bj][m][1][j]); }
                *(u32x4*)(base + row * 256 + col) = pack8(v);
            EPI_ROWS_END }
    }
};
struct EpiS5Loc {
    static constexpr bool PERM = false;
    float* SL;
    __device__ __forceinline__ void operator()(const f32x4 (&acc)[2][2][4][2], const GUnit& u, int wr, int wc, int fr, int fq) const {
        const int g = u.i0, mt = u.i1;
        EPI_ROWS_BEGIN(mt * 256)
            float* rp = SL + ((size_t)(g * S5ROWS + row)) * 256 + wc * 32 + 4 * fq;
#pragma unroll
            for (int bj = 0; bj < 2; ++bj)
#pragma unroll
                for (int n = 0; n < 2; ++n) *(f32x4*)(rp + bj * 128 + n * 16) = acc[ai][bj][m][n];
        EPI_ROWS_END
    }
};
struct EpiS5Out {
    static constexpr bool PERM = true;
    bf16_t* YP;
    __device__ __forceinline__ void operator()(const f32x4 (&acc)[2][2][4][2], const GUnit& u, int wr, int wc, int fr, int fq) const {
        const int g = u.i0, mt = u.i1, pn = u.i2;
#pragma unroll
        for (int bj = 0; bj < 2; ++bj) { const int col = pn * 256 + bj * 128 + wc * 32 + 8 * fq, mm = col >> 4, p0 = col & 15;
            EPI_ROWS_BEGIN(mt * 256)
                if (row < S5CH) {
                    float v[8];
#pragma unroll
                    for (int j = 0; j < 4; ++j) { v[j] = acc[ai][bj][m][0][j]; v[4 + j] = acc[ai][bj][m][1][j]; }
#pragma unroll
                    for (int j = 0; j < 8; ++j) { const float x = v[j]; v[j] = x * fsigmoid(1.5957691216057308f * (x + 0.044715f * x * x * x)); }
                    *(u32x4*)(YP + (size_t)(row * S5L + mm) * 512 + g * 16 + p0) = pack8(v);
                }
            EPI_ROWS_END }
    }
};
struct EpiGlu {
    static constexpr bool PERM = true;
    const bf16_t* YP; bf16_t* Y;
    __device__ __forceinline__ void operator()(const f32x4 (&acc)[2][2][4][2], const GUnit& u, int wr, int wc, int fr, int fq) const {
        const int col0 = u.i1 * 256 + wc * 32 + 8 * fq;
#pragma unroll
        for (int ai = 0; ai < 2; ++ai) { u32x4 yv[4][2];
#pragma unroll
            for (int m = 0; m < 4; ++m)
#pragma unroll
                for (int bj = 0; bj < 2; ++bj) yv[m][bj] = *(const u32x4*)(YP + (size_t)(u.i0 * 256 + ai * 128 + wr * 64 + m * 16 + fr) * 512 + col0 + bj * 128);
#pragma unroll
            for (int m = 0; m < 4; ++m)
#pragma unroll
                for (int bj = 0; bj < 2; ++bj) { const int row = u.i0 * 256 + ai * 128 + wr * 64 + m * 16 + fr; float y[8], v[8]; unpack8(yv[m][bj], y);
#pragma unroll
                    for (int j = 0; j < 4; ++j) { v[j] = y[j] * fsigmoid(acc[ai][bj][m][0][j]); v[4 + j] = y[4 + j] * fsigmoid(acc[ai][bj][m][1][j]); }
                    *(u32x4*)(Y + (size_t)row * 1536 + 1024 + col0 + bj * 128) = pack8(v); }
            asm volatile("" ::: "memory"); }
    }
};
struct EpiMerge {
    static constexpr bool PERM = true;
    GateMap GM; bf16_t* MG;
#ifdef PROBE_MERGE
    int pmode;
#endif
    __device__ __forceinline__ void operator()(const f32x4 (&acc)[2][2][4][2], const GUnit& u, int wr, int wc, int fr, int fq) const {
        const int k = u.i2, col0 = u.i1 * 256 + wc * 32 + 8 * fq;
        const bf16_t* gb = GM.loc(u.i0, k * 4 + u.i1) + wc * 32 + 8 * fq;
#pragma unroll
        for (int ai = 0; ai < 2; ++ai) { u32x4 gv[4][2], pv[4][2];
#pragma unroll
            for (int m = 0; m < 4; ++m)
#pragma unroll
                for (int bj = 0; bj < 2; ++bj) { const size_t row = (size_t)(u.i0 * 256 + ai * 128 + wr * 64 + m * 16 + fr);
#ifdef PROBE_MERGE
                    gv[m][bj] = (pmode & 2) ? (u32x4){0x3f803f80u, 0x3f803f80u, 0x3f803f80u, 0x3f803f80u} : *(const u32x4*)(gb + (ai * 128 + wr * 64 + m * 16 + fr) * 256 + bj * 128);
                    pv[m][bj] = (k > 0 && !(pmode & 1)) ? *(const u32x4*)(MG + row * 1024 + col0 + bj * 128) : (u32x4){0u, 0u, 0u, 0u}; }
#else
                    gv[m][bj] = *(const u32x4*)(gb + (ai * 128 + wr * 64 + m * 16 + fr) * 256 + bj * 128);
                    pv[m][bj] = k > 0 ? *(const u32x4*)(MG + row * 1024 + col0 + bj * 128) : (u32x4){0u, 0u, 0u, 0u}; }
#endif
#pragma unroll
            for (int m = 0; m < 4; ++m)
#pragma unroll
                for (int bj = 0; bj < 2; ++bj) { const size_t row = (size_t)(u.i0 * 256 + ai * 128 + wr * 64 + m * 16 + fr); float gt[8], pr[8], v[8]; unpack8(gv[m][bj], gt); unpack8(pv[m][bj], pr);
#pragma unroll
                    for (int j = 0; j < 4; ++j) { v[j] = gt[j] * acc[ai][bj][m][0][j] + pr[j]; v[4 + j] = gt[4 + j] * acc[ai][bj][m][1][j] + pr[4 + j]; }
                    *(u32x4*)(MG + row * 1024 + col0 + bj * 128) = pack8(v); }
            asm volatile("" ::: "memory"); }
    }
};
struct EpiResid {
    static constexpr bool PERM = false;
    float* XW; const float* modacc; const float* adab;
    __device__ __forceinline__ void operator()(const f32x4 (&acc)[2][2][4][2], const GUnit& u, int wr, int wc, int fr, int fq) const {
        const int pm = u.i0, bidx = pm < 4 ? 4 : ((pm - 4) >> 4);
        const int col0 = u.i1 * 256 + wc * 32 + 4 * fq;
        f32x4 gv[2][2];
#pragma unroll
        for (int bj = 0; bj < 2; ++bj)
#pragma unroll
            for (int n = 0; n < 2; ++n) gv[bj][n] = *(const f32x4*)(modacc + bidx * 6144 + col0 + bj * 128 + n * 16) + *(const f32x4*)(adab + col0 + bj * 128 + n * 16);
#pragma unroll
        for (int ai = 0; ai < 2; ++ai) { f32x4 xv[4][2][2];
#pragma unroll
            for (int m = 0; m < 4; ++m) { const float* rp = XW + (size_t)(pm * 256 + ai * 128 + wr * 64 + m * 16 + fr) * 1024 + col0;
#pragma unroll
                for (int bj = 0; bj < 2; ++bj)
#pragma unroll
                    for (int n = 0; n < 2; ++n) xv[m][bj][n] = *(const f32x4*)(rp + bj * 128 + n * 16); }
#pragma unroll
            for (int m = 0; m < 4; ++m) { float* rp = XW + (size_t)(pm * 256 + ai * 128 + wr * 64 + m * 16 + fr) * 1024 + col0;
#pragma unroll
                for (int bj = 0; bj < 2; ++bj)
#pragma unroll
                    for (int n = 0; n < 2; ++n) *(f32x4*)(rp + bj * 128 + n * 16) = xv[m][bj][n] + gv[bj][n] * acc[ai][bj][m][n]; }
            asm volatile("" ::: "memory"); }
    }
};
struct EpiSwiglu {
    static constexpr bool PERM = true;
    bf16_t* HID;
    __device__ __forceinline__ void operator()(const f32x4 (&acc)[2][2][4][2], const GUnit& u, int wr, int wc, int fr, int fq) const {
        const int col = u.i1 * 128 + wc * 32 + 8 * fq;
        EPI_ROWS_BEGIN(u.i0 * 256)
            float v[8];
#pragma unroll
            for (int j = 0; j < 4; ++j) { v[j] = fsilu(acc[ai][0][m][0][j]) * acc[ai][1][m][0][j]; v[4 + j] = fsilu(acc[ai][0][m][1][j]) * acc[ai][1][m][1][j]; }
            *(u32x4*)(HID + (size_t)row * FFN + col) = pack8(v);
        EPI_ROWS_END
    }
};
struct EpiStoreBf16 {
    static constexpr bool PERM = true;
    bf16_t* O; int ld;
    __device__ __forceinline__ void operator()(const f32x4 (&acc)[2][2][4][2], const GUnit& u, int wr, int wc, int fr, int fq) const {
#pragma unroll
        for (int bj = 0; bj < 2; ++bj) { const int col = u.i1 * 256 + bj * 128 + wc * 32 + 8 * fq;
            EPI_ROWS_BEGIN(u.i0 * 256)
                float v[8];
#pragma unroll
                for (int j = 0; j < 4; ++j) { v[j] = acc[ai][bj][m][0][j]; v[4 + j] = acc[ai][bj][m][1][j]; }
                *(u32x4*)(O + (size_t)row * ld + col) = pack8(v);
            EPI_ROWS_END }
    }
};
#ifdef PROBE_GEMM
struct EpiNull {
    static constexpr bool PERM = false;
    float* O;
    __device__ __forceinline__ void operator()(const f32x4 (&acc)[2][2][4][2], const GUnit& u, int wr, int wc, int fr, int fq) const {
        f32x4 t = acc[0][0][0][0];
#pragma unroll
        for (int ai = 0; ai < 2; ++ai)
#pragma unroll
            for (int bj = 0; bj < 2; ++bj)
#pragma unroll
                for (int m = 0; m < 4; ++m) { t += acc[ai][bj][m][0]; t += acc[ai][bj][m][1]; }
        if (t[0] + t[1] + t[2] + t[3] == 12345.678f) O[fq] = t[0];
    }
};
#endif
struct EpiSlab {
    static constexpr bool PERM = false;
    float* SLB;
    __device__ __forceinline__ void operator()(const f32x4 (&acc)[2][2][4][2], const GUnit& u, int wr, int wc, int fr, int fq) const {
        float* base = SLB + (size_t)u.i2 * 65536 + wc * 32 + 4 * fq;
#pragma unroll
        for (int ai = 0; ai < 2; ++ai)
#pragma unroll
            for (int m = 0; m < 4; ++m) { float* rp = base + (ai * 128 + wr * 64 + m * 16 + fr) * 256;
#pragma unroll
                for (int bj = 0; bj < 2; ++bj)
#pragma unroll
                    for (int n = 0; n < 2; ++n) *(f32x4*)(rp + bj * 128 + n * 16) = acc[ai][bj][m][n]; }
    }
};
}
struct Args { const float* in[33]; float* out; unsigned char* ws; int ph_lo, ph_hi; };
typedef const __attribute__((address_space(4))) Args* ArgsP;
struct Frame {
    LAS unsigned char* lds;
    unsigned* ctl; unsigned char* ws;
    int tid, lane, wave, G, c;
    ArgsP ap;
};
enum { I_X = 0, I_C, I_CTX, I_CCTX, I_N1G, I_N2G, I_ADAW, I_ADAB, I_WIN, I_LBL, I_HGNG, I_GUP, I_GB, I_GLNG, I_SARE, I_SAIM, I_SLOG, I_SBRE, I_SBIM, I_SCRE, I_SCIM, I_SD, I_SGLU, I_BRP, I_WOUT,
       I_FW1, I_FW3, I_FW2, I_RW, I_MW1, I_MW3, I_MW2, I_FNG };

__device__ __forceinline__ void tr_load(const float* W, int ldw, int scol0, int k0, int lane, float (&r)[32]) {
#pragma unroll
    for (int i = 0; i < 32; ++i) r[i] = W[(size_t)(k0 + 2 * i + (lane >> 5)) * ldw + scol0 + (lane & 31)];
}
__device__ __forceinline__ void tr_store(const float (&r)[32], bf16_t* WT, int K, int drow0, int k0, LAS float* scr, int lane) {
#pragma unroll
    for (int i = 0; i < 32; ++i) scr[(2 * i + (lane >> 5)) * 33 + (lane & 31)] = r[i];
    LDS_WAIT(); asm volatile("" ::: "memory");
    const int c = lane & 7;
#pragma unroll
    for (int j = 0; j < 4; ++j) { const int n = (lane >> 3) + 8 * j; const LAS float* s = scr + (8 * c) * 33 + n;
        u32x4 o; o.x = pk2(s[0 * 33], s[1 * 33]); o.y = pk2(s[2 * 33], s[3 * 33]); o.z = pk2(s[4 * 33], s[5 * 33]); o.w = pk2(s[6 * 33], s[7 * 33]);
        *(u32x4*)(WT + (size_t)(drow0 + n) * K + k0 + 8 * c) = o; }
    LDS_WAIT(); asm volatile("" ::: "memory");
}
__device__ __forceinline__ void tr_load4(const float* W, int ldw, int scol0, int k0, int lane, f32x4 (&r)[8]) {
#pragma unroll
    for (int i = 0; i < 8; ++i) r[i] = *(const f32x4*)(W + (size_t)(k0 + 8 * i + (lane >> 3)) * ldw + scol0 + 4 * (lane & 7));
}
__device__ __forceinline__ void tr_store4(const f32x4 (&r)[8], bf16_t* WT, int K, int drow0, int k0, LAS float* scr, int lane) {
#pragma unroll
    for (int i = 0; i < 8; ++i)
#pragma unroll
        for (int j = 0; j < 4; ++j) scr[(8 * i + (lane >> 3)) * 33 + 4 * (lane & 7) + j] = r[i][j];
    LDS_WAIT(); asm volatile("" ::: "memory");
    const int c = lane & 7;
#pragma unroll
    for (int j = 0; j < 4; ++j) { const int n = (lane >> 3) + 8 * j; const LAS float* s = scr + (8 * c) * 33 + n;
        u32x4 o; o.x = pk2(s[0 * 33], s[1 * 33]); o.y = pk2(s[2 * 33], s[3 * 33]); o.z = pk2(s[4 * 33], s[5 * 33]); o.w = pk2(s[6 * 33], s[7 * 33]);
        *(u32x4*)(WT + (size_t)(drow0 + n) * K + k0 + 8 * c) = o; }
    LDS_WAIT(); asm volatile("" ::: "memory");
}
__device__ __forceinline__ void tr_job(Frame& F, int& base, const float* W, int ldw, int scol0, int ncols, int K, bf16_t* WT, int drow0, int dmap) {
    const int gw = F.c * 8 + F.wave, NGW = F.G * 8, nblk = ncols / 32, nitems = (K / 64) * nblk;
    LAS float* scr = (LAS float*)(F.lds + F.wave * 16384);
    int first = gw - (base % NGW); if (first < 0) first += NGW;
    float ra[32], rb[32];
    int it = first;
    if (it < nitems) tr_load(W, ldw, scol0 + (it % nblk) * 32, (it / nblk) * 64, F.lane, ra);
    while (it < nitems) {
        const int nx = it + NGW;
        if (nx < nitems) tr_load(W, ldw, scol0 + (nx % nblk) * 32, (nx / nblk) * 64, F.lane, rb);
        { const int n0 = (it % nblk) * 32; const int dr = dmap == 0 ? drow0 + n0 : drow0 + (n0 >> 7) * 256 + (n0 & 127); tr_store(ra, WT, K, dr, (it / nblk) * 64, scr, F.lane); }
        it = nx;
        if (it >= nitems) break;
        const int nx2 = it + NGW;
        if (nx2 < nitems) tr_load(W, ldw, scol0 + (nx2 % nblk) * 32, (nx2 / nblk) * 64, F.lane, ra);
        { const int n0 = (it % nblk) * 32; const int dr = dmap == 0 ? drow0 + n0 : drow0 + (n0 >> 7) * 256 + (n0 & 127); tr_store(rb, WT, K, dr, (it / nblk) * 64, scr, F.lane); }
        it = nx2;
    }
    base += nitems;
}

struct cplx { float re, im; };
__device__ __forceinline__ cplx cmul(cplx a, cplx b) { return {a.re * b.re - a.im * b.im, a.re * b.im + a.im * b.re}; }
__device__ __forceinline__ cplx s5_pow(float are, float aim, float dt, int j) {
    const float mag = __expf((float)j * are * dt);
    double ang = (double)j * (double)aim * (double)dt; ang -= 6.283185307179586476925 * rint(ang * 0.15915494309189533577);
    const float sn = sinf((float)ang), cs = cosf((float)ang);
    return {mag * cs, mag * sn};
}
__device__ __forceinline__ cplx s5_z(float are, float aim, float dt) {
    const float x = are * dt; double ang = (double)aim * (double)dt; ang -= 6.283185307179586476925 * rint(ang * 0.15915494309189533577);
    const float th = (float)ang, sh = sinf(0.5f * th), em1 = expm1f(x), ex = em1 + 1.0f;
    const float cm1 = -2.0f * sh * sh;
    const float nre = em1 * (1.0f + cm1) + cm1, nim = ex * sinf(th);
    const float den = are * are + aim * aim;
    return {(nre * are + nim * aim) / den, (nim * are - nre * aim) / den};
}
constexpr size_t WS_S5PW = WS_BIG + 334 * MiB;
constexpr size_t WS_S5KT = WS_BIG + 338 * MiB;
constexpr size_t WS_S5BB = WS_BIG + 342 * MiB;
static_assert(WS_S5BB + 1 * MiB <= WS_END, "ws");

__device__ __forceinline__ void s5_tables(Frame& F) {
    float* PW = (float*)(F.ws + WS_S5PW); float* KT = (float*)(F.ws + WS_S5KT);
    LAS float* spw = (LAS float*)F.lds;
    LAS float* sbb = spw + 9 * 128;
    LAS float* scc = sbb + 2048;
    for (int it = F.c; it < 2 * 2 * 32 * 4; it += F.G) {
        const int jq = it & 3, g = (it >> 2) & 31, d = (it >> 7) & 1, l = it >> 8, ldg = (l * 2 + d) * 32 + g, j0 = jq * 8;
        const float dt = __expf(F.ap->in[I_SLOG][ldg]);
        __syncthreads();
        for (int u = F.tid; u < 9 * 64; u += NTHREADS) { const int j = j0 + u / 64, n = u % 64; if (j <= 32) { const cplx p = s5_pow(F.ap->in[I_SARE][ldg * 64 + n], F.ap->in[I_SAIM][ldg * 64 + n], dt, j);
            spw[u * 2] = p.re; spw[u * 2 + 1] = p.im; PW[((size_t)ldg * 33 + j) * 128 + n * 2] = p.re; PW[((size_t)ldg * 33 + j) * 128 + n * 2 + 1] = p.im; } }
        for (int u = F.tid; u < 1024; u += NTHREADS) { const int n = u >> 4, p = u & 15; const cplx z = s5_z(F.ap->in[I_SARE][ldg * 64 + n], F.ap->in[I_SAIM][ldg * 64 + n], dt);
            const cplx b = {F.ap->in[I_SBRE][(size_t)ldg * 1024 + u], F.ap->in[I_SBIM][(size_t)ldg * 1024 + u]}; const cplx bb = cmul(z, b); sbb[u * 2] = bb.re; sbb[u * 2 + 1] = bb.im; if (jq == 0) { float* BB = (float*)(F.ws + WS_S5BB); BB[((size_t)ldg * 1024 + u) * 2] = bb.re; BB[((size_t)ldg * 1024 + u) * 2 + 1] = bb.im; }
            const int pp = u >> 6, nn = u & 63; scc[u * 2] = F.ap->in[I_SCRE][(size_t)ldg * 1024 + pp * 64 + nn]; scc[u * 2 + 1] = F.ap->in[I_SCIM][(size_t)ldg * 1024 + pp * 64 + nn]; }
        __syncthreads();
#pragma unroll
        for (int e = 0; e < 4; ++e) { const int u = F.tid + e * NTHREADS, jj = u >> 8, p = (u >> 4) & 15, q = u & 15; float s = 0.f;
            for (int n = 0; n < 64; ++n) { const cplx c = {scc[(p * 64 + n) * 2], scc[(p * 64 + n) * 2 + 1]}, w = {spw[(jj * 64 + n) * 2], spw[(jj * 64 + n) * 2 + 1]}, b = {sbb[(n * 16 + q) * 2], sbb[(n * 16 + q) * 2 + 1]};
                const cplx cw = cmul(c, w); s += cw.re * b.re - cw.im * b.im; }
            KT[((size_t)ldg * 32 + j0 + jj) * 256 + p * 16 + q] = s; }
    }
    __syncthreads();
}
__device__ __forceinline__ void s5_task_T(Frame& F, const int l, const unsigned t) {
    const float* KT = (const float*)(F.ws + WS_S5KT); bf16_t* BC = (bf16_t*)(F.ws + WS_S5C);
    const int qh = (int)(t & 1), m2 = (int)((t >> 1) & 31), row = (int)((t >> 6) & 511), g = (int)(t >> 15), m = row >> 4, p = row & 15;
    float v[8];
#pragma unroll
    for (int j = 0; j < 8; ++j) v[j] = 0.f;
    if (m2 <= m) { const float* k = KT + ((size_t)((l * 2 + 0) * 32 + g) * 32 + (m - m2)) * 256 + p * 16 + qh * 8;
#pragma unroll
        for (int j = 0; j < 8; ++j) v[j] += k[j]; }
    if (m2 >= m) { const float* k = KT + ((size_t)((l * 2 + 1) * 32 + g) * 32 + (m2 - m)) * 256 + p * 16 + qh * 8;
#pragma unroll
        for (int j = 0; j < 8; ++j) v[j] += k[j]; }
    if (m2 == m && (p >> 3) == qh) v[p & 7] += F.ap->in[I_SD][l * 512 + g * 16 + p];
    *(u32x4*)(BC + ((size_t)(g * 512 + row)) * 768 + m2 * 16 + qh * 8) = epi::pack8(v);
}
__device__ __forceinline__ void s5_task_W(Frame& F, const int l, const unsigned t) {
    const float* PW = (const float*)(F.ws + WS_S5PW); bf16_t* BC = (bf16_t*)(F.ws + WS_S5C);
    const int n8 = (int)(t & 7), c = (int)((t >> 3) & 1), d = (int)((t >> 4) & 1), row = (int)((t >> 5) & 511), g = (int)(t >> 14), m = row >> 4, p = row & 15;
    const int ldg = (l * 2 + d) * 32 + g, e = d == 0 ? m + 1 : 32 - m; float v[8];
#pragma unroll
    for (int j = 0; j < 8; ++j) { const int n = n8 * 8 + j; const cplx cc = {F.ap->in[I_SCRE][(size_t)ldg * 1024 + p * 64 + n], F.ap->in[I_SCIM][(size_t)ldg * 1024 + p * 64 + n]};
        const cplx w = {PW[((size_t)ldg * 33 + e) * 128 + n * 2], PW[((size_t)ldg * 33 + e) * 128 + n * 2 + 1]}; const cplx cw = cmul(cc, w); v[j] = c == 0 ? cw.re : -cw.im; }
    *(u32x4*)(BC + ((size_t)(g * 512 + row)) * 768 + 512 + d * 128 + c * 64 + n8 * 8) = epi::pack8(v);
}
__device__ __forceinline__ void s5_task_V(Frame& F, const int l, const unsigned t) {
    const float* PW = (const float*)(F.ws + WS_S5PW); const float* BB = (const float*)(F.ws + WS_S5BB); bf16_t* VT = (bf16_t*)(F.ws + WS_S5V);
    const int qh = (int)(t & 1), m2 = (int)((t >> 1) & 31), vr = (int)((t >> 6) & 255), g = (int)(t >> 14), d = vr >> 7, c = (vr >> 6) & 1, n = vr & 63;
    const int ldg = (l * 2 + d) * 32 + g, e = d == 0 ? 31 - m2 : m2;
    const cplx w = {PW[((size_t)ldg * 33 + e) * 128 + n * 2], PW[((size_t)ldg * 33 + e) * 128 + n * 2 + 1]}; float v[8];
    const float* bp = BB + ((size_t)ldg * 1024 + n * 16 + qh * 8) * 2;
#pragma unroll
    for (int j = 0; j < 8; ++j) { const cplx b = {bp[j * 2], bp[j * 2 + 1]}; const cplx r = cmul(w, b); v[j] = c == 0 ? r.re : r.im; }
    *(u32x4*)(VT + ((size_t)(g * 256 + vr)) * 512 + m2 * 16 + qh * 8) = epi::pack8(v);
}
template <int L>
__device__ __forceinline__ void bg_s5fill(Frame& F) {
    volatile LAS unsigned* slot = (volatile LAS unsigned*)(F.lds + LDS_MISC + 64);
    for (;;) {
        __syncthreads();
        if (F.tid == 0) slot[0] = __hip_atomic_fetch_add(F.ctl + CW_WQ + 64 * (7 + L), 1u, __ATOMIC_RELAXED, __HIP_MEMORY_SCOPE_AGENT);
        __syncthreads();
        const unsigned blk = slot[0]; if (blk >= 1024u) break;
        if (blk < 512u) { for (int u = 0; u < 4; ++u) s5_task_T(F, L, (blk * 4 + u) * NTHREADS + F.tid); }
        else if (blk < 768u) { for (int u = 0; u < 4; ++u) s5_task_W(F, L, ((blk - 512u) * 4 + u) * NTHREADS + F.tid); }
        else { for (int u = 0; u < 4; ++u) s5_task_V(F, L, ((blk - 768u) * 4 + u) * NTHREADS + F.tid); }
    }
    __syncthreads();
}

struct ConvItem { const float* W; bf16_t* WT; int ldw, scol, ldo, drow, k0; };
__device__ __forceinline__ ConvItem small_item(Frame& F, int l, int it) {
    ConvItem m; const float* win = F.ap->in[I_WIN] + (size_t)l * D * N_IN; bf16_t* wm = (bf16_t*)(F.ws + WS_WMIX) + (size_t)l * NMIX * D; int nblk, loc;
    if (it < 1792) { loc = it; nblk = 112; m.W = win; m.ldw = N_IN; m.scol = 0; m.WT = wm; m.ldo = D; m.drow = 0; }
    else if (it < 2048) { loc = it - 1792; nblk = 16; m.W = win; m.ldw = N_IN; m.scol = 3616; m.WT = wm; m.ldo = D; m.drow = 4096; }
    else if (it < 2304) { loc = it - 2048; nblk = 16; m.W = win; m.ldw = N_IN; m.scol = 4128; m.WT = wm; m.ldo = D; m.drow = 4608; }
    else if (it < 3840) { loc = it - 2304; nblk = 96; m.W = win; m.ldw = N_IN; m.scol = 4640; m.WT = (bf16_t*)(F.ws + WS_WGATE) + (size_t)l * NGATE * D; m.ldo = D; m.drow = 0; }
    else if (it < 4608) { const int k = (it - 3840) >> 8; loc = (it - 3840) & 255; nblk = 32; m.W = F.ap->in[I_BRP] + (size_t)(l * 3 + k) * 512 * D; m.ldw = D; m.scol = 0; m.WT = (bf16_t*)(F.ws + WS_WBR) + (size_t)(l * 3 + k) * D * 512; m.ldo = 512; m.drow = 0; }
    else if (it < 5120) { loc = it - 4608; nblk = 32; m.W = F.ap->in[I_WOUT] + (size_t)l * D * D; m.ldw = D; m.scol = 0; m.WT = (bf16_t*)(F.ws + WS_WOUT) + (size_t)l * D * D; m.ldo = D; m.drow = 0; }
    else { loc = it - 5120; nblk = 16; m.W = F.ap->in[I_SGLU] + (size_t)l * 512 * 512; m.ldw = 512; m.scol = 0; m.WT = (bf16_t*)(F.ws + WS_WGLU) + (size_t)l * 512 * 512; m.ldo = 512; m.drow = 0; }
    const int nb = loc % nblk, kb = loc / nblk; m.scol += nb * 32; m.drow += nb * 32; m.k0 = kb * 64; return m;
}
__device__ __forceinline__ ConvItem ffn_item(Frame& F, int it) {
    ConvItem m; const int mat = it / 1792, loc = it % 1792;
    if (mat < 2) { const int nb = loc % 112, kb = loc / 112, n0 = nb * 32; m.W = F.ap->in[mat == 0 ? I_FW1 : I_FW3]; m.ldw = FFN; m.scol = n0; m.WT = (bf16_t*)(F.ws + WS_W13); m.ldo = D; m.drow = (n0 >> 7) * 256 + (n0 & 127) + (mat == 0 ? 0 : 128); m.k0 = kb * 64; }
    else { const int nb = loc % 32, kb = loc / 32; m.W = F.ap->in[I_FW2]; m.ldw = D; m.scol = nb * 32; m.WT = (bf16_t*)(F.ws + WS_W2); m.ldo = FFN; m.drow = nb * 32; m.k0 = kb * 64; }
    return m;
}
__device__ __forceinline__ ConvItem moe2_item(Frame& F, int it) {
    ConvItem m; const int e = it / 1792, loc = it % 1792, nb = loc % 32, kb = loc / 32;
    m.W = F.ap->in[I_MW2] + (size_t)e * FFN * D; m.ldw = D; m.scol = nb * 32; m.WT = (bf16_t*)(F.ws + WS_MW2) + (size_t)e * D * FFN; m.ldo = FFN; m.drow = nb * 32; m.k0 = kb * 64; return m;
}
template <int SET>
__device__ __forceinline__ void bg_drain(Frame& F) {
    constexpr int NITEMS = SET == 1 ? 8320 : (SET == 2 ? 5248 : 14336), NBLK = NITEMS / 8;
    LAS float* scr = (LAS float*)(F.lds + F.wave * 16384);
    volatile LAS unsigned* slot = (volatile LAS unsigned*)(F.lds + LDS_MISC + 64);
    float ra[32];
    int lane = F.lane; asm volatile("" : "+v"(lane));
    for (;;) {
        __syncthreads();
        if (F.tid == 0) slot[0] = __hip_atomic_fetch_add(F.ctl + CW_WQ + 64 * (3 + SET), 1u, __ATOMIC_RELAXED, __HIP_MEMORY_SCOPE_AGENT);
        __syncthreads();
        const int blk = (int)slot[0]; if (blk >= NBLK) break;
        const int it = blk * 8 + F.wave; ConvItem m;
        if (SET == 1) m = it < 2944 ? small_item(F, 0, 2304 + it) : ffn_item(F, it - 2944); else if (SET == 2) m = small_item(F, 1, it); else m = moe2_item(F, it);
        tr_load(m.W, m.ldw, m.scol, m.k0, lane, ra); tr_store(ra, m.WT, m.ldo, m.drow, m.k0, scr, lane);
    }
    __syncthreads();
}

__device__ __forceinline__ void phase_pre(Frame& F) {
    { const int gw = F.c * 8 + F.wave, NGW = F.G * 8; LAS float* scr = (LAS float*)(F.lds + F.wave * 16384); float ra[32];
        for (int it = gw; it < 2304; it += NGW) { const ConvItem m = small_item(F, 0, it); tr_load(m.W, m.ldw, m.scol, m.k0, F.lane, ra); tr_store(ra, m.WT, m.ldo, m.drow, m.k0, scr, F.lane); } }
    __syncthreads();
    const size_t gt = (size_t)F.c * NTHREADS + F.tid, NT = (size_t)F.G * NTHREADS;
    for (size_t t = gt; t < (size_t)2 * 2 * 256 * 128; t += NT) {
        const int k8 = (int)(t & 127), n = (int)((t >> 7) & 255), dir = (int)((t >> 15) & 1), l = (int)(t >> 16);
        const float* win = F.ap->in[I_WIN] + (size_t)l * D * N_IN + 3584 + 16 * dir; const float* up = F.ap->in[I_GUP] + (size_t)((l * 2 + dir) * 16) * 256 + n;
        float upv[16];
#pragma unroll
        for (int r = 0; r < 16; ++r) upv[r] = up[r * 256];
        float v[8];
#pragma unroll
        for (int j = 0; j < 8; ++j) { const float* wr = win + (size_t)(k8 * 8 + j) * N_IN; float s = 0.f;
#pragma unroll
            for (int r = 0; r < 16; ++r) s += wr[r] * upv[r];
            v[j] = s; }
        *(u32x4*)((bf16_t*)(F.ws + WS_WMIX) + ((size_t)l * NMIX + 3584 + 256 * dir + n) * D + k8 * 8) = epi::pack8(v);
    }
    {
        LAS float* cond = (LAS float*)F.lds;
        for (int u = F.tid; u < 5 * 1024; u += NTHREADS) { const int b = u >> 10, k = u & 1023; const float c = b < 4 ? F.ap->in[I_C][b * 1024 + k] : F.ap->in[I_CCTX][k]; cond[u] = fsilu(c); }
        __syncthreads();
        float* modacc = (float*)(F.ctl + CW_MOD);
        LAS float* red = cond + 5 * 1024;
        for (int blk = F.c; blk < 256; blk += F.G) {
            const int l = blk >> 7, col0 = (blk & 127) * 48;
            if (F.tid < 384) { const int cj = F.tid % 48, ks = F.tid / 48;
                const float* w = F.ap->in[I_ADAW] + (size_t)l * D * 6144 + (size_t)(ks * 128) * 6144 + col0 + cj; float a[5] = {0.f, 0.f, 0.f, 0.f, 0.f};
                for (int k0 = 0; k0 < 128; k0 += 32) { float wv[32];
#pragma unroll
                    for (int k = 0; k < 32; ++k) wv[k] = w[(size_t)(k0 + k) * 6144];
#pragma unroll
                    for (int k = 0; k < 32; ++k)
#pragma unroll
                        for (int b = 0; b < 5; ++b) a[b] += cond[b * 1024 + ks * 128 + k0 + k] * wv[k]; }
#pragma unroll
                for (int b = 0; b < 5; ++b) red[(ks * 48 + cj) * 5 + b] = a[b]; }
            __syncthreads();
            if (F.tid < 240) { const int cj = F.tid % 48, b = F.tid / 48; float sacc = 0.f;
#pragma unroll
                for (int ks = 0; ks < 8; ++ks) sacc += red[(ks * 48 + cj) * 5 + b];
                modacc[(l * 5 + b) * 6144 + col0 + cj] = sacc; }
            __syncthreads();
        }
        __syncthreads();
    }
    if (F.c == 0) { float* lbp = (float*)(F.ctl + CW_LB);
        for (int ch = F.tid; ch < 512; ch += NTHREADS) { const float l0 = F.ap->in[I_LBL][ch], l1 = F.ap->in[I_LBL][512 + ch];
            lbp[ch] = 0.f; lbp[1024 + ch] = 1.0f;
            lbp[512 + ch] = fsigmoid(l1 - l0); lbp[1024 + 512 + ch] = fsigmoid(l0 - l1); } }
    { float* PT = (float*)(F.ctl + CW_POS);
        for (size_t t = gt; t < (size_t)64 * 512; t += NT) { const int pp = (int)(t >> 9), q = (int)(t & 511), i = q & 255; const float om = exp2f(-(float)i * (13.287712379549449f / 256.0f)), a = (float)pp * om; PT[t] = q < 256 ? sinf(a) : cosf(a); } }
    s5_tables(F);
}

constexpr int RT_OFF = 5 * 2048 * 4, RT_SLOTS = 16;
__device__ __forceinline__ void route_write(Frame& F, int tok, int i1, int i2, int rk1, int rk2, float w1, float w2) {
    int* te = (int*)(F.ctl + CW_TOKE); int* tr = (int*)(F.ctl + CW_TOKR); float* tw = (float*)(F.ctl + CW_TOKW);
    te[tok * 2] = i1; te[tok * 2 + 1] = i2; tr[tok * 2] = rk1; tr[tok * 2 + 1] = rk2; tw[tok * 2] = w1; tw[tok * 2 + 1] = w2;
    int* pm2 = (int*)(F.ctl + CW_PERM2); pm2[i1 * 16384 + rk1] = tok; pm2[i2 * 16384 + rk2] = tok;
}
template <int MODE>
__device__ __forceinline__ void norm_load(Frame& F, int row, f32x4 (&v)[4]) {
    const int lane = F.lane; const float* XW = (const float*)(F.ws + WS_XW);
    if (MODE == 0) {
        if (row < MCTX) {
#pragma unroll
            for (int j = 0; j < 4; ++j) v[j] = *(const f32x4*)(F.ap->in[I_CTX] + (size_t)row * D + 4 * lane + 256 * j);
        } else { const int rl = row - MCTX;
#pragma unroll
            for (int j = 0; j < 4; ++j) v[j] = *(const f32x4*)(F.ap->in[I_X] + (size_t)rl * D + 4 * lane + 256 * j); }
    } else {
#pragma unroll
        for (int j = 0; j < 4; ++j) v[j] = *(const f32x4*)(XW + (size_t)row * D + 4 * lane + 256 * j);
    }
}
template <int MODE>
__device__ __forceinline__ void norm_finish(Frame& F, int row, f32x4 (&v)[4], const int slot = -1) {
    const int bidx = row < MCTX ? 4 : ((row - MCTX) >> 12); const LAS float* GA = (const LAS float*)F.lds + bidx * 2048;
    float* XW = (float*)(F.ws + WS_XW); bf16_t* H = (bf16_t*)(F.ws + WS_H);
    const int lane = F.lane;
    if (MODE == 0) {
        if (row >= MCTX) { const int rl = row - MCTX, t = rl & 4095; const float* PT = (const float*)(F.ctl + CW_POS);
#pragma unroll
            for (int j = 0; j < 4; ++j) v[j] = v[j] + *(const f32x4*)(PT + ((j < 2 ? (t >> 6) : (t & 63)) * 512 + (j & 1) * 256 + 4 * lane)); }
#pragma unroll
        for (int j = 0; j < 4; ++j) *(f32x4*)(XW + (size_t)row * D + 4 * lane + 256 * j) = v[j];
    }
    float ss = 0.f;
#pragma unroll
    for (int j = 0; j < 4; ++j) ss += (v[j][0] * v[j][0] + v[j][1] * v[j][1]) + (v[j][2] * v[j][2] + v[j][3] * v[j][3]);
    const float rstd = 1.0f / sqrtf(wave_sum(ss) * (1.0f / D) + EPS);
    float lg[8];
#pragma unroll
    for (int e = 0; e < 8; ++e) lg[e] = 0.f;
#pragma unroll
    for (int j = 0; j < 4; ++j) { const int d0 = 4 * lane + 256 * j;
        const f32x4 h = (v[j] * rstd) * *(const LAS f32x4*)(GA + d0) + *(const LAS f32x4*)(GA + 1024 + d0);
        u32x2 w; w.x = pk2(h[0], h[1]); w.y = pk2(h[2], h[3]);
        *(u32x2*)(H + (size_t)row * D + d0) = w;
        if (MODE == 2) {
#pragma unroll
            for (int e = 0; e < 4; ++e) { const f32x4 r0v = *(const f32x4*)(F.ap->in[I_RW] + (size_t)(d0 + e) * 8), r1v = *(const f32x4*)(F.ap->in[I_RW] + (size_t)(d0 + e) * 8 + 4);
                lg[0] += h[e] * r0v[0]; lg[1] += h[e] * r0v[1]; lg[2] += h[e] * r0v[2]; lg[3] += h[e] * r0v[3]; lg[4] += h[e] * r1v[0]; lg[5] += h[e] * r1v[1]; lg[6] += h[e] * r1v[2]; lg[7] += h[e] * r1v[3]; } }
    }
    if (MODE == 2) {
#pragma unroll
        for (int e = 0; e < 8; ++e) lg[e] = wave_sum(lg[e]);
        if (lane == 0) {
            int i1 = 0; float m1 = lg[0];
#pragma unroll
            for (int e = 1; e < 8; ++e) if (lg[e] > m1) { m1 = lg[e]; i1 = e; }
            int i2 = -1; float m2 = -3.0e38f;
#pragma unroll
            for (int e = 0; e < 8; ++e) if (e != i1 && lg[e] > m2) { m2 = lg[e]; i2 = e; }
            const float w1 = 1.0f / (1.0f + __expf(m2 - m1)), w2 = 1.0f - w1;
            const int tok = row - MCTX;
            if (slot >= 0) {
                LAS unsigned* lc = (LAS unsigned*)(F.lds + RT_OFF);
                const unsigned l1 = __hip_atomic_fetch_add(lc + i1, 1u, __ATOMIC_RELAXED, __HIP_MEMORY_SCOPE_WORKGROUP), l2 = __hip_atomic_fetch_add(lc + i2, 1u, __ATOMIC_RELAXED, __HIP_MEMORY_SCOPE_WORKGROUP);
                LAS int* ent = (LAS int*)(F.lds + RT_OFF + 128) + (F.wave * RT_SLOTS + slot) * 8;
                ent[0] = tok; ent[1] = i1; ent[2] = i2; ent[3] = (int)l1; ent[4] = (int)l2; ent[5] = __float_as_int(w1); ent[6] = __float_as_int(w2);
            } else {
                const int rk1 = (int)atomicAdd(F.ctl + CW_MOECNT + 64 * i1, 1u), rk2 = (int)atomicAdd(F.ctl + CW_MOECNT + 64 * i2, 1u);
                route_write(F, tok, i1, i2, rk1, rk2, w1, w2); }
        }
    }
}
template <int MODE>
__device__ __forceinline__ void norm_rows(Frame& F, int l, int moff  , const float* gain) {
    const float* modacc = (const float*)(F.ctl + CW_MOD) + (size_t)l * 5 * 6144; const float* adab = F.ap->in[I_ADAB] + (size_t)l * 6144;
    LAS float* GA = (LAS float*)F.lds;
    for (int u = F.tid; u < 5 * 1024; u += NTHREADS) { const int b = u >> 10, dd = u & 1023;
        const float sh = modacc[b * 6144 + moff + dd] + adab[moff + dd], sc = modacc[b * 6144 + moff + 1024 + dd] + adab[moff + 1024 + dd];
        GA[b * 2048 + dd] = gain[dd] * (sc + 1.0f); GA[b * 2048 + 1024 + dd] = sh; }
    const int gw = F.c * 8 + F.wave, NGW = F.G * 8;
    const int r0 = MODE == 2 ? MCTX : 0;
    const bool agg = MODE == 2 && (MLAT + NGW - 1) / NGW <= RT_SLOTS;
    if (MODE == 2 && F.tid < 16) ((LAS unsigned*)(F.lds + RT_OFF))[F.tid] = 0u;
    __syncthreads();
    for (int row = r0 + gw; row < M; row += 2 * NGW) {
        const int rowB = row + NGW; const bool hasB = rowB < M;
        f32x4 va[4], vb[4];
        norm_load<MODE>(F, row, va);
        if (hasB) norm_load<MODE>(F, rowB, vb);
        const int slot = agg ? (row - r0 - gw) / NGW : -1;
        norm_finish<MODE>(F, row, va, slot);
        if (hasB) norm_finish<MODE>(F, rowB, vb, agg ? slot + 1 : -1);
    }
    __syncthreads();
    if (MODE == 2 && agg) {
        LAS unsigned* lc = (LAS unsigned*)(F.lds + RT_OFF);
        if (F.tid < 8) lc[8 + F.tid] = lc[F.tid] ? atomicAdd(F.ctl + CW_MOECNT + 64 * F.tid, lc[F.tid]) : 0u;
        __syncthreads();
        if (F.tid < 8 * RT_SLOTS) { const int w = F.tid / RT_SLOTS, k = F.tid % RT_SLOTS;
            if (F.c * 8 + w + k * NGW < MLAT) { const LAS int* ent = (const LAS int*)(F.lds + RT_OFF + 128) + F.tid * 8;
                const int i1 = ent[1], i2 = ent[2];
                route_write(F, ent[0], i1, i2, (int)lc[8 + i1] + ent[3], (int)lc[8 + i2] + ent[4], __int_as_float(ent[5]), __int_as_float(ent[6])); } }
        __syncthreads();
    }
}

struct MoeSeg { int cnt[NE], tstart[NE + 1]; };
__device__ __forceinline__ void moe_seg(Frame& F, MoeSeg& s) {
    int acc = 0;
#pragma unroll
    for (int e = 0; e < NE; ++e) { const int c = (int)__hip_atomic_load(F.ctl + CW_MOECNT + 64 * e, __ATOMIC_RELAXED, __HIP_MEMORY_SCOPE_AGENT); s.cnt[e] = c; s.tstart[e] = acc; acc += (c + 255) >> 8; }
    s.tstart[NE] = acc;
}
__device__ __forceinline__ void moe_scatter(Frame& F) {
    MoeSeg s; moe_seg(F, s);
    const int* te = (const int*)(F.ctl + CW_TOKE); const int* tr = (const int*)(F.ctl + CW_TOKR); int* perm = (int*)(F.ctl + CW_PERM);
    for (int t = F.c * NTHREADS + F.tid; t < 2 * MLAT; t += F.G * NTHREADS) { const int e = te[t], rk = tr[t]; int ts = 0;
#pragma unroll
        for (int k = 0; k < NE; ++k) ts = (e == k) ? s.tstart[k] : ts;
        perm[ts * 256 + rk] = t >> 1; }
}
struct MoeItem { const float* W; bf16_t* WT; int ldw, scol, K, drow, k0; };
__device__ __forceinline__ MoeItem moe_item(Frame& F, int it) {
    const int job = it / 1792, loc = it % 1792, e = job / 2, mat = job % 2; MoeItem m;
    if (mat < 2) { const int nb = loc % 112, kb = loc / 112, n0 = nb * 32; m.W = F.ap->in[mat == 0 ? I_MW1 : I_MW3] + (size_t)e * D * FFN; m.ldw = FFN; m.scol = n0; m.K = D; m.k0 = kb * 64;
        m.WT = (bf16_t*)(F.ws + WS_MW13) + (size_t)e * 7168 * D; m.drow = (n0 >> 7) * 256 + (n0 & 127) + (mat == 0 ? 0 : 128); }
    else { const int nb = loc % 32, kb = loc / 32; m.W = F.ap->in[I_MW2] + (size_t)e * FFN * D; m.ldw = D; m.scol = nb * 32; m.K = FFN; m.k0 = kb * 64; m.WT = (bf16_t*)(F.ws + WS_MW2) + (size_t)e * D * FFN; m.drow = nb * 32; }
    return m;
}
__device__ __forceinline__ void moe_convert(Frame& F, const int pmode = 0) {
    const int gw = F.c * 8 + F.wave, NGW = F.G * 8, nitems = NE * 2 * 1792;
    LAS float* scr = (LAS float*)(F.lds + F.wave * 16384);
    f32x4 ra[8], rb[8], rc[8];
    if (pmode & 1) { for (int i = 0; i < 8; ++i) { ra[i] = (f32x4){1.f, 2.f, 3.f, 4.f}; rb[i] = ra[i]; rc[i] = ra[i]; } }
    if (pmode & 4) return;
    int it = gw;
#define MC_LOAD(buf, i) do { if ((i) < nitems && !(pmode & 1)) { const MoeItem m_ = moe_item(F, (i)); tr_load4(m_.W, m_.ldw, m_.scol, m_.k0, F.lane, buf); } } while (0)
#define MC_STORE(buf, i) do { const MoeItem m_ = moe_item(F, (i)); if (!(pmode & 2)) tr_store4(buf, m_.WT, m_.K, m_.drow, m_.k0, scr, F.lane); else if (buf[0][0] == 1.2345e-30f) m_.WT[0] = (bf16_t)1; } while (0)
    MC_LOAD(ra, it); MC_LOAD(rb, it + NGW);
    while (it < nitems) {
        MC_LOAD(rc, it + 2 * NGW); MC_STORE(ra, it); it += NGW; if (it >= nitems) break;
        MC_LOAD(ra, it + 2 * NGW); MC_STORE(rb, it); it += NGW; if (it >= nitems) break;
        MC_LOAD(rb, it + 2 * NGW); MC_STORE(rc, it); it += NGW;
    }
#undef MC_LOAD
#undef MC_STORE
    __syncthreads();
}
__device__ __forceinline__ void phase_final(Frame& F) {
    MoeSeg s; moe_seg(F, s);
    const float* XW = (const float*)(F.ws + WS_XW); const bf16_t* SL = (const bf16_t*)(F.ws + WS_SLAB);
    const float* modacc = (const float*)(F.ctl + CW_MOD) + (size_t)1 * 5 * 6144; const float* adab = F.ap->in[I_ADAB] + (size_t)1 * 6144;
    const int* te = (const int*)(F.ctl + CW_TOKE); const int* tr = (const int*)(F.ctl + CW_TOKR); const float* tw = (const float*)(F.ctl + CW_TOKW);
    const int gw = F.c * 8 + F.wave, NGW = F.G * 8, lane = F.lane;
    for (int tok = gw; tok < MLAT; tok += NGW) {
        const int row = MCTX + tok, bidx = tok >> 12; int pos[2];
#pragma unroll
        for (int sl = 0; sl < 2; ++sl) { const int e = __hip_atomic_load(te + tok * 2 + sl, __ATOMIC_RELAXED, __HIP_MEMORY_SCOPE_AGENT); int ts = 0;
#pragma unroll
            for (int k = 0; k < NE; ++k) ts = (e == k) ? s.tstart[k] : ts;
            pos[sl] = ts * 256 + __hip_atomic_load(tr + tok * 2 + sl, __ATOMIC_RELAXED, __HIP_MEMORY_SCOPE_AGENT); }
        const float w0 = __hip_atomic_load(tw + tok * 2, __ATOMIC_RELAXED, __HIP_MEMORY_SCOPE_AGENT), w1 = __hip_atomic_load(tw + tok * 2 + 1, __ATOMIC_RELAXED, __HIP_MEMORY_SCOPE_AGENT);
        f32x4 v[4]; float ss = 0.f;
#pragma unroll
        for (int j = 0; j < 4; ++j) { const int d0 = 4 * lane + 256 * j;
            const f32x4 g2 = *(const f32x4*)(modacc + bidx * 6144 + 5120 + d0) + *(const f32x4*)(adab + 5120 + d0);
            const u32x2 a = *(const u32x2*)(SL + (size_t)pos[0] * D + d0), b = *(const u32x2*)(SL + (size_t)pos[1] * D + d0);
            f32x4 fa, fb; fa[0] = __uint_as_float(a.x << 16); fa[1] = __uint_as_float(a.x & 0xffff0000u); fa[2] = __uint_as_float(a.y << 16); fa[3] = __uint_as_float(a.y & 0xffff0000u);
            fb[0] = __uint_as_float(b.x << 16); fb[1] = __uint_as_float(b.x & 0xffff0000u); fb[2] = __uint_as_float(b.y << 16); fb[3] = __uint_as_float(b.y & 0xffff0000u);
            v[j] = *(const f32x4*)(XW + (size_t)row * D + d0) + g2 * (fa * w0 + fb * w1);
            ss += (v[j][0] * v[j][0] + v[j][1] * v[j][1]) + (v[j][2] * v[j][2] + v[j][3] * v[j][3]); }
        const float rstd = 1.0f / sqrtf(wave_sum(ss) * (1.0f / D) + EPS);
#pragma unroll
        for (int j = 0; j < 4; ++j) { const int d0 = 4 * lane + 256 * j; *(f32x4*)(F.ap->out + (size_t)tok * D + d0) = (v[j] * rstd) * *(const f32x4*)(F.ap->in[I_FNG] + d0); }
    }
}
constexpr int ML_QA = 0, ML_KA = 8704, ML_KBX = 17408, ML_KT = 21760, ML_VT = 32000, ML_AS = 42240, ML_PS = 44800, ML_EL = 46848, ML_E15 = 47360, ML_FLAG = 47872, ML_BC = 47888, ML_STG = 65296, ML_OS = 90896;
static_assert(ML_OS + 65536 <= LDS_MISC, "mixer LDS");


template <int NV> __device__ __forceinline__ void bfly_step(float (&a)[32], int lane, int xb) {
    const bool hi = (lane & xb) != 0;
#pragma unroll
    for (int i = 0; i < NV / 2; ++i) { const float keep = hi ? a[NV / 2 + i] : a[i], send = hi ? a[i] : a[NV / 2 + i]; a[i] = keep + __shfl_xor(send, xb); }
}

__device__ __forceinline__ int sc_row(int r0, int n, int dir) { return dir == 0 ? r0 + n : r0 + 255 - n; }

template <int DK, bool HG, bool OUT> struct Stg {
    static constexpr int KOFF = DK, VOFF = HG ? DK : 2 * DK, QOFF = VOFF + 128, SW = OUT ? QOFF + DK : QOFF, SWP = SW, NPC = SW / 8, NLD = (32 * NPC + NTHREADS - 1) / NTHREADS;
};
template <int DK, bool HG, bool OUT> struct ChunkIn { int unused; };
template <int DK, bool HG, bool OUT>
__device__ __forceinline__ void gla_load(Frame& F, const bf16_t* P, int r0, int c, int dir, int qcol, int gcol, int kcol, int vcol, ChunkIn<DK, HG, OUT>&) {
    typedef Stg<DK, HG, OUT> G;
#pragma unroll
    for (int j = 0; j < G::NLD; ++j) { const int pid = F.tid + NTHREADS * j;
        if (G::NLD * NTHREADS == 32 * G::NPC || F.wave * 64 + NTHREADS * j < 32 * G::NPC) {
            const int tau = pid / G::NPC, c8 = (pid % G::NPC) * 8;
            const int col = c8 < DK ? gcol + c8 : ((!HG && c8 < G::VOFF) ? kcol + c8 - G::KOFF : (c8 < G::QOFF ? vcol + c8 - G::VOFF : qcol + c8 - G::QOFF));
            __builtin_amdgcn_global_load_lds((const unsigned*)(P + (size_t)sc_row(r0, 32 * c + tau, dir) * LDP + col), (LAS unsigned*)(F.lds + ML_STG + (F.wave * 64 + NTHREADS * j) * 16), 16, 0, 0); } }
}
template <int DK, bool HG, bool OUT>
__device__ __forceinline__ void gla_stage(Frame& F, const ChunkIn<DK, HG, OUT>&) { asm volatile("s_waitcnt vmcnt(0)" ::: "memory"); }
template <int DK, bool HG, bool OUT, int VAR = 0>
__device__ __forceinline__ void gla_chunk(Frame& F, const bf16_t* P, ChunkIn<DK, HG, OUT>& N, bool have_next, int nr0, int nc, int ndir, int c, int dir, int qcol, int gcolf, int gcolb, int kcol, int vcol,
                                          f32x4 (&S)[DK / 16], float& gtot) {
    typedef Stg<DK, HG, OUT> G;
    LAS unsigned char* lds = F.lds;
    LAS float* BC = (LAS float*)(lds + ML_BC); LAS bf16_t* QA = (LAS bf16_t*)(lds + ML_QA); LAS bf16_t* KA = (LAS bf16_t*)(lds + ML_KA); LAS bf16_t* KBX = (LAS bf16_t*)(lds + ML_KBX); LAS bf16_t* STG = (LAS bf16_t*)(lds + ML_STG);
    LAS float* E15 = (LAS float*)(lds + ML_E15); volatile LAS unsigned* FLAG = (volatile LAS unsigned*)(lds + ML_FLAG);
    LAS unsigned char* KT = lds + ML_KT; LAS unsigned char* VT = lds + ML_VT; LAS unsigned char* AS = lds + ML_AS; LAS float* PS = (LAS float*)(lds + ML_PS); LAS float* EL = (LAS float*)(lds + ML_EL);
    LAS bf16_t* OS = (LAS bf16_t*)(lds + ML_OS);
    constexpr int NT = DK / 16, NPART = NTHREADS / DK, HS = DK + 8;
    const int tid = F.tid, lane = F.lane, w = F.wave;
    const int d = tid & (DK - 1), part = tid / DK, t0 = part * NT;
    float cs[NT], gg[NT], qq[NT], kk[NT];
    float off = 0.f, tot = 0.f, ref15 = 0.f;
    if (VAR != 4) {
#pragma unroll
        for (int pp = 0; pp < NPART; ++pp) { float ps = 0.f;
#pragma unroll
            for (int i = 0; i < NT; ++i) ps += bf2f(STG[(pp * NT + i) * G::SWP + d]);
            tot += ps; off += (pp < part) ? ps : 0.f; if (pp * NT < 16) ref15 += ps; }
        float run = 0.f;
#pragma unroll
        for (int i = 0; i < NT; ++i) { const LAS bf16_t* rp = STG + (t0 + i) * G::SWP;
            gg[i] = bf2f(rp[d]); if (OUT) qq[i] = bf2f(rp[G::QOFF + d]); if (!HG) kk[i] = bf2f(rp[G::KOFF + d]);
            run += gg[i]; cs[i] = run; }
        if (OUT && tid == 0) FLAG[(c + 1) & 1] = 0u;
        const int v = tid & 127, pv = tid >> 7; unsigned short vb[8];
#pragma unroll
        for (int i = 0; i < 8; ++i) vb[i] = STG[(8 * pv + i) * G::SWP + G::VOFF + v];
        u32x4 wv; wv.x = vb[0] | ((unsigned)vb[1] << 16); wv.y = vb[2] | ((unsigned)vb[3] << 16); wv.z = vb[4] | ((unsigned)vb[5] << 16); wv.w = vb[6] | ((unsigned)vb[7] << 16);
        *(LAS u32x4*)(VT + v * 80 + pv * 16) = wv;
    }
    float bcv[NT], kq[NT];
    if (VAR < 4) {
        float kh[NT];
        bool big = false;
        const float c0 = __expf(tot), c1 = __expf(tot - ref15), e15 = __expf(ref15);
        float qa[NT], ka[NT], kx[NT];
#pragma unroll
        for (int i = 0; i < NT; ++i) { const float bc = off + cs[i], f = __expf(gg[i]), k = HG ? 1.0f - f : kk[i]; const int tau = t0 + i; bcv[i] = bc; kq[i] = k;
            const bool hi = tau >= 16; const float X = (hi ? ref15 : 0.f) - bc;
            const float eX = __expf(fminf(X, 80.f)); ka[i] = k * eX;
            big |= X > 80.f;
            if (OUT && VAR < 2) { qa[i] = qq[i] * __builtin_amdgcn_rcpf(eX); kx[i] = ka[i] * e15; }
            kh[i] = ka[i] * (hi ? c1 : c0); }
        if (big) {
#pragma unroll
            for (int i = 0; i < NT; ++i) kh[i] = kq[i] * __expf(tot - bcv[i]); }
        if (OUT && VAR < 2) {
#pragma unroll
            for (int i = 0; i < NT; i += 2) { const int tau = t0 + i; const unsigned wq = pk2(qa[i], qa[i + 1]), wk2 = pk2(ka[i], ka[i + 1]);
                QA[tau * HS + d] = (bf16_t)(wq & 0xffffu); QA[(tau + 1) * HS + d] = (bf16_t)(wq >> 16); KA[tau * HS + d] = (bf16_t)(wk2 & 0xffffu); KA[(tau + 1) * HS + d] = (bf16_t)(wk2 >> 16);
                if (tau < 16) { const unsigned wx = pk2(kx[i], kx[i + 1]); KBX[tau * HS + d] = (bf16_t)(wx & 0xffffu); KBX[(tau + 1) * HS + d] = (bf16_t)(wx >> 16); } } }
        if (NT == 8) { u32x4 wk; wk.x = pk2(kh[0], kh[1]); wk.y = pk2(kh[2], kh[3]); wk.z = pk2(kh[4 % NT], kh[5 % NT]); wk.w = pk2(kh[6 % NT], kh[7 % NT]); *(LAS u32x4*)(KT + d * 80 + t0 * 2) = wk; }
        else { u32x2 wk; wk.x = pk2(kh[0], kh[1]); wk.y = pk2(kh[2], kh[3]); *(LAS u32x2*)(KT + d * 80 + t0 * 2) = wk; }
        if (OUT && big) FLAG[c & 1] = 1u;
        if (OUT && part == 0) E15[d] = __expf(ref15);
        if (part == 0) { EL[d] = __expf(tot); gtot += tot; }
    }
    __syncthreads();
    bool slow = false;
    if (OUT) slow = __builtin_amdgcn_readfirstlane((int)FLAG[c & 1]) != 0;
    if (OUT && slow) {
#pragma unroll
        for (int i = 0; i < NT; ++i) { const int tau = t0 + i; BC[tau * HS + d] = bcv[i] * 1.4426950408889634f; }
        __syncthreads();
        const int g4 = lane >> 4, r = lane & 15;
        for (int job = w; job < 11; job += 8) {
            const int lvl = job == 0 ? 4 : 3 - ((job - 1) >> 1), tt = job == 0 ? 1 : ((job - 1) & 1), ss = job == 0 ? 0 : tt;
            const int t = 16 * tt + r, sx = 16 * ss + r;
            bool va = true, vb = true; int reft = t, refs = sx;
            if (lvl >= 0) { const int bsz = 2 << lvl, hb = 1 << lvl; va = ((t >> lvl) & 1) != 0; vb = ((sx >> lvl) & 1) == 0; reft = (t & ~(bsz - 1)) + hb - 1; refs = (sx & ~(bsz - 1)) + hb - 1; }
            f32x4 acc = (f32x4){0.f, 0.f, 0.f, 0.f};
#pragma unroll
            for (int kk2 = 0; kk2 < DK / 32; ++kk2) { const int d0 = 32 * kk2 + 8 * g4;
                float qv[8], kv[8]; epi::unpack8(*(const LAS u32x4*)(STG + t * G::SWP + G::QOFF + d0), qv);
                if (HG) { epi::unpack8(*(const LAS u32x4*)(STG + sx * G::SWP + d0), kv);
#pragma unroll
                    for (int j = 0; j < 8; ++j) kv[j] = 1.0f - __expf(kv[j]); }
                else epi::unpack8(*(const LAS u32x4*)(STG + sx * G::SWP + G::KOFF + d0), kv);
                if (lvl >= 0) {
                    const f32x4 bt0 = *(const LAS f32x4*)(BC + t * HS + d0), bt1 = *(const LAS f32x4*)(BC + t * HS + d0 + 4), br0 = *(const LAS f32x4*)(BC + reft * HS + d0), br1 = *(const LAS f32x4*)(BC + reft * HS + d0 + 4);
                    const f32x4 bs0 = *(const LAS f32x4*)(BC + sx * HS + d0), bs1 = *(const LAS f32x4*)(BC + sx * HS + d0 + 4), bq0 = *(const LAS f32x4*)(BC + refs * HS + d0), bq1 = *(const LAS f32x4*)(BC + refs * HS + d0 + 4);
#pragma unroll
                    for (int j = 0; j < 4; ++j) { qv[j] = va ? qv[j] * __builtin_amdgcn_exp2f(bt0[j] - br0[j]) : 0.f; qv[4 + j] = va ? qv[4 + j] * __builtin_amdgcn_exp2f(bt1[j] - br1[j]) : 0.f;
                        kv[j] = vb ? kv[j] * __builtin_amdgcn_exp2f(bq0[j] - bs0[j]) : 0.f; kv[4 + j] = vb ? kv[4 + j] * __builtin_amdgcn_exp2f(bq1[j] - bs1[j]) : 0.f; }
                }
                const u32x4 af = epi::pack8(qv), bf = epi::pack8(kv);
                acc = __builtin_amdgcn_mfma_f32_16x16x32_bf16(__builtin_bit_cast(bf16x8, af), __builtin_bit_cast(bf16x8, bf), acc, 0, 0, 0);
            }
#pragma unroll
            for (int i = 0; i < 4; ++i) { const int to = 16 * tt + 4 * g4 + i, so = 16 * ss + r;
                bool valid; if (lvl >= 0) valid = (((to ^ so) >> (lvl + 1)) == 0) && (((to >> lvl) & 1) != 0) && (((so >> lvl) & 1) == 0); else valid = (to == so);
                if (valid) *(LAS bf16_t*)(AS + to * 80 + so * 2) = (bf16_t)f2bf(acc[i]);
                else if (lvl < 0 && so > to) *(LAS bf16_t*)(AS + to * 80 + so * 2) = (bf16_t)0;
                if (job == 0) *(LAS bf16_t*)(AS + (4 * g4 + i) * 80 + (16 + r) * 2) = (bf16_t)0;
            }
        }
        __syncthreads();
    }
    if (have_next && VAR < 4) gla_load<DK, HG, OUT>(F, P, nr0, nc, ndir, qcol, ndir == 0 ? gcolf : gcolb, kcol, vcol, N);
    {
        const int g4 = lane >> 4, r = lane & 15;
        const bf16x8 bV = *(const LAS bf16x8*)(VT + (16 * w + r) * 80 + g4 * 16);
        if (OUT && VAR < 1) {
            f32x4 o[2];
            if (!slow) {
                f32x4 t00 = (f32x4){0.f, 0.f, 0.f, 0.f}, t01 = t00, t11 = t00;
#pragma unroll
                for (int kk2 = 0; kk2 < DK / 32; ++kk2) { const int d0 = 32 * kk2 + 8 * g4;
                    const bf16x8 q0 = *(const LAS bf16x8*)(QA + r * HS + d0), q1 = *(const LAS bf16x8*)(QA + (16 + r) * HS + d0);
                    const bf16x8 k0 = *(const LAS bf16x8*)(KA + r * HS + d0), k1 = *(const LAS bf16x8*)(KA + (16 + r) * HS + d0), kx = *(const LAS bf16x8*)(KBX + r * HS + d0);
                    t00 = __builtin_amdgcn_mfma_f32_16x16x32_bf16(k0, q0, t00, 0, 0, 0); t01 = __builtin_amdgcn_mfma_f32_16x16x32_bf16(kx, q1, t01, 0, 0, 0); t11 = __builtin_amdgcn_mfma_f32_16x16x32_bf16(k1, q1, t11, 0, 0, 0); }
#pragma unroll
                for (int i = 0; i < 4; ++i) { const bool keep = (4 * g4 + i) <= r; t00[i] = keep ? t00[i] : 0.f; t11[i] = keep ? t11[i] : 0.f; }
                u32x4 a0, a1; a0.x = pk2(t00[0], t00[1]); a0.y = pk2(t00[2], t00[3]); a0.z = 0u; a0.w = 0u; a1.x = pk2(t01[0], t01[1]); a1.y = pk2(t01[2], t01[3]); a1.z = pk2(t11[0], t11[1]); a1.w = pk2(t11[2], t11[3]);
                const u32x2 vlo = *(const LAS u32x2*)(VT + (16 * w + r) * 80 + 8 * g4), vhi = *(const LAS u32x2*)(VT + (16 * w + r) * 80 + 32 + 8 * g4);
                u32x4 vp; vp.x = vlo.x; vp.y = vlo.y; vp.z = vhi.x; vp.w = vhi.y;
                o[0] = __builtin_amdgcn_mfma_f32_16x16x32_bf16(__builtin_bit_cast(bf16x8, a0), __builtin_bit_cast(bf16x8, vp), (f32x4){0.f, 0.f, 0.f, 0.f}, 0, 0, 0);
                o[1] = __builtin_amdgcn_mfma_f32_16x16x32_bf16(__builtin_bit_cast(bf16x8, a1), __builtin_bit_cast(bf16x8, vp), (f32x4){0.f, 0.f, 0.f, 0.f}, 0, 0, 0);
            } else {
#pragma unroll
                for (int tt = 0; tt < 2; ++tt) { const bf16x8 aS = *(const LAS bf16x8*)(AS + (16 * tt + r) * 80 + g4 * 16); o[tt] = __builtin_amdgcn_mfma_f32_16x16x32_bf16(aS, bV, (f32x4){0.f, 0.f, 0.f, 0.f}, 0, 0, 0); }
            }
#pragma unroll
            for (int kk2 = 0; kk2 < DK / 32; ++kk2) {
                const f32x4 e0 = *(const LAS f32x4*)(E15 + 32 * kk2 + 4 * g4), e1 = *(const LAS f32x4*)(E15 + 32 * kk2 + 16 + 4 * g4);
                u32x4 bs, bs2; bs.x = pk2(S[2 * kk2][0], S[2 * kk2][1]); bs.y = pk2(S[2 * kk2][2], S[2 * kk2][3]); bs.z = pk2(S[2 * kk2 + 1][0], S[2 * kk2 + 1][1]); bs.w = pk2(S[2 * kk2 + 1][2], S[2 * kk2 + 1][3]);
                bs2.x = pk2(S[2 * kk2][0] * e0[0], S[2 * kk2][1] * e0[1]); bs2.y = pk2(S[2 * kk2][2] * e0[2], S[2 * kk2][3] * e0[3]); bs2.z = pk2(S[2 * kk2 + 1][0] * e1[0], S[2 * kk2 + 1][1] * e1[1]); bs2.w = pk2(S[2 * kk2 + 1][2] * e1[2], S[2 * kk2 + 1][3] * e1[3]);
#pragma unroll
                for (int tt = 0; tt < 2; ++tt) { const u32x2 lo = *(const LAS u32x2*)(QA + (16 * tt + r) * HS + 32 * kk2 + 4 * g4), hi = *(const LAS u32x2*)(QA + (16 * tt + r) * HS + 32 * kk2 + 16 + 4 * g4);
                    u32x4 aq; aq.x = lo.x; aq.y = lo.y; aq.z = hi.x; aq.w = hi.y;
                    o[tt] = __builtin_amdgcn_mfma_f32_16x16x32_bf16(__builtin_bit_cast(bf16x8, aq), __builtin_bit_cast(bf16x8, tt == 0 ? bs : bs2), o[tt], 0, 0, 0); }
            }
#pragma unroll
            for (int tt = 0; tt < 2; ++tt)
#pragma unroll
                for (int i = 0; i < 4; ++i) { const int n = 32 * c + 16 * tt + 4 * g4 + i, nn = dir == 0 ? n : 255 - n; LAS bf16_t* op = OS + nn * 128 + 16 * w + r;
                    float val = o[tt][i]; if (dir == 1) val += bf2f(*op); *op = (bf16_t)f2bf(val); }
        }
#pragma unroll
        for (int dt = 0; dt < (VAR >= 3 ? 0 : DK / 16); ++dt) { const f32x4 el = *(const LAS f32x4*)(EL + 16 * dt + 4 * g4); const bf16x8 aK = *(const LAS bf16x8*)(KT + (16 * dt + r) * 80 + g4 * 16);
            S[dt] = __builtin_amdgcn_mfma_f32_16x16x32_bf16(aK, bV, S[dt] * el, 0, 0, 0); }
    }
    if (have_next && VAR < 4) gla_stage<DK, HG, OUT>(F, N);
    __syncthreads();
}

template <bool HG> struct MixCols {
    static __device__ __forceinline__ int q(int h) { return HG ? 128 * h : 2560 + 64 * h; }
    static __device__ __forceinline__ int g(int h, int dir) { return HG ? 512 + 512 * dir + 128 * h : 3584 + 256 * dir + 64 * h; }
    static __device__ __forceinline__ int k(int h) { return HG ? 0 : 2816 + 64 * h; }
    static __device__ __forceinline__ int v(int h) { return HG ? 1536 + 128 * h : 3072 + 128 * h; }
    static __device__ __forceinline__ int og(int h) { return HG ? 2048 + 128 * h : 4096 + 128 * h; }
};
__device__ __forceinline__ int sc_r0(int b, int sc) { return sc == 0 ? b * 256 : MCTX + b * 4096 + (sc - 1) * 256; }
__device__ __forceinline__ int sc_of_pos(int dir, int p) { return (dir == 0 || p == 0) ? p : 17 - p; }

template <int DK, bool HG>
__device__ __forceinline__ void gla_pass1_item(Frame& F, int b, int h, int dir, int p) {
    const bf16_t* P = (const bf16_t*)(F.ws + WS_P);
    constexpr int NDT = DK / 16, E = DK * 128;
    const int sc = sc_of_pos(dir, p), r0 = sc_r0(b, sc);
    float* ST = (float*)(F.ws + (HG ? WS_GST : WS_GST2)) + ((size_t)((b * 4 + h) * 2 + dir) * NSC + sc) * E;
    float* DEC = (float*)(F.ws + WS_GDEC) + (HG ? 0 : 4 * 4 * 2 * NSC * 128) + ((size_t)((b * 4 + h) * 2 + dir) * NSC + sc) * DK;
    f32x4 S[NDT];
#pragma unroll
    for (int i = 0; i < NDT; ++i) S[i] = (f32x4){0.f, 0.f, 0.f, 0.f};
    float gtot = 0.f;
    const int gcf = MixCols<HG>::g(h, 0), gcb = MixCols<HG>::g(h, 1), kc = MixCols<HG>::k(h), vc = MixCols<HG>::v(h);
    ChunkIn<DK, HG, false> N;
    gla_load<DK, HG, false>(F, P, r0, 0, dir, 0, dir == 0 ? gcf : gcb, kc, vc, N); gla_stage<DK, HG, false>(F, N); __syncthreads();
    for (int c = 0; c < 8; ++c) gla_chunk<DK, HG, false>(F, P, N, c < 7, r0, c + 1, dir, c, dir, 0, gcf, gcb, kc, vc, S, gtot);
#pragma unroll
    for (int dt = 0; dt < NDT; ++dt)
#pragma unroll
        for (int i = 0; i < 4; ++i) ST[((F.wave * NDT + dt) * 4 + i) * 64 + F.lane] = S[dt][i];
    if (F.tid < DK) DEC[F.tid] = __expf(gtot);
}
template <int DK, bool HG, int VAR = 0>
__device__ __forceinline__ void gla_pass3_item(Frame& F, int l, int b, int h, int sc) {
    const bf16_t* P = (const bf16_t*)(F.ws + WS_P); bf16_t* Y = (bf16_t*)(F.ws + WS_Y);
    constexpr int NDT = DK / 16, E = DK * 128;
    const int r0 = sc_r0(b, sc);
    const int qc = MixCols<HG>::q(h), gcf = MixCols<HG>::g(h, 0), gcb = MixCols<HG>::g(h, 1), kc = MixCols<HG>::k(h), vc = MixCols<HG>::v(h);
    ChunkIn<DK, HG, true> N;
    if (F.tid == 0) { volatile LAS unsigned* FLAG = (volatile LAS unsigned*)(F.lds + ML_FLAG); FLAG[0] = 0u; FLAG[1] = 0u; }
    gla_load<DK, HG, true>(F, P, r0, 0, 0, qc, gcf, kc, vc, N); gla_stage<DK, HG, true>(F, N); __syncthreads();
    for (int dir = 0; dir < 2; ++dir) {
        const float* ST = (const float*)(F.ws + (HG ? WS_GST : WS_GST2)) + ((size_t)((b * 4 + h) * 2 + dir) * NSC + sc) * E;
        f32x4 S[NDT];
#pragma unroll
        for (int dt = 0; dt < NDT; ++dt)
#pragma unroll
            for (int i = 0; i < 4; ++i) S[dt][i] = ST[((F.wave * NDT + dt) * 4 + i) * 64 + F.lane];
        float gtot = 0.f;
        for (int c = 0; c < 8; ++c) { const bool hn = !(dir == 1 && c == 7); const int nc = c < 7 ? c + 1 : 0, nd = c < 7 ? dir : 1;
            gla_chunk<DK, HG, true, VAR>(F, P, N, hn, r0, nc, nd, c, dir, qc, gcf, gcb, kc, vc, S, gtot); }
    }
    {
        const LAS bf16_t* OS = (const LAS bf16_t*)(F.lds + ML_OS);
        const int n = F.tid >> 1, hf = F.tid & 1; float o[64]; float ss = 0.f;
#pragma unroll
        for (int j = 0; j < 8; ++j) { float t8[8]; epi::unpack8(*(const LAS u32x4*)(OS + n * 128 + hf * 64 + j * 8), t8);
#pragma unroll
            for (int e = 0; e < 8; ++e) { o[j * 8 + e] = t8[e]; ss += t8[e] * t8[e]; } }
        ss += __shfl_xor(ss, 1);
        const float rstd = 1.0f / sqrtf(ss * (1.0f / 128.0f) + EPS);
        const float* gain = F.ap->in[HG ? I_HGNG : I_GLNG] + l * 512 + h * 128 + hf * 64;
        const bf16_t* og = P + (size_t)(r0 + n) * LDP + MixCols<HG>::og(h) + hf * 64;
        bf16_t* yo = Y + (size_t)(r0 + n) * 1536 + (HG ? 0 : 512) + h * 128 + hf * 64;
#pragma unroll
        for (int j = 0; j < 8; ++j) { float gt[8], v[8]; epi::unpack8(*(const u32x4*)(og + j * 8), gt);
#pragma unroll
            for (int e = 0; e < 8; ++e) v[e] = o[j * 8 + e] * rstd * gain[j * 8 + e] * gt[e];
            *(u32x4*)(yo + j * 8) = epi::pack8(v); }
    }
    __syncthreads();
}
__device__ __forceinline__ void gla_carry(Frame& F) {
    const size_t gt = (size_t)F.c * NTHREADS + F.tid, NTT = (size_t)F.G * NTHREADS;
    constexpr size_t EH = 16384, EG = 8192, NH = 32 * EH, NGL = 32 * EG;
    for (size_t t = gt; t < NH + NGL; t += NTT) {
        const bool hg = t < NH; const size_t tt = hg ? t : t - NH; const int E = hg ? (int)EH : (int)EG, DK = hg ? 128 : 64, NDT = DK / 16;
        const int chain = (int)(tt / E), e = (int)(tt % E), dir = chain & 1;
        const int ln = e & 63, i = (e >> 6) & 3, dt = (e >> 8) % NDT, dd = 16 * dt + 4 * (ln >> 4) + i;
        float* ST = (float*)(F.ws + (hg ? WS_GST : WS_GST2)) + (size_t)chain * NSC * E + e;
        const float* DEC = (const float*)(F.ws + WS_GDEC) + (hg ? 0 : 4 * 4 * 2 * NSC * 128) + (size_t)chain * NSC * DK + dd;
        float loc[16], dec[16];
#pragma unroll
        for (int p = 0; p < 16; ++p) { const int sc = sc_of_pos(dir, p); loc[p] = ST[(size_t)sc * E]; dec[p] = DEC[sc * DK]; }
        float S = 0.f;
#pragma unroll
        for (int p = 0; p < 16; ++p) { const int sc = sc_of_pos(dir, p); ST[(size_t)sc * E] = S; S = dec[p] * S + loc[p]; }
        ST[(size_t)sc_of_pos(dir, 16) * E] = S;
    }
}
__device__ __forceinline__ void s5_carry(Frame& F, int l) {
    const float* SL = (const float*)(F.ws + WS_SLOC); bf16_t* UG = (bf16_t*)(F.ws + WS_UG); const float* PW = (const float*)(F.ws + WS_S5PW);
    LAS float* EX = (LAS float*)F.lds;
    const int n = F.lane, j = F.wave;
    for (int it = F.c; it < NB * 32 * 2; it += F.G) {
        const int dir = it & 1, g = (it >> 1) & 31, b = it >> 6, ldg = (l * 2 + dir) * 32 + g;
        const cplx a = {PW[((size_t)ldg * 33 + 32) * 128 + n * 2], PW[((size_t)ldg * 33 + 32) * 128 + n * 2 + 1]};
        float lre[17], lim[17]; size_t rbs[17];
#pragma unroll
        for (int i = 0; i < 17; ++i) { const int p = 17 * j + i; int ck;
            if (p < 8) ck = 8 * b + (dir == 0 ? p : 7 - p); else ck = 32 + 128 * b + (dir == 0 ? p - 8 : 135 - p);
            rbs[i] = (size_t)(g * S5ROWS + ck); lre[i] = SL[rbs[i] * 256 + 128 * dir + n]; lim[i] = SL[rbs[i] * 256 + 128 * dir + 64 + n]; }
        float pre_re[17], pre_im[17]; cplx s = {0.f, 0.f};
#pragma unroll
        for (int i = 0; i < 17; ++i) { pre_re[i] = s.re; pre_im[i] = s.im; const cplx t = cmul(a, s); s.re = t.re + lre[i]; s.im = t.im + lim[i]; }
        __syncthreads();
        EX[(j * 64 + n) * 2] = s.re; EX[(j * 64 + n) * 2 + 1] = s.im;
        __syncthreads();
        cplx a2 = cmul(a, a), a4 = cmul(a2, a2), a8 = cmul(a4, a4), a16 = cmul(a8, a8), a17 = cmul(a16, a);
        cplx cin = {0.f, 0.f};
        for (int jj = 0; jj < j; ++jj) { const cplx t = cmul(a17, cin); cin.re = t.re + EX[(jj * 64 + n) * 2]; cin.im = t.im + EX[(jj * 64 + n) * 2 + 1]; }
        cplx wv = {1.f, 0.f};
#pragma unroll
        for (int i = 0; i < 17; ++i) { const cplx t = cmul(wv, cin); const float sre = pre_re[i] + t.re, sim = pre_im[i] + t.im;
            UG[rbs[i] * S5K + 512 + 128 * dir + n] = (bf16_t)f2bf(sre); UG[rbs[i] * S5K + 512 + 128 * dir + 64 + n] = (bf16_t)f2bf(sim);
            wv = cmul(wv, a); }
    }
    __syncthreads();
}
namespace pg8 {
struct S5LocSched { static constexpr bool GATHER = false; const char* UG; const char* VT; int G, c;
    __device__ __forceinline__ bool next(int i, GUnit& u) const { const int L = i * G + c; if (L >= 96) return false; const int g = L / 3, mt = L % 3;
        u.A = UG + ((size_t)(g * S5ROWS + mt * 256)) * (S5K * 2); u.B = VT + (size_t)g * 256 * 1024; u.i0 = g; u.i1 = mt; u.i2 = 0; u.i3 = 0; return true; } };
struct S5OutSched { static constexpr bool GATHER = false; const char* UG; const char* BC; int G, c;
    __device__ __forceinline__ bool next(int i, GUnit& u) const { const int L = i * G + c; if (L >= 192) return false; const int g = L / 6, rem = L % 6, mt = rem >> 1, pn = rem & 1;
        u.A = UG + ((size_t)(g * S5ROWS + mt * 256)) * (S5K * 2); u.B = BC + ((size_t)(g * 512 + pn * 256)) * (S5K * 2); u.i0 = g; u.i1 = mt; u.i2 = pn; u.i3 = 0; return true; } };
struct MergeSched { static constexpr bool GATHER = false; const char* Y; const char* WB; int nM, pm0, G, c, lim;
    __device__ __forceinline__ bool next(int i, GUnit& u) const { const int Lt = (i / 3) * G + c, k = i % 3; if (Lt >= lim) return false; const int pm = pm0 + (Lt >> 2), pn = Lt & 3;
        u.A = Y + (size_t)pm * 256 * 3072 + k * 1024; u.B = WB + ((size_t)(k * 1024 + pn * 256)) * 1024; u.i0 = pm; u.i1 = pn; u.i2 = k; u.i3 = 0; return true; } };
struct MergeTailSched { static constexpr bool GATHER = false; const char* Y; const char* WB; int nM, pm0, first, c;
    __device__ __forceinline__ bool next(int i, GUnit& u) const { if (i > 0) return false; const int Lt = first + c / 3, k = c % 3; if (Lt >= nM * 4) return false; const int pm = pm0 + (Lt >> 2), pn = Lt & 3;
        u.A = Y + (size_t)pm * 256 * 3072 + k * 1024; u.B = WB + ((size_t)(k * 1024 + pn * 256)) * 1024; u.i0 = pm; u.i1 = pn; u.i2 = c; u.i3 = k; return true; } };
struct GateEarlySched { static constexpr bool GATHER = false; const char* H; const char* W; int G, c;
    __device__ __forceinline__ bool next(int i, GUnit& u) const { if (c < 80 || G <= 80) return false; const int g = i * (G - 80) + c - 80; if (g >= 176) return false; const int pn = g < 128 ? 11 - (g >> 6) : 9, pm = 4 + (g < 128 ? (g & 63) : g - 128);
        u.A = H + (size_t)pm * 256 * 2048; u.B = W + (size_t)pn * 256 * 2048; u.i0 = pm; u.i1 = pn; u.i2 = 0; u.i3 = 0; return true; } };
struct GateCtxSched { static constexpr bool GATHER = false; const char* H; const char* W; int G, c;
    __device__ __forceinline__ bool next(int i, GUnit& u) const { const int w0 = G >= 144 ? 96 : 0; const int g = i * (G - w0) + c - w0; if (c < w0 || g >= 48) return false; const int pm = g / 12, pn = g % 12;
        u.A = H + (size_t)pm * 256 * 2048; u.B = W + (size_t)pn * 256 * 2048; u.i0 = pm; u.i1 = pn; u.i2 = 0; u.i3 = 0; return true; } };
struct GateRestSched { static constexpr bool GATHER = false; pg8::DenseSched D; int G, c;
    __device__ __forceinline__ bool next(int i, GUnit& u) const { const int L = i * G + c; if (L >= 592) return false; int pm, pn;
        if (L < 576) D.tile_of(L, pm, pn); else { pm = 52 + (L - 576); pn = 9; }
        u.A = D.A + (size_t)pm * 256 * 2048; u.B = D.B + (size_t)pn * 256 * 2048; u.i0 = pm; u.i1 = pn; u.i2 = 0; u.i3 = 0; return true; } };
struct MoeUpSched { static constexpr bool GATHER = true; const char* H; const char* W; const int* perm; int ntiles, ts[NE + 1], G, c;
    __device__ __forceinline__ bool next(int i, GUnit& u) const { const int L = i * G + c; if (L >= ntiles * 28) return false; const int tile = L / 28, pn = L % 28; int e = 0;
#pragma unroll
        for (int k = 1; k < NE; ++k) e += (tile >= ts[k]) ? 1 : 0;
        u.A = H; u.B = W + ((size_t)(e * 7168 + pn * 256)) * 2048; u.i0 = tile; u.i1 = pn; u.i2 = e; u.i3 = 0; return true; }
    __device__ __forceinline__ const int* rowtab(const GUnit& u) const { int t0 = 0;
#pragma unroll
        for (int k = 1; k < NE; ++k) t0 = (u.i2 == k) ? ts[k] : t0;
        return perm + u.i2 * 16384 + (u.i0 - t0) * 256; } };
struct MoeDownSched { static constexpr bool GATHER = false; const char* HID; const char* W; int ntiles, ts[NE + 1], G, c, lim;
    __device__ __forceinline__ bool next(int i, GUnit& u) const { const int L = i * G + c; if (L >= lim) return false; const int tile = L >> 2, pn = L & 3; int e = 0;
#pragma unroll
        for (int k = 1; k < NE; ++k) e += (tile >= ts[k]) ? 1 : 0;
        u.A = HID + (size_t)tile * 256 * 7168; u.B = W + ((size_t)(e * 1024 + pn * 256)) * 7168; u.i0 = tile; u.i1 = pn; u.i2 = e; u.i3 = 0; return true; } };
struct MoeDownTailSched { static constexpr bool GATHER = false; const char* HID; const char* W; int ntiles, ts[NE + 1], first, c;
    __device__ __forceinline__ bool next(int i, GUnit& u) const { if (i > 0) return false; const int L = first + (c >> 2), ks = c & 3; if (L >= ntiles * 4) return false; const int tile = L >> 2, pn = L & 3; int e = 0;
#pragma unroll
        for (int k = 1; k < NE; ++k) e += (tile >= ts[k]) ? 1 : 0;
        u.A = HID + (size_t)tile * 256 * 7168 + ks * 1792; u.B = W + ((size_t)(e * 1024 + pn * 256)) * 7168 + ks * 1792; u.i0 = tile; u.i1 = pn; u.i2 = c; u.i3 = ks; return true; } };
}

constexpr size_t WS_SLB_G = WS_BIG + 128 * MiB;
constexpr size_t WS_SLB_F = WS_BIG + 104 * MiB;
constexpr size_t WS_GSP = WS_BIG + 343 * MiB;
static_assert(WS_GSP + 22 * MiB <= WS_END, "ws");
constexpr size_t WS_SLB_M = WS_H;
__device__ __forceinline__ void combine_resid(Frame& F, const pg8::DenseSched& S, int first, int R, int SPL, const float* slab, const float* modacc, const float* adab) {
    float* XW = (float*)(F.ws + WS_XW);
    for (int t = F.c * NTHREADS + F.tid; t < R * 16384; t += F.G * NTHREADS) { const int r = t >> 14, e = t & 16383, row = e >> 6, c4 = (e & 63) * 4; int pm, pn; S.tile_of(first + r, pm, pn);
        f32x4 sum = (f32x4){0.f, 0.f, 0.f, 0.f};
        for (int ks = 0; ks < SPL; ++ks) sum += *(const f32x4*)(slab + (size_t)(r * SPL + ks) * 65536 + row * 256 + c4);
        const int bidx = pm < 4 ? 4 : ((pm - 4) >> 4), gcol = pn * 256 + c4; const f32x4 g = *(const f32x4*)(modacc + bidx * 6144 + gcol) + *(const f32x4*)(adab + gcol);
        f32x4* xp = (f32x4*)(XW + (size_t)(pm * 256 + row) * 1024 + gcol); *xp = *xp + g * sum; }
}
__device__ __forceinline__ void combine_merge(Frame& F, int nM, int pm0, int first, const float* slab) {
    const bf16_t* GT = (const bf16_t*)(F.ws + WS_P); bf16_t* MG = (bf16_t*)(F.ws + WS_H); const int R = nM * 4 - first;
    for (int t = F.c * NTHREADS + F.tid; t < R * 8192; t += F.G * NTHREADS) { const int r = t >> 13, e = t & 8191, row = e >> 5, c8 = (e & 31) * 8; const int Lt = first + r, pm = pm0 + (Lt >> 2), pn = Lt & 3;
        const size_t grow = (size_t)(pm * 256 + row); const int gcol = pn * 256 + c8; float v[8];
#pragma unroll
        for (int j = 0; j < 8; ++j) v[j] = 0.f;
#pragma unroll
        for (int k = 0; k < 3; ++k) { float gt[8]; epi::unpack8(*(const u32x4*)(GT + (size_t)(pm * 12 + k * 4 + pn) * 65536 + row * 256 + c8), gt); const float* sp = slab + (size_t)(r * 3 + k) * 65536 + row * 256 + c8;
            const f32x4 a = *(const f32x4*)sp, b = *(const f32x4*)(sp + 4);
#pragma unroll
            for (int j = 0; j < 4; ++j) { v[j] += gt[j] * a[j]; v[4 + j] += gt[4 + j] * b[j]; } }
        *(u32x4*)(MG + grow * 1024 + gcol) = epi::pack8(v); }
}
__device__ __forceinline__ void combine_moe(Frame& F, int first, int R, const float* slab) {
    bf16_t* SL = (bf16_t*)(F.ws + WS_SLAB);
    for (int t = F.c * NTHREADS + F.tid; t < R * 8192; t += F.G * NTHREADS) { const int r = t >> 13, e = t & 8191, row = e >> 5, c8 = (e & 31) * 8; const int L = first + r, tile = L >> 2, pn = L & 3; float v[8];
#pragma unroll
        for (int j = 0; j < 8; ++j) v[j] = 0.f;
#pragma unroll
        for (int ks = 0; ks < 4; ++ks) { const float* sp = slab + (size_t)(r * 4 + ks) * 65536 + row * 256 + c8; const f32x4 a = *(const f32x4*)sp, b = *(const f32x4*)(sp + 4);
#pragma unroll
            for (int j = 0; j < 4; ++j) { v[j] += a[j]; v[4 + j] += b[j]; } }
        *(u32x4*)(SL + (size_t)(tile * 256 + row) * 1024 + pn * 256 + c8) = epi::pack8(v); }
}

__device__ __forceinline__ int wq_pull(Frame& F, unsigned* head) {
    volatile LAS unsigned* slot = (volatile LAS unsigned*)(F.lds + LDS_MISC + 64);
    __syncthreads();
    if (F.tid == 0) slot[0] = __hip_atomic_fetch_add(head, 1u, __ATOMIC_RELAXED, __HIP_MEMORY_SCOPE_AGENT);
    __syncthreads();
    return (int)slot[0];
}
__device__ __forceinline__ bool launder(Frame& F) { unsigned char* w = F.ws; ArgsP a = F.ap; asm volatile("" : "+s"(w), "+s"(a)); F.ws = w; F.ap = a; F.ctl = (unsigned*)(w + WS_CTL); return true; }
constexpr int NPHASE = 26;
#define IN(k) (lo <= (k) && (k) < hi && launder(F))
#define SEAM(k) do { if ((k) + 1 < hi) xcd_barrier(bar); } while (0)
template <int l>
__device__ __forceinline__ void layer_phases(Frame& F, const XcdBarrier& bar, const int lo, const int hi) {
    const int G = F.G, c = F.c; LAS unsigned char* lds = F.lds;
    constexpr int pb = 1 + 12 * l;

        const int pm0 = l == 0 ? 0 : 4, nM = l == 0 ? 68 : 64;
        const float* modacc = (const float*)(F.ctl + CW_MOD) + (size_t)l * 5 * 6144; const float* adab = F.ap->in[I_ADAB] + (size_t)l * 6144;
        if (IN(pb + 0)) { if (l == 0) norm_rows<0>(F, 0, 0, F.ap->in[I_N1G]); else norm_rows<1>(F, 1, 0, F.ap->in[I_N1G] + D); SEAM(pb + 0); }
        if (IN(pb + 1)) {
            pg8::DenseSched S; S.init(F.ws + WS_H, F.ws + WS_WMIX + (size_t)l * NMIX * D * 2, 2048, 2048, 68, 20, 0, G, c);
            const float* lbp = (const float*)(F.ctl + CW_LB);
            epi::EpiWin E{(bf16_t*)(F.ws + WS_P), (bf16_t*)(F.ws + WS_UG), lbp + 512 * l, lbp + 1024 + 512 * l, F.ap->in[I_GB] + l * 512};
            pg8::gemm_phase(lds, S, E, 2048, 2048, 16);
            if (l == 0) { bg_drain<1>(F); bg_s5fill<0>(F); }
            else { pg8::GateEarlySched T{(const char*)(F.ws + WS_H), (const char*)(F.ws + WS_WGATE + (size_t)NGATE * D * 2), G, c}; epi::EpiGate EG{{(bf16_t*)(F.ws + WS_P), (bf16_t*)(F.ws + WS_GSP), 1}};
                pg8::gemm_phase(lds, T, EG, 2048, 2048, 16); }
            SEAM(pb + 1); }
        if (IN(pb + 2)) {
            { pg8::S5LocSched S{(const char*)(F.ws + WS_UG), (const char*)(F.ws + WS_S5V), G, c}; epi::EpiS5Loc E{(float*)(F.ws + WS_SLOC)}; pg8::gemm_phase(lds, S, E, S5K * 2, 1024, 8); }
            if (l == 0) { pg8::GateCtxSched T{(const char*)(F.ws + WS_H), (const char*)(F.ws + WS_WGATE), G, c}; epi::EpiGate EG{{(bf16_t*)(F.ws + WS_P), (bf16_t*)(F.ws + WS_GSP), 0}}; pg8::gemm_phase(lds, T, EG, 2048, 2048, 16); }
            __syncthreads();
            for (;;) { const int it = wq_pull(F, F.ctl + CW_WQ + 64 * (2 * l)); if (it >= 1024) break;
                const int br = it >> 9, r = it & 511, p = r & 15, dir = (r >> 4) & 1, h = (r >> 5) & 3, b = r >> 7;
                if (br == 0) gla_pass1_item<128, true>(F, b, h, dir, p); else gla_pass1_item<64, false>(F, b, h, dir, p); }
            SEAM(pb + 2); }
        if (IN(pb + 3)) { gla_carry(F); s5_carry(F, l); SEAM(pb + 3); }
        if (IN(pb + 4)) {
            { pg8::S5OutSched S{(const char*)(F.ws + WS_UG), (const char*)(F.ws + WS_S5C), G, (c + G - 64) % G}; epi::EpiS5Out E{(bf16_t*)(F.ws + WS_YPRE)}; pg8::gemm_phase(lds, S, E, S5K * 2, S5K * 2, 12); }
            __syncthreads();
            const int nsc = l == 0 ? 17 : 16, nit = 16 * nsc;
            for (;;) { const int q = wq_pull(F, F.ctl + CW_WQ + 64 * (2 * l + 1)); if (q >= 2 * nit) break;
                const int br = q >= nit, it = br ? q - nit : q, sc = (it % nsc) + (l == 0 ? 0 : 1), h = (it / nsc) & 3, b = it / (nsc * 4);
                if (br == 0) gla_pass3_item<128, true>(F, l, b, h, sc); else gla_pass3_item<64, false>(F, l, b, h, sc); }
            SEAM(pb + 4); }
        if (IN(pb + 5)) {
            if (l == 0) { pg8::DenseSched S; S.init(F.ws + WS_H, F.ws + WS_WGATE, 2048, 2048, 64, 12, 4, G, c); epi::EpiGate E{{(bf16_t*)(F.ws + WS_P), (bf16_t*)(F.ws + WS_GSP), 0}}; pg8::gemm_phase(lds, S, E, 2048, 2048, 16); }
            else { pg8::GateRestSched S; S.D.init(F.ws + WS_H, F.ws + WS_WGATE + (size_t)NGATE * D * 2, 2048, 2048, 64, 9, 4, G, c); S.G = G; S.c = c; epi::EpiGate E{{(bf16_t*)(F.ws + WS_P), (bf16_t*)(F.ws + WS_GSP), 1}}; pg8::gemm_phase(lds, S, E, 2048, 2048, 16); }
            { pg8::DenseSched S; S.init(F.ws + WS_YPRE, F.ws + WS_WGLU + (size_t)l * 512 * 512 * 2, 1024, 1024, nM, 2, pm0, G, (c + G - (l == 0 ? 768 : 592) % G) % G); epi::EpiGlu E{(const bf16_t*)(F.ws + WS_YPRE), (bf16_t*)(F.ws + WS_Y)}; pg8::gemm_phase(lds, S, E, 1024, 1024, 8); }
            if (l == 0) bg_drain<2>(F);
            SEAM(pb + 5); }
        if (IN(pb + 6)) {
            const int nT = nM * 4, fullT = (nT / G) * G; const bool split = (hi - lo > 1) && nT > fullT && (nT - fullT) * 3 <= G;
            pg8::MergeSched S{(const char*)(F.ws + WS_Y), (const char*)(F.ws + WS_WBR + (size_t)l * 3 * D * 512 * 2), nM, pm0, G, c, split ? fullT : nT}; epi::EpiMerge E{{(bf16_t*)(F.ws + WS_P), (bf16_t*)(F.ws + WS_GSP), l}, (bf16_t*)(F.ws + WS_H)};
#ifdef PROBE_MERGE
            E.pmode = (hi - lo == 1) ? PROBE_MERGE : 0;
#endif
            pg8::gemm_phase(lds, S, E, 3072, 1024, 8);
            if (split) { pg8::MergeTailSched T{(const char*)(F.ws + WS_Y), (const char*)(F.ws + WS_WBR + (size_t)l * 3 * D * 512 * 2), nM, pm0, fullT, c}; epi::EpiSlab ES{(float*)(F.ws + WS_SLB_F)};
                pg8::gemm_phase(lds, T, ES, 3072, 1024, 8); xcd_barrier(bar); combine_merge(F, nM, pm0, fullT, (const float*)(F.ws + WS_SLB_F)); }
            SEAM(pb + 6); }
        if (IN(pb + 7)) {
            pg8::DenseSched S; S.init(F.ws + WS_H, F.ws + WS_WOUT + (size_t)l * D * D * 2, 2048, 2048, nM, 4, pm0, G, c); epi::EpiResid E{(float*)(F.ws + WS_XW), modacc + 2048, adab + 2048};
            const int full = (S.nwg / G) * G; const bool split = (hi - lo > 1) && S.nwg > full && (S.nwg - full) * 4 <= G;
            if (split) S.lim = full;
            pg8::gemm_phase(lds, S, E, 2048, 2048, 16);
            if (split) { pg8::SplitSched T{S, full, 4, 512, c}; epi::EpiSlab ES{(float*)(F.ws + WS_SLB_G)}; pg8::gemm_phase(lds, T, ES, 2048, 2048, 4); xcd_barrier(bar);
                combine_resid(F, S, full, S.nwg - full, 4, (const float*)(F.ws + WS_SLB_G), modacc + 2048, adab + 2048); }
            SEAM(pb + 7); }
        if (IN(pb + 8)) { if (l == 0) norm_rows<1>(F, 0, 3072, F.ap->in[I_N2G]); else { norm_rows<2>(F, 1, 3072, F.ap->in[I_N2G] + D);
#ifdef PROBE_MC
            moe_convert(F, (hi - lo == 1) ? PROBE_MC : 0);
#else
            moe_convert(F);
#endif
            } SEAM(pb + 8); }
        if (IN(pb + 10)) {
            if (l == 0) { pg8::DenseSched S; S.init(F.ws + WS_H, F.ws + WS_W13, 2048, 2048, 68, 28, 0, G, c); epi::EpiSwiglu E{(bf16_t*)(F.ws + WS_HID)}; pg8::gemm_phase(lds, S, E, 2048, 2048, 16); bg_s5fill<1>(F); }
            else { MoeSeg sg; moe_seg(F, sg); pg8::MoeUpSched S; S.H = (const char*)(F.ws + WS_H) + (size_t)MCTX * 2048; S.W = (const char*)(F.ws + WS_MW13); S.perm = (const int*)(F.ctl + CW_PERM2); S.ntiles = sg.tstart[NE]; S.G = G; S.c = c;
#pragma unroll
                for (int e = 0; e <= NE; ++e) S.ts[e] = sg.tstart[e];
                epi::EpiSwiglu E{(bf16_t*)(F.ws + WS_MHID)}; pg8::gemm_phase(lds, S, E, 2048, 2048, 16);
                bg_drain<3>(F); }
            SEAM(pb + 10); }
        if (IN(pb + 11)) {
            if (l == 0) { pg8::DenseSched S; S.init(F.ws + WS_HID, F.ws + WS_W2, 7168, 7168, 68, 4, 0, G, c); epi::EpiResid E{(float*)(F.ws + WS_XW), modacc + 5120, adab + 5120};
                const int full = (S.nwg / G) * G; const bool split = (hi - lo > 1) && S.nwg > full && (S.nwg - full) * 14 <= G;
                if (split) S.lim = full;
                pg8::gemm_phase(lds, S, E, 7168, 7168, 56);
                if (split) { pg8::SplitSched T{S, full, 14, 512, c}; epi::EpiSlab ES{(float*)(F.ws + WS_SLB_G)}; pg8::gemm_phase(lds, T, ES, 7168, 7168, 4); xcd_barrier(bar);
                    combine_resid(F, S, full, S.nwg - full, 14, (const float*)(F.ws + WS_SLB_G), modacc + 5120, adab + 5120); } }
            else { MoeSeg sg; moe_seg(F, sg); pg8::MoeDownSched S; S.HID = (const char*)(F.ws + WS_MHID); S.W = (const char*)(F.ws + WS_MW2); S.ntiles = sg.tstart[NE]; S.G = G; S.c = c;
#pragma unroll
                for (int e = 0; e <= NE; ++e) S.ts[e] = sg.tstart[e];
                const int nU = sg.tstart[NE] * 4, full = (nU / G) * G; const bool split = (hi - lo > 1) && nU > full && (nU - full) * 4 <= G;
                S.lim = split ? full : nU;
                epi::EpiStoreBf16 E{(bf16_t*)(F.ws + WS_SLAB), 1024}; pg8::gemm_phase(lds, S, E, 7168, 7168, 56);
                if (split) { pg8::MoeDownTailSched T; T.HID = S.HID; T.W = S.W; T.ntiles = S.ntiles; T.first = full; T.c = c;
#pragma unroll
                    for (int e = 0; e <= NE; ++e) T.ts[e] = sg.tstart[e];
                    epi::EpiSlab ES{(float*)(F.ws + WS_SLB_M)}; pg8::gemm_phase(lds, T, ES, 7168, 7168, 14); xcd_barrier(bar); combine_moe(F, full, nU - full, (const float*)(F.ws + WS_SLB_M)); } }
            SEAM(pb + 11); }
    }

__global__ void __launch_bounds__(NTHREADS, 2) fwd_kernel(Args args) {
    extern __shared__ __attribute__((aligned(16))) unsigned char lds_raw[];
    Frame F;
    F.lds = (LAS unsigned char*)lds_raw; F.ws = args.ws; F.ctl = (unsigned*)(args.ws + WS_CTL);
    F.tid = threadIdx.x; F.lane = F.tid & 63; F.wave = __builtin_amdgcn_readfirstlane(F.tid >> 6); F.G = gridDim.x; F.c = blockIdx.x;
    F.ap = (ArgsP)__builtin_amdgcn_kernarg_segment_ptr();
    volatile LAS unsigned* MISC = (volatile LAS unsigned*)(F.lds + LDS_MISC);
    for (int u = F.tid; u < (LDS_BYTES - LDS_MISC) / 4; u += NTHREADS) MISC[u] = 0u;
    __syncthreads();
    XcdBarrier bar; bar.bar = F.ctl + CW_BAR; bar.x = 0; bar.st = nullptr;
    const int lo = args.ph_lo, hi = args.ph_hi;
    if (hi - lo > 1) bar = xcd_barrier_post(F.ctl + CW_BAR, MISC + 8);

    if (IN(0)) { phase_pre(F); SEAM(0); }

    layer_phases<0>(F, bar, lo, hi);
    layer_phases<1>(F, bar, lo, hi);
    if (IN(25)) phase_final(F);
#ifdef PROBE_GEMM
    if (IN(40)) { pg8::DenseSched S; S.init(F.ws + PROBE_A, F.ws + PROBE_B, PROBE_LD, PROBE_LD, 68, 28, 0, F.G, F.c); S.lim = PROBE_LIM; PROBE_EPI; pg8::gemm_phase(F.lds, S, E, PROBE_LD, PROBE_LD, PROBE_NT); }
#endif
#ifdef PROBE_VARIANTS
#define PV_ITEMS(V) do { for (int it = F.c; it < 272; it += F.G) { const int sc = it % 17, h = (it / 17) & 3, b = it / 68; gla_pass3_item<128, true, V>(F, 0, b, h, sc); } \
        if (F.c >= 16) for (int it = F.c - 16; it < 272; it += 240) { const int sc = it % 17, h = (it / 17) & 3, b = it / 68; gla_pass3_item<64, false, V>(F, 0, b, h, sc); } } while (0)
    if (IN(30)) PV_ITEMS(0);
    if (IN(31)) PV_ITEMS(1);
    if (IN(32)) PV_ITEMS(2);
    if (IN(33)) PV_ITEMS(3);
    if (IN(34)) PV_ITEMS(4);
    if (IN(35)) PV_ITEMS(5);
#endif

#undef IN
#undef SEAM
}

extern "C" void kernel_launch(void* const* d_in, const int* in_sizes, int n_in, void* d_out, int out_size, void* d_ws, size_t ws_size, hipStream_t stream) {
    static int grid = 0;
    if (grid == 0) {
        if (n_in != 33 || ws_size < WS_END) { fprintf(stderr, "kernel_launch: need 33 inputs and %zu bytes of workspace (got %d, %zu)\n", (size_t)WS_END, n_in, ws_size); grid = -1; return; }
        int dev = 0, cus = 0, per_cu = 0;
        if (hipGetDevice(&dev) != hipSuccess || hipDeviceGetAttribute(&cus, hipDeviceAttributeMultiprocessorCount, dev) != hipSuccess) { grid = -1; return; }
        if (hipFuncSetAttribute((const void*)fwd_kernel, hipFuncAttributeMaxDynamicSharedMemorySize, LDS_BYTES) != hipSuccess) { fprintf(stderr, "kernel_launch: hipFuncSetAttribute failed\n"); grid = -1; return; }
        if (hipOccupancyMaxActiveBlocksPerMultiprocessor(&per_cu, (const void*)fwd_kernel, NTHREADS, LDS_BYTES) != hipSuccess || per_cu < 1) fprintf(stderr, "kernel_launch: occupancy query says %d\n", per_cu);
        (void)hipGetLastError();
        grid = cus;
    }
    if (grid < 0) return;
    (void)hipMemsetAsync((char*)d_ws + WS_CTL, 0, CTL_BYTES, stream);
    Args a{};
    for (int i = 0; i < 33; ++i) a.in[i] = (const float*)d_in[i];
    a.out = (float*)d_out; a.ws = (unsigned char*)d_ws;
#if MK_N_LAUNCHES == 1
    a.ph_lo = 0; a.ph_hi = NPHASE;
    hipLaunchKernelGGL(fwd_kernel, dim3(grid), dim3(NTHREADS), LDS_BYTES, stream, a);
#ifdef PROBE_PHASES
    { const int pl[] = {PROBE_PHASES}; for (int k : pl) { a.ph_lo = k; a.ph_hi = k + 1; hipLaunchKernelGGL(fwd_kernel, dim3(grid), dim3(NTHREADS), LDS_BYTES, stream, a); } }
#endif
#else
    for (int k = 0; k < NPHASE; ++k) { if (k == 10) continue; a.ph_lo = k; a.ph_hi = k + 1; hipLaunchKernelGGL(fwd_kernel, dim3(grid), dim3(NTHREADS), LDS_BYTES, stream, a); }
#endif
}
```

```cpp
#include <hip/hip_runtime.h>
#include <cstdio>
#include <cstdint>

#ifndef MK_N_LAUNCHES
#define MK_N_LAUNCHES 1
#endif

#define GAS __attribute__((address_space(1)))
#define LAS __attribute__((address_space(3)))
typedef unsigned short bf16_t;
typedef short bf16x8 __attribute__((ext_vector_type(8)));
typedef short bf16x4 __attribute__((ext_vector_type(4)));
typedef float f32x4 __attribute__((ext_vector_type(4)));
typedef float f32x2 __attribute__((ext_vector_type(2)));
typedef unsigned u32x4 __attribute__((ext_vector_type(4)));
typedef unsigned u32x2 __attribute__((ext_vector_type(2)));

constexpr int D = 1024, NB = 4, SEQ = 4096, CTX = 256, FFN = 3584, NE = 8;
constexpr int MCTX = NB * CTX;
constexpr int MLAT = NB * SEQ;
constexpr int M = MCTX + MLAT;
constexpr int NMIX = 5120, NGATE = 3072, LDP = 4608;
constexpr int N_IN = 7712;
constexpr int NSC = 17;
constexpr int S5L = 32, S5CH = M / S5L;
constexpr int S5ROWS = 768;
constexpr int S5K = 768;
constexpr float EPS = 1e-6f;
constexpr int MOE_ROWS = 2 * MLAT + NE * 256;
constexpr int MOE_TILES = MOE_ROWS / 256;

constexpr size_t MiB = (size_t)1 << 20;
constexpr size_t WS_CTL = 0, CTL_BYTES = 2 * MiB;
constexpr size_t WS_XW = 2 * MiB;
constexpr size_t WS_H = 70 * MiB;
constexpr size_t WS_WSM = 104 * MiB;
constexpr size_t WS_WMIX = WS_WSM;
constexpr size_t WS_WGATE = WS_WMIX + 20 * MiB;
constexpr size_t WS_WBR = WS_WGATE + 12 * MiB;
constexpr size_t WS_WOUT = WS_WBR + 6 * MiB;
constexpr size_t WS_WGLU = WS_WOUT + 4 * MiB;
constexpr size_t WS_W13 = WS_WGLU + 1 * MiB;
constexpr size_t WS_W2 = WS_W13 + 14 * MiB;
constexpr size_t WS_MW2 = WS_WSM;
constexpr size_t WS_S5C = 168 * MiB;
constexpr size_t WS_S5V = WS_S5C + 24 * MiB;
constexpr size_t WS_BIG = 200 * MiB;
constexpr size_t WS_P = WS_BIG;
constexpr size_t WS_Y = WS_BIG + 153 * MiB;
constexpr size_t WS_YPRE = WS_BIG + 204 * MiB;
constexpr size_t WS_UG = WS_BIG + 221 * MiB;
constexpr size_t WS_SLOC = WS_BIG + 257 * MiB;
constexpr size_t WS_GST = WS_BIG + 281 * MiB;
constexpr size_t WS_GST2 = WS_GST + 34 * MiB;
constexpr size_t WS_GDEC = WS_BIG + 332 * MiB;
constexpr size_t WS_HID = WS_BIG;
constexpr size_t WS_MW13 = WS_BIG;
constexpr size_t WS_MHID = WS_BIG + 112 * MiB;
constexpr size_t WS_SLAB = WS_BIG;
constexpr size_t WS_END = 578 * MiB;
static_assert(WS_MHID + (size_t)MOE_ROWS * FFN * 2 <= WS_END, "ws map");
static_assert(WS_GDEC + 1 * MiB <= WS_END, "ws map");

constexpr int CW_BAR = 0;
constexpr int CW_MOECNT = 4096;
constexpr int CW_WQ = 5120;
constexpr int CW_MOD = 8192;
constexpr int CW_LB = CW_MOD + 61440;
constexpr int CW_TOKE = CW_LB + 2048;
constexpr int CW_TOKR = CW_TOKE + 32768;
constexpr int CW_TOKW = CW_TOKR + 32768;
constexpr int CW_PERM = CW_TOKW + 32768;
constexpr int CW_END = CW_PERM + MOE_ROWS;
constexpr int CW_POS = 262144;
constexpr int CW_PERM2 = 327680;
static_assert(CW_END <= CW_POS && (size_t)(CW_POS + 64 * 512) * 4 <= CTL_BYTES, "ctl pos");
static_assert(CW_POS + 64 * 512 <= CW_PERM2 && (size_t)(CW_PERM2 + 8 * 16384) * 4 <= CTL_BYTES, "ctl perm2");
static_assert((size_t)CW_END * 4 <= CTL_BYTES, "ctl");

constexpr int NTHREADS = 512;
constexpr int LDS_BYTES = 161792;
constexpr int LDS_MISC = 160768;

__device__ __forceinline__ float bf2f(bf16_t v) { return __uint_as_float(((unsigned)v) << 16); }
__device__ __forceinline__ unsigned f2bf(float f) { unsigned u = __float_as_uint(f); return (u + 0x7fffu + ((u >> 16) & 1u)) >> 16; }
typedef __bf16 bf16v2_t __attribute__((ext_vector_type(2)));
__device__ __forceinline__ unsigned pk2(float lo, float hi) { const f32x2 v = {lo, hi}; return __builtin_bit_cast(unsigned, __builtin_convertvector(v, bf16v2_t)); }
__device__ __forceinline__ float fsigmoid(float x) { return __builtin_amdgcn_rcpf(1.0f + __expf(-x)); }
__device__ __forceinline__ float fsilu(float x) { return x * __builtin_amdgcn_rcpf(1.0f + __expf(-x)); }
__device__ __forceinline__ float flogsig(float x) { return fminf(x, 0.f) - __logf(1.0f + __expf(-fabsf(x))); }
__device__ __forceinline__ float wave_sum(float v) {
#pragma unroll
    for (int o = 1; o < 64; o <<= 1) v += __shfl_xor(v, o);
    return v;
}
#define LDS_WAIT() asm volatile("s_waitcnt lgkmcnt(0)" ::: "memory")
#define VM_WAIT() asm volatile("s_waitcnt vmcnt(0)" ::: "memory")

#define XB_TMO      128
#define XB_XCNT(j)  (256  + 64 * (j))
#define XB_XSUB(j)  (1280 + 64 * (j))
#define XB_XGEN(j)  (2304 + 64 * (j))
#define XB_TOP      3328
#define XB_TOPGEN   3392
#define XCD_BAR_WORDS 3456
#define XB_SPIN_CAP (1u << 22)
__device__ __forceinline__ unsigned xb_ld(unsigned* p)              { return __hip_atomic_load(p, __ATOMIC_RELAXED, __HIP_MEMORY_SCOPE_AGENT); }
__device__ __forceinline__ unsigned xb_add(unsigned* p, unsigned v) { return __hip_atomic_fetch_add(p, v, __ATOMIC_RELAXED, __HIP_MEMORY_SCOPE_AGENT); }
__device__ __forceinline__ unsigned xb_xcc_id() { return (unsigned)__builtin_amdgcn_s_getreg((3 << 11) | 20) & 0xFu; }
#define XB_SPIN(cond, bar) do { unsigned _sp = 0; while (cond) { __builtin_amdgcn_s_sleep(1); \
    if ((++_sp & 255u) == 0u) { if (xb_ld(&(bar)[XB_TMO])) break; if (_sp > XB_SPIN_CAP) { atomicAdd(&(bar)[XB_TMO], 1u); break; } } } } while (0)
struct XcdBarrier { unsigned* bar; unsigned x; volatile LAS unsigned* st; };
__device__ __forceinline__ XcdBarrier xcd_barrier_post(unsigned* bar, volatile LAS unsigned* st) {
    XcdBarrier b; b.bar = bar; b.x = xb_xcc_id(); b.st = st;
    if (threadIdx.x == 0) (void)xb_add(&bar[XB_XCNT(b.x)], 1u);
    return b;
}
__device__ __forceinline__ void xcd_barrier_complete(unsigned* bar, unsigned x, unsigned& nloc, unsigned& nx) {
    const unsigned G = gridDim.x * gridDim.y * gridDim.z;
    unsigned sum, cnt, mine, sp = 0u;
    for (;;) {
        sum = 0u; cnt = 0u; mine = 0u;
#pragma unroll
        for (unsigned j = 0; j < 16; ++j) { const unsigned c = xb_ld(&bar[XB_XCNT(j)]); sum += c; cnt += (c > 0u) ? 1u : 0u; mine = (j == x) ? c : mine; }
        if (sum == G) break;
        __builtin_amdgcn_s_sleep(1);
        if ((++sp & 255u) == 0u) { if (xb_ld(&bar[XB_TMO])) break; if (sp > XB_SPIN_CAP) { atomicAdd(&bar[XB_TMO], 1u); break; } }
    }
    nloc = mine > 0u ? mine : 1u; nx = cnt > 0u ? cnt : 1u;
}
__device__ __forceinline__ void xcd_barrier(const XcdBarrier& b) {
    asm volatile("s_waitcnt vmcnt(0)" ::: "memory");
    __syncthreads();
    if (threadIdx.x == 0) {
        unsigned* bar = b.bar;
        __builtin_amdgcn_s_waitcnt(0);
        unsigned nloc = b.st[0], nx = b.st[1];
        if (nloc == 0u) { xcd_barrier_complete(bar, b.x, nloc, nx); b.st[0] = nloc; b.st[1] = nx; }
        const unsigned old = xb_add(&bar[XB_XSUB(b.x)], 1u);
        const unsigned gen = old / nloc;
        if (old + 1u == (gen + 1u) * nloc) {
            __builtin_amdgcn_fence(__ATOMIC_RELEASE, "agent");
            asm volatile("s_waitcnt vmcnt(0)" ::: "memory");
            const unsigned og = xb_add(&bar[XB_TOP], 1u);
            const unsigned tg = og / nx;
            if (og + 1u == (tg + 1u) * nx) xb_add(&bar[XB_TOPGEN], 1u);
            else XB_SPIN(xb_ld(&bar[XB_TOPGEN]) == tg, bar);
            __builtin_amdgcn_fence(__ATOMIC_ACQUIRE, "agent");
            xb_add(&bar[XB_XGEN(b.x)], 1u);
            asm volatile("s_waitcnt vmcnt(0)" ::: "memory");
        } else {
            XB_SPIN(xb_ld(&bar[XB_XGEN(b.x)]) == gen, bar);
            __builtin_amdgcn_fence(__ATOMIC_ACQUIRE, "agent");
            asm volatile("s_waitcnt vmcnt(0)" ::: "memory");
        }
    }
    __syncthreads();
}
namespace pg8 {
constexpr int BM = 256, BK = 64, HALF = 128, HTB = HALF * BK * 2, STAGE_BYTES = 8 * HTB;
__host__ __device__ __forceinline__ int lds_byte(int r, int c) { const int st = (r >> 4) * 2 + (c >> 5), rr = r & 15, cc = c & 31, ob = rr * 64 + cc * 2; return st * 1024 + (ob ^ (((ob >> 9) & 1) << 5)); }
__host__ __device__ __forceinline__ void stage_rc(int b, int& R, int& C) { const int st = b / 1024, sb = b % 1024, swz = sb ^ (((sb >> 9) & 1) << 5); R = (st >> 1) * 16 + swz / 64; C = (st & 1) * 32 + (swz % 64) / 2; }
__host__ __device__ __forceinline__ int perm32(int rho) { const int n = rho >> 4, i = rho & 15; return 8 * (i >> 2) + 4 * n + (i & 3); }

struct GUnit { const char* A; const char* B; int i0, i1, i2, i3; };

template <class Sched, class Epi>
__device__ __forceinline__ void gemm_phase(LAS unsigned char* lds, const Sched& S, const Epi& E, const int lda, const int ldb, const int nt) {
    int tid_ = threadIdx.x; asm volatile("" : "+v"(tid_));
    const int tid = tid_, wid = __builtin_amdgcn_readfirstlane(tid >> 6), lane = tid & 63, wr = wid >> 2, wc = wid & 3, fr = lane & 15, fq = lane >> 4;
    constexpr bool GATHER = Sched::GATHER;
    unsigned voffA[2], voffB[2]; int RA[2], CA[2];
#pragma unroll
    for (int i = 0; i < 2; ++i) { int R, C; stage_rc(tid * 16 + i * 8192, R, C); const int Rb = Epi::PERM ? ((R & ~31) + perm32(R & 31)) : R;
        RA[i] = R; CA[i] = C; voffA[i] = (unsigned)(R * lda + C * 2); voffB[i] = (unsigned)(Rb * ldb + C * 2); }
    unsigned gAc[2], gAn[2];
    const size_t kstep = (size_t)(BK * 2);
    const size_t hstepA = GATHER ? 0 : (size_t)HALF * lda, hstepB = (size_t)HALF * ldb;
    const unsigned ldsw = (unsigned)wid * 1024u;
    const int aoff = lds_byte(wr * 64 + fr, fq * 8), boff = lds_byte(wc * 32 + fr, fq * 8);
#define PG8_SA(b, h) (((b) * 2 + (h)) * HTB)
#define PG8_SB(b, h) ((4 + (b) * 2 + (h)) * HTB)
#define PG8_STAGE(bufoff, gbase, voff) do { _Pragma("unroll") for (int _i = 0; _i < 2; ++_i) \
        __builtin_amdgcn_global_load_lds((const unsigned*)((const char*)(gbase) + (voff)[_i]), (LAS unsigned*)(lds + (bufoff) + ldsw + _i * 8192), 16, 0, 0); } while (0)
#define PG8_STAGE_A(bufoff, gbase, h, nx) do { if constexpr (GATHER) { const unsigned _pk = (nx) ? gAn[h] : gAc[h]; unsigned _vo[2]; _vo[0] = (_pk & 0xffffu) * (unsigned)lda + (unsigned)(CA[0] * 2); _vo[1] = (_pk >> 16) * (unsigned)lda + (unsigned)(CA[1] * 2); \
        PG8_STAGE(bufoff, gbase, _vo); } else PG8_STAGE(bufoff, (gbase) + (h) * hstepA, voffA); } while (0)
#define PG8_LDA(dst, b, h) do { _Pragma("unroll") for (int m = 0; m < 4; ++m) _Pragma("unroll") for (int k = 0; k < 2; ++k) dst[m][k] = *(const LAS bf16x8*)(lds + PG8_SA(b, h) + aoff + m * 2048 + k * 1024); } while (0)
#define PG8_LDB(dst, b, h) do { _Pragma("unroll") for (int n = 0; n < 2; ++n) _Pragma("unroll") for (int k = 0; k < 2; ++k) dst[n][k] = *(const LAS bf16x8*)(lds + PG8_SB(b, h) + boff + n * 2048 + k * 1024); } while (0)
#define PG8_MMA(ai, bj, At, Bt) do { __builtin_amdgcn_s_setprio(1); _Pragma("unroll") for (int m = 0; m < 4; ++m) _Pragma("unroll") for (int n = 0; n < 2; ++n) _Pragma("unroll") for (int k = 0; k < 2; ++k) \
        acc[ai][bj][m][n] = __builtin_amdgcn_mfma_f32_16x16x32_bf16(Bt[n][k], At[m][k], acc[ai][bj][m][n], 0, 0, 0); __builtin_amdgcn_s_setprio(0); } while (0)
#define PG8_WAIT_V(n) asm volatile("s_waitcnt vmcnt(" #n ")" ::: "memory")
#define PG8_WAIT_L(n) asm volatile("s_waitcnt lgkmcnt(" #n ")" ::: "memory")
#define PG8_BAR __builtin_amdgcn_s_barrier()
#define PG8_SCHED __builtin_amdgcn_sched_barrier(0)
#define PG8_GVOFF(dst, u) do { if constexpr (GATHER) { const int* _rt = S.rowtab(u); _Pragma("unroll") for (int _h = 0; _h < 2; ++_h) \
        dst[_h] = (unsigned)_rt[_h * HALF + RA[0]] | ((unsigned)_rt[_h * HALF + RA[1]] << 16); } } while (0)
    GUnit cur, nxt; int ui = 0;
    if (!S.next(0, cur)) return;
    f32x4 acc[2][2][4][2];
#pragma unroll
    for (int a = 0; a < 2; ++a)
#pragma unroll
        for (int b = 0; b < 2; ++b)
#pragma unroll
            for (int m = 0; m < 4; ++m)
#pragma unroll
                for (int n = 0; n < 2; ++n) acc[a][b][m][n] = (f32x4){0.f, 0.f, 0.f, 0.f};
    bf16x8 At[4][2], B0[2][2], B1[2][2];
    const char* cA = cur.A; const char* cB = cur.B;
    PG8_GVOFF(gAc, cur);
    PG8_STAGE(PG8_SB(0, 0), cB, voffB); PG8_STAGE_A(PG8_SA(0, 0), cA, 0, false); PG8_STAGE(PG8_SB(0, 1), cB + hstepB, voffB); PG8_STAGE_A(PG8_SA(0, 1), cA, 1, false);
    if (wr == 1) PG8_BAR;
    PG8_WAIT_V(4); PG8_BAR;
    PG8_STAGE(PG8_SB(1, 0), cB + kstep, voffB); PG8_STAGE_A(PG8_SA(1, 0), cA + kstep, 0, false); PG8_STAGE(PG8_SB(1, 1), cB + hstepB + kstep, voffB);
    PG8_WAIT_V(6); PG8_BAR;
    for (;;) {
        const bool has_next = S.next(ui + 1, nxt);
        const char* nA = has_next ? nxt.A : cA; const char* nB = has_next ? nxt.B : cB;
        if constexpr (GATHER) { if (has_next) { PG8_GVOFF(gAn, nxt); } else { gAn[0] = gAc[0]; gAn[1] = gAc[1]; } }
        for (int t = 0; t < nt; t += 2) {
            const bool last = (t == nt - 2);
            const char* a1 = cA + (size_t)(t + 1) * kstep;
            const char* a2 = last ? nA : cA + (size_t)(t + 2) * kstep; const char* b2 = last ? nB : cB + (size_t)(t + 2) * kstep;
            const char* a3 = a2 + kstep; const char* b3 = b2 + kstep;
            PG8_LDB(B0, 0, 0); PG8_SCHED; PG8_LDA(At, 0, 0); PG8_STAGE_A(PG8_SA(1, 1), a1, 1, false);
            PG8_WAIT_L(8); PG8_BAR; PG8_WAIT_L(0); PG8_MMA(0, 0, At, B0); PG8_BAR; PG8_SCHED;
            PG8_LDB(B1, 0, 1); PG8_STAGE(PG8_SB(0, 0), b2, voffB);
            PG8_BAR; PG8_WAIT_L(0); PG8_MMA(0, 1, At, B1); PG8_BAR;
            PG8_LDA(At, 0, 1); PG8_STAGE_A(PG8_SA(0, 0), a2, 0, last);
            PG8_BAR; PG8_WAIT_L(0); PG8_MMA(1, 0, At, B0); PG8_BAR; PG8_SCHED;
            PG8_STAGE(PG8_SB(0, 1), b2 + hstepB, voffB);
            PG8_WAIT_V(6); PG8_BAR; PG8_MMA(1, 1, At, B1); PG8_BAR;
            PG8_LDB(B0, 1, 0); PG8_SCHED; PG8_LDA(At, 1, 0); PG8_STAGE_A(PG8_SA(0, 1), a2, 1, last);
            PG8_WAIT_L(8); PG8_BAR; PG8_WAIT_L(0); PG8_MMA(0, 0, At, B0); PG8_BAR; PG8_SCHED;
            PG8_LDB(B1, 1, 1); PG8_STAGE(PG8_SB(1, 0), b3, voffB);
            PG8_BAR; PG8_WAIT_L(0); PG8_MMA(0, 1, At, B1); PG8_BAR;
            PG8_LDA(At, 1, 1); PG8_STAGE_A(PG8_SA(1, 0), a3, 0, last);
            PG8_BAR; PG8_WAIT_L(0); PG8_MMA(1, 0, At, B0); PG8_BAR; PG8_SCHED;
            PG8_STAGE(PG8_SB(1, 1), b3 + hstepB, voffB);
            PG8_WAIT_V(6); PG8_BAR; PG8_MMA(1, 1, At, B1); PG8_BAR;
        }
        E(acc, cur, wr, wc, fr, fq);
        if (!has_next) break;
#pragma unroll
        for (int a = 0; a < 2; ++a)
#pragma unroll
            for (int b = 0; b < 2; ++b)
#pragma unroll
                for (int m = 0; m < 4; ++m)
#pragma unroll
                    for (int n = 0; n < 2; ++n) acc[a][b][m][n] = (f32x4){0.f, 0.f, 0.f, 0.f};
        cur = nxt; cA = nA; cB = nB; ++ui;
        if constexpr (GATHER) { gAc[0] = gAn[0]; gAc[1] = gAn[1]; }
    }
    PG8_WAIT_V(0);
    if (wr == 0) PG8_BAR;
    PG8_BAR;
#undef PG8_SA
#undef PG8_SB
#undef PG8_STAGE
#undef PG8_STAGE_A
#undef PG8_LDA
#undef PG8_LDB
#undef PG8_MMA
#undef PG8_WAIT_V
#undef PG8_WAIT_L
#undef PG8_BAR
#undef PG8_SCHED
#undef PG8_GVOFF
}

struct DenseSched {
    static constexpr bool GATHER = false;
    const char* A; const char* B; int lda, ldb, nM, nN, pm0, nwg, G, c, lim;
    __device__ void init(const void* A_, const void* B_, int lda_, int ldb_, int nM_, int nN_, int pm0_, int G_, int c_) { A = (const char*)A_; B = (const char*)B_; lda = lda_; ldb = ldb_; nM = nM_; nN = nN_; pm0 = pm0_; nwg = nM * nN; G = G_; c = c_; lim = nwg; }
    __device__ __forceinline__ void tile_of(int L, int& pm, int& pn) const {
        int wgid = L; { const int q = nwg / 8, r = nwg % 8, xcd = wgid % 8, off = wgid / 8; wgid = (xcd < r ? xcd * (q + 1) : r * (q + 1) + (xcd - r) * q) + off; }
        const int nig = 8 * nN, gid = wgid / nig, fm = gid * 8, gsz = (nM - fm) < 8 ? (nM - fm) : 8;
        pm = fm + ((wgid % nig) % gsz) + pm0; pn = (wgid % nig) / gsz; }
    __device__ __forceinline__ bool next(int i, GUnit& u) const {
        const long L = (long)i * G + c; if (L >= lim) return false;
        int wgid = (int)L; { const int q = nwg / 8, r = nwg % 8, xcd = wgid % 8, off = wgid / 8; wgid = (xcd < r ? xcd * (q + 1) : r * (q + 1) + (xcd - r) * q) + off; }
        const int nig = 8 * nN, gid = wgid / nig, fm = gid * 8, gsz = (nM - fm) < 8 ? (nM - fm) : 8;
        const int pm = fm + ((wgid % nig) % gsz) + pm0, pn = (wgid % nig) / gsz;
        u.A = A + (size_t)pm * 256 * lda; u.B = B + (size_t)pn * 256 * ldb; u.i0 = pm; u.i1 = pn; u.i2 = 0; u.i3 = 0; return true;
    }
};
struct SplitSched {
    static constexpr bool GATHER = false;
    DenseSched D; int first, S, kbytes, c;
    __device__ __forceinline__ bool next(int i, GUnit& u) const {
        if (i > 0) return false; const int L = first + c / S, ks = c % S; if (L >= D.nwg) return false;
        int pm, pn; D.tile_of(L, pm, pn);
        u.A = D.A + (size_t)pm * 256 * D.lda + (size_t)ks * kbytes; u.B = D.B + (size_t)pn * 256 * D.ldb + (size_t)ks * kbytes; u.i0 = pm; u.i1 = pn; u.i2 = c; u.i3 = ks; return true; }
};
}
namespace epi {
using pg8::GUnit;
__device__ __forceinline__ void unpack8(const u32x4 w, float (&o)[8]) {
    o[0] = __uint_as_float(w.x << 16); o[1] = __uint_as_float(w.x & 0xffff0000u); o[2] = __uint_as_float(w.y << 16); o[3] = __uint_as_float(w.y & 0xffff0000u);
    o[4] = __uint_as_float(w.z << 16); o[5] = __uint_as_float(w.z & 0xffff0000u); o[6] = __uint_as_float(w.w << 16); o[7] = __uint_as_float(w.w & 0xffff0000u);
}
__device__ __forceinline__ u32x4 pack8(const float (&v)[8]) { u32x4 w; w.x = pk2(v[0], v[1]); w.y = pk2(v[2], v[3]); w.z = pk2(v[4], v[5]); w.w = pk2(v[6], v[7]); return w; }
#define EPI_ROWS_BEGIN(pmrow0) _Pragma("unroll") for (int ai = 0; ai < 2; ++ai) _Pragma("unroll") for (int m = 0; m < 4; ++m) { const int row = (pmrow0) + ai * 128 + wr * 64 + m * 16 + fr;
#define EPI_ROWS_END asm volatile("" ::: "memory"); }

struct EpiWin {
    static constexpr bool PERM = true;
    bf16_t* P; bf16_t* UG; const float* loglb; const float* logub; const float* gbias;
    template <int TYPE>
    __device__ __forceinline__ void body(const f32x4 (&acc)[2][2][4][2], const GUnit& u, int wr, int wc, int fr, int fq) const {
        const int pm = u.i0, pn = u.i1;
#pragma unroll
        for (int bj = 0; bj < 2; ++bj) {
            const int col = pn * 256 + bj * 128 + wc * 32 + 8 * fq;
            float pa[8], pb[8];
#pragma unroll
            for (int j = 0; j < 8; ++j) { pa[j] = 0.f; pb[j] = 0.f; }
            if (TYPE == 1) { const int ch = col & 511;
#pragma unroll
                for (int j = 0; j < 8; ++j) { pa[j] = loglb[ch + j]; pb[j] = logub[ch + j]; } }
            if (TYPE == 4) { const int n = col - 3584;
#pragma unroll
                for (int j = 0; j < 8; ++j) pa[j] = gbias[n + j]; }
            EPI_ROWS_BEGIN(pm * 256)
                float v[8];
#pragma unroll
                for (int j = 0; j < 4; ++j) { v[j] = acc[ai][bj][m][0][j]; v[4 + j] = acc[ai][bj][m][1][j]; }
                if (TYPE == 1) {
#pragma unroll
                    for (int j = 0; j < 8; ++j) { const float z = v[j], t = __expf(-fabsf(z)), rc = __builtin_amdgcn_rcpf(1.0f + t), sg = z >= 0.f ? rc : t * rc;
                        const bool pos = pa[j] > 0.f; const float L = __logf(pos ? pa[j] + pb[j] * sg : 1.0f + t); v[j] = pos ? L : fminf(z, 0.f) - L; }
                } else if (TYPE == 2) {
#pragma unroll
                    for (int j = 0; j < 8; ++j) v[j] = fsilu(v[j]);
                } else if (TYPE == 3) {
#pragma unroll
                    for (int j = 0; j < 8; ++j) v[j] *= 0.125f;
                } else if (TYPE == 4) {
#pragma unroll
                    for (int j = 0; j < 8; ++j) v[j] = flogsig(v[j] + pa[j]) * 0.0625f;
                }
                const u32x4 w = pack8(v);
                if (TYPE == 5) { const int c0 = col - 4608, g = c0 >> 4, p0 = c0 & 15, ck = row >> 5, mm = row & 31;
                    *(u32x4*)(UG + ((size_t)(g * S5ROWS + ck) * S5K + mm * 16 + p0)) = w; }
                else *(u32x4*)(P + (size_t)row * LDP + col) = w;
            EPI_ROWS_END
        }
    }
    __device__ __forceinline__ void operator()(const f32x4 (&acc)[2][2][4][2], const GUnit& u, int wr, int wc, int fr, int fq) const {
        const int pn = u.i1;
        if (pn >= 2 && pn <= 5) body<1>(acc, u, wr, wc, fr, fq);
        else if (pn == 8 || pn == 9 || pn == 16 || pn == 17) body<2>(acc, u, wr, wc, fr, fq);
        else if (pn == 10) body<3>(acc, u, wr, wc, fr, fq);
        else if (pn == 14 || pn == 15) body<4>(acc, u, wr, wc, fr, fq);
        else if (pn >= 18) body<5>(acc, u, wr, wc, fr, fq);
        else body<0>(acc, u, wr, wc, fr, fq);
    }
};
struct GateMap { bf16_t* G; bf16_t* SP; int mode;
    __device__ __forceinline__ bf16_t* loc(int pm, int pn) const {
        int g = -1;
        if (mode == 1) { if (pn >= 10) g = (11 - pn) * 64 + (pm - 4); else if (pn == 9 && pm < 52) g = 128 + (pm - 4); }
        else if (pm < 4) g = pm * 12 + pn;
        return g >= 0 ? SP + (size_t)g * 65536 : G + (size_t)(pm * 12 + pn) * 65536; } };
struct EpiGate {
    static constexpr bool PERM = true;
    GateMap GM;
    __device__ __forceinline__ void operator()(const f32x4 (&acc)[2][2][4][2], const GUnit& u, int wr, int wc, int fr, int fq) const {
        bf16_t* base = GM.loc(u.i0, u.i1);
#pragma unroll
        for (int bj = 0; bj < 2; ++bj) { const int col = bj * 128 + wc * 32 + 8 * fq;
            EPI_ROWS_BEGIN(0)
                float v[8];
#pragma unroll
                for (int j = 0; j < 4; ++j) { v[j] = fsigmoid(acc[ai][bj][m][0][j]); v[4 + j] = fsigmoid(acc[ai][bj][m][1][j]); }
                *(u32x4*)(base + row * 256 + col) = pack8(v);
            EPI_ROWS_END }
    }
};
struct EpiS5Loc {
    static constexpr bool PERM = false;
    float* SL;
    __device__ __forceinline__ void operator()(const f32x4 (&acc)[2][2][4][2], const GUnit& u, int wr, int wc, int fr, int fq) const {
        const int g = u.i0, mt = u.i1;
        EPI_ROWS_BEGIN(mt * 256)
            float* rp = SL + ((size_t)(g * S5ROWS + row)) * 256 + wc * 32 + 4 * fq;
#pragma unroll
            for (int bj = 0; bj < 2; ++bj)
#pragma unroll
                for (int n = 0; n < 2; ++n) *(f32x4*)(rp + bj * 128 + n * 16) = acc[ai][bj][m][n];
        EPI_ROWS_END
    }
};
struct EpiS5Out {
    static constexpr bool PERM = true;
    bf16_t* YP;
    __device__ __forceinline__ void operator()(const f32x4 (&acc)[2][2][4][2], const GUnit& u, int wr, int wc, int fr, int fq) const {
        const int g = u.i0, mt = u.i1, pn = u.i2;
#pragma unroll
        for (int bj = 0; bj < 2; ++bj) { const int col = pn * 256 + bj * 128 + wc * 32 + 8 * fq, mm = col >> 4, p0 = col & 15;
            EPI_ROWS_BEGIN(mt * 256)
                if (row < S5CH) {
                    float v[8];
#pragma unroll
                    for (int j = 0; j < 4; ++j) { v[j] = acc[ai][bj][m][0][j]; v[4 + j] = acc[ai][bj][m][1][j]; }
#pragma unroll
                    for (int j = 0; j < 8; ++j) { const float x = v[j]; v[j] = x * fsigmoid(1.5957691216057308f * (x + 0.044715f * x * x * x)); }
                    *(u32x4*)(YP + (size_t)(row * S5L + mm) * 512 + g * 16 + p0) = pack8(v);
                }
            EPI_ROWS_END }
    }
};
struct EpiGlu {
    static constexpr bool PERM = true;
    const bf16_t* YP; bf16_t* Y;
    __device__ __forceinline__ void operator()(const f32x4 (&acc)[2][2][4][2], const GUnit& u, int wr, int wc, int fr, int fq) const {
        const int col0 = u.i1 * 256 + wc * 32 + 8 * fq;
#pragma unroll
        for (int ai = 0; ai < 2; ++ai) { u32x4 yv[4][2];
#pragma unroll
            for (int m = 0; m < 4; ++m)
#pragma unroll
                for (int bj = 0; bj < 2; ++bj) yv[m][bj] = *(const u32x4*)(YP + (size_t)(u.i0 * 256 + ai * 128 + wr * 64 + m * 16 + fr) * 512 + col0 + bj * 128);
#pragma unroll
            for (int m = 0; m < 4; ++m)
#pragma unroll
                for (int bj = 0; bj < 2; ++bj) { const int row = u.i0 * 256 + ai * 128 + wr * 64 + m * 16 + fr; float y[8], v[8]; unpack8(yv[m][bj], y);
#pragma unroll
                    for (int j = 0; j < 4; ++j) { v[j] = y[j] * fsigmoid(acc[ai][bj][m][0][j]); v[4 + j] = y[4 + j] * fsigmoid(acc[ai][bj][m][1][j]); }
                    *(u32x4*)(Y + (size_t)row * 1536 + 1024 + col0 + bj * 128) = pack8(v); }
            asm volatile("" ::: "memory"); }
    }
};
struct EpiMerge {
    static constexpr bool PERM = true;
    GateMap GM; bf16_t* MG;
#ifdef PROBE_MERGE
    int pmode;
#endif
    __device__ __forceinline__ void operator()(const f32x4 (&acc)[2][2][4][2], const GUnit& u, int wr, int wc, int fr, int fq) const {
        const int k = u.i2, col0 = u.i1 * 256 + wc * 32 + 8 * fq;
        const bf16_t* gb = GM.loc(u.i0, k * 4 + u.i1) + wc * 32 + 8 * fq;
#pragma unroll
        for (int ai = 0; ai < 2; ++ai) { u32x4 gv[4][2], pv[4][2];
#pragma unroll
            for (int m = 0; m < 4; ++m)
#pragma unroll
                for (int bj = 0; bj < 2; ++bj) { const size_t row = (size_t)(u.i0 * 256 + ai * 128 + wr * 64 + m * 16 + fr);
#ifdef PROBE_MERGE
                    gv[m][bj] = (pmode & 2) ? (u32x4){0x3f803f80u, 0x3f803f80u, 0x3f803f80u, 0x3f803f80u} : *(const u32x4*)(gb + (ai * 128 + wr * 64 + m * 16 + fr) * 256 + bj * 128);
                    pv[m][bj] = (k > 0 && !(pmode & 1)) ? *(const u32x4*)(MG + row * 1024 + col0 + bj * 128) : (u32x4){0u, 0u, 0u, 0u}; }
#else
                    gv[m][bj] = *(const u32x4*)(gb + (ai * 128 + wr * 64 + m * 16 + fr) * 256 + bj * 128);
                    pv[m][bj] = k > 0 ? *(const u32x4*)(MG + row * 1024 + col0 + bj * 128) : (u32x4){0u, 0u, 0u, 0u}; }
#endif
#pragma unroll
            for (int m = 0; m < 4; ++m)
#pragma unroll
                for (int bj = 0; bj < 2; ++bj) { const size_t row = (size_t)(u.i0 * 256 + ai * 128 + wr * 64 + m * 16 + fr); float gt[8], pr[8], v[8]; unpack8(gv[m][bj], gt); unpack8(pv[m][bj], pr);
#pragma unroll
                    for (int j = 0; j < 4; ++j) { v[j] = gt[j] * acc[ai][bj][m][0][j] + pr[j]; v[4 + j] = gt[4 + j] * acc[ai][bj][m][1][j] + pr[4 + j]; }
                    *(u32x4*)(MG + row * 1024 + col0 + bj * 128) = pack8(v); }
            asm volatile("" ::: "memory"); }
    }
};
struct EpiResid {
    static constexpr bool PERM = false;
    float* XW; const float* modacc; const float* adab;
    __device__ __forceinline__ void operator()(const f32x4 (&acc)[2][2][4][2], const GUnit& u, int wr, int wc, int fr, int fq) const {
        const int pm = u.i0, bidx = pm < 4 ? 4 : ((pm - 4) >> 4);
        const int col0 = u.i1 * 256 + wc * 32 + 4 * fq;
        f32x4 gv[2][2];
#pragma unroll
        for (int bj = 0; bj < 2; ++bj)
#pragma unroll
            for (int n = 0; n < 2; ++n) gv[bj][n] = *(const f32x4*)(modacc + bidx * 6144 + col0 + bj * 128 + n * 16) + *(const f32x4*)(adab + col0 + bj * 128 + n * 16);
#pragma unroll
        for (int ai = 0; ai < 2; ++ai) { f32x4 xv[4][2][2];
#pragma unroll
            for (int m = 0; m < 4; ++m) { const float* rp = XW + (size_t)(pm * 256 + ai * 128 + wr * 64 + m * 16 + fr) * 1024 + col0;
#pragma unroll
                for (int bj = 0; bj < 2; ++bj)
#pragma unroll
                    for (int n = 0; n < 2; ++n) xv[m][bj][n] = *(const f32x4*)(rp + bj * 128 + n * 16); }
#pragma unroll
            for (int m = 0; m < 4; ++m) { float* rp = XW + (size_t)(pm * 256 + ai * 128 + wr * 64 + m * 16 + fr) * 1024 + col0;
#pragma unroll
                for (int bj = 0; bj < 2; ++bj)
#pragma unroll
                    for (int n = 0; n < 2; ++n) *(f32x4*)(rp + bj * 128 + n * 16) = xv[m][bj][n] + gv[bj][n] * acc[ai][bj][m][n]; }
            asm volatile("" ::: "memory"); }
    }
};
struct EpiSwiglu {
    static constexpr bool PERM = true;
    bf16_t* HID;
    __device__ __forceinline__ void operator()(const f32x4 (&acc)[2][2][4][2], const GUnit& u, int wr, int wc, int fr, int fq) const {
        const int col = u.i1 * 128 + wc * 32 + 8 * fq;
        EPI_ROWS_BEGIN(u.i0 * 256)
            float v[8];
#pragma unroll
            for (int j = 0; j < 4; ++j) { v[j] = fsilu(acc[ai][0][m][0][j]) * acc[ai][1][m][0][j]; v[4 + j] = fsilu(acc[ai][0][m][1][j]) * acc[ai][1][m][1][j]; }
            *(u32x4*)(HID + (size_t)row * FFN + col) = pack8(v);
        EPI_ROWS_END
    }
};
struct EpiStoreBf16 {
    static constexpr bool PERM = true;
    bf16_t* O; int ld;
    __device__ __forceinline__ void operator()(const f32x4 (&acc)[2][2][4][2], const GUnit& u, int wr, int wc, int fr, int fq) const {
#pragma unroll
        for (int bj = 0; bj < 2; ++bj) { const int col = u.i1 * 256 + bj * 128 + wc * 32 + 8 * fq;
            EPI_ROWS_BEGIN(u.i0 * 256)
                float v[8];
#pragma unroll
                for (int j = 0; j < 4; ++j) { v[j] = acc[ai][bj][m][0][j]; v[4 + j] = acc[ai][bj][m][1][j]; }
                *(u32x4*)(O + (size_t)row * ld + col) = pack8(v);
            EPI_ROWS_END }
    }
};
#ifdef PROBE_GEMM
struct EpiNull {
    static constexpr bool PERM = false;
    float* O;
    __device__ __forceinline__ void operator()(const f32x4 (&acc)[2][2][4][2], const GUnit& u, int wr, int wc, int fr, int fq) const {
        f32x4 t = acc[0][0][0][0];
#pragma unroll
        for (int ai = 0; ai < 2; ++ai)
#pragma unroll
            for (int bj = 0; bj < 2; ++bj)
#pragma unroll
                for (int m = 0; m < 4; ++m) { t += acc[ai][bj][m][0]; t += acc[ai][bj][m][1]; }
        if (t[0] + t[1] + t[2] + t[3] == 12345.678f) O[fq] = t[0];
    }
};
#endif
struct EpiSlab {
    static constexpr bool PERM = false;
    float* SLB;
    __device__ __forceinline__ void operator()(const f32x4 (&acc)[2][2][4][2], const GUnit& u, int wr, int wc, int fr, int fq) const {
        float* base = SLB + (size_t)u.i2 * 65536 + wc * 32 + 4 * fq;
#pragma unroll
        for (int ai = 0; ai < 2; ++ai)
#pragma unroll
            for (int m = 0; m < 4; ++m) { float* rp = base + (ai * 128 + wr * 64 + m * 16 + fr) * 256;
#pragma unroll
                for (int bj = 0; bj < 2; ++bj)
#pragma unroll
                    for (int n = 0; n < 2; ++n) *(f32x4*)(rp + bj * 128 + n * 16) = acc[ai][bj][m][n]; }
    }
};
}
struct Args { const float* in[33]; float* out; unsigned char* ws; int ph_lo, ph_hi; };
typedef const __attribute__((address_space(4))) Args* ArgsP;
struct Frame {
    LAS unsigned char* lds;
    unsigned* ctl; unsigned char* ws;
    int tid, lane, wave, G, c;
    ArgsP ap;
};
enum { I_X = 0, I_C, I_CTX, I_CCTX, I_N1G, I_N2G, I_ADAW, I_ADAB, I_WIN, I_LBL, I_HGNG, I_GUP, I_GB, I_GLNG, I_SARE, I_SAIM, I_SLOG, I_SBRE, I_SBIM, I_SCRE, I_SCIM, I_SD, I_SGLU, I_BRP, I_WOUT,
       I_FW1, I_FW3, I_FW2, I_RW, I_MW1, I_MW3, I_MW2, I_FNG };

__device__ __forceinline__ void tr_load(const float* W, int ldw, int scol0, int k0, int lane, float (&r)[32]) {
#pragma unroll
    for (int i = 0; i < 32; ++i) r[i] = W[(size_t)(k0 + 2 * i + (lane >> 5)) * ldw + scol0 + (lane & 31)];
}
__device__ __forceinline__ void tr_store(const float (&r)[32], bf16_t* WT, int K, int drow0, int k0, LAS float* scr, int lane) {
#pragma unroll
    for (int i = 0; i < 32; ++i) scr[(2 * i + (lane >> 5)) * 33 + (lane & 31)] = r[i];
    LDS_WAIT(); asm volatile("" ::: "memory");
    const int c = lane & 7;
#pragma unroll
    for (int j = 0; j < 4; ++j) { const int n = (lane >> 3) + 8 * j; const LAS float* s = scr + (8 * c) * 33 + n;
        u32x4 o; o.x = pk2(s[0 * 33], s[1 * 33]); o.y = pk2(s[2 * 33], s[3 * 33]); o.z = pk2(s[4 * 33], s[5 * 33]); o.w = pk2(s[6 * 33], s[7 * 33]);
        *(u32x4*)(WT + (size_t)(drow0 + n) * K + k0 + 8 * c) = o; }
    LDS_WAIT(); asm volatile("" ::: "memory");
}
__device__ __forceinline__ void tr_load4(const float* W, int ldw, int scol0, int k0, int lane, f32x4 (&r)[8]) {
#pragma unroll
    for (int i = 0; i < 8; ++i) r[i] = *(const f32x4*)(W + (size_t)(k0 + 8 * i + (lane >> 3)) * ldw + scol0 + 4 * (lane & 7));
}
__device__ __forceinline__ void tr_store4(const f32x4 (&r)[8], bf16_t* WT, int K, int drow0, int k0, LAS float* scr, int lane) {
#pragma unroll
    for (int i = 0; i < 8; ++i)
#pragma unroll
        for (int j = 0; j < 4; ++j) scr[(8 * i + (lane >> 3)) * 33 + 4 * (lane & 7) + j] = r[i][j];
    LDS_WAIT(); asm volatile("" ::: "memory");
    const int c = lane & 7;
#pragma unroll
    for (int j = 0; j < 4; ++j) { const int n = (lane >> 3) + 8 * j; const LAS float* s = scr + (8 * c) * 33 + n;
        u32x4 o; o.x = pk2(s[0 * 33], s[1 * 33]); o.y = pk2(s[2 * 33], s[3 * 33]); o.z = pk2(s[4 * 33], s[5 * 33]); o.w = pk2(s[6 * 33], s[7 * 33]);
        *(u32x4*)(WT + (size_t)(drow0 + n) * K + k0 + 8 * c) = o; }
    LDS_WAIT(); asm volatile("" ::: "memory");
}
__device__ __forceinline__ void tr_job(Frame& F, int& base, const float* W, int ldw, int scol0, int ncols, int K, bf16_t* WT, int drow0, int dmap) {
    const int gw = F.c * 8 + F.wave, NGW = F.G * 8, nblk = ncols / 32, nitems = (K / 64) * nblk;
    LAS float* scr = (LAS float*)(F.lds + F.wave * 16384);
    int first = gw - (base % NGW); if (first < 0) first += NGW;
    float ra[32], rb[32];
    int it = first;
    if (it < nitems) tr_load(W, ldw, scol0 + (it % nblk) * 32, (it / nblk) * 64, F.lane, ra);
    while (it < nitems) {
        const int nx = it + NGW;
        if (nx < nitems) tr_load(W, ldw, scol0 + (nx % nblk) * 32, (nx / nblk) * 64, F.lane, rb);
        { const int n0 = (it % nblk) * 32; const int dr = dmap == 0 ? drow0 + n0 : drow0 + (n0 >> 7) * 256 + (n0 & 127); tr_store(ra, WT, K, dr, (it / nblk) * 64, scr, F.lane); }
        it = nx;
        if (it >= nitems) break;
        const int nx2 = it + NGW;
        if (nx2 < nitems) tr_load(W, ldw, scol0 + (nx2 % nblk) * 32, (nx2 / nblk) * 64, F.lane, ra);
        { const int n0 = (it % nblk) * 32; const int dr = dmap == 0 ? drow0 + n0 : drow0 + (n0 >> 7) * 256 + (n0 & 127); tr_store(rb, WT, K, dr, (it / nblk) * 64, scr, F.lane); }
        it = nx2;
    }
    base += nitems;
}

struct cplx { float re, im; };
__device__ __forceinline__ cplx cmul(cplx a, cplx b) { return {a.re * b.re - a.im * b.im, a.re * b.im + a.im * b.re}; }
__device__ __forceinline__ cplx s5_pow(float are, float aim, float dt, int j) {
    const float mag = __expf((float)j * are * dt);
    double ang = (double)j * (double)aim * (double)dt; ang -= 6.283185307179586476925 * rint(ang * 0.15915494309189533577);
    const float sn = sinf((float)ang), cs = cosf((float)ang);
    return {mag * cs, mag * sn};
}
__device__ __forceinline__ cplx s5_z(float are, float aim, float dt) {
    const float x = are * dt; double ang = (double)aim * (double)dt; ang -= 6.283185307179586476925 * rint(ang * 0.15915494309189533577);
    const float th = (float)ang, sh = sinf(0.5f * th), em1 = expm1f(x), ex = em1 + 1.0f;
    const float cm1 = -2.0f * sh * sh;
    const float nre = em1 * (1.0f + cm1) + cm1, nim = ex * sinf(th);
    const float den = are * are + aim * aim;
    return {(nre * are + nim * aim) / den, (nim * are - nre * aim) / den};
}
constexpr size_t WS_S5PW = WS_BIG + 334 * MiB;
constexpr size_t WS_S5KT = WS_BIG + 338 * MiB;
constexpr size_t WS_S5BB = WS_BIG + 342 * MiB;
static_assert(WS_S5BB + 1 * MiB <= WS_END, "ws");

__device__ __forceinline__ void s5_tables(Frame& F) {
    float* PW = (float*)(F.ws + WS_S5PW); float* KT = (float*)(F.ws + WS_S5KT);
    LAS float* spw = (LAS float*)F.lds;
    LAS float* sbb = spw + 9 * 128;
    LAS float* scc = sbb + 2048;
    for (int it = F.c; it < 2 * 2 * 32 * 4; it += F.G) {
        const int jq = it & 3, g = (it >> 2) & 31, d = (it >> 7) & 1, l = it >> 8, ldg = (l * 2 + d) * 32 + g, j0 = jq * 8;
        const float dt = __expf(F.ap->in[I_SLOG][ldg]);
        __syncthreads();
        for (int u = F.tid; u < 9 * 64; u += NTHREADS) { const int j = j0 + u / 64, n = u % 64; if (j <= 32) { const cplx p = s5_pow(F.ap->in[I_SARE][ldg * 64 + n], F.ap->in[I_SAIM][ldg * 64 + n], dt, j);
            spw[u * 2] = p.re; spw[u * 2 + 1] = p.im; PW[((size_t)ldg * 33 + j) * 128 + n * 2] = p.re; PW[((size_t)ldg * 33 + j) * 128 + n * 2 + 1] = p.im; } }
        for (int u = F.tid; u < 1024; u += NTHREADS) { const int n = u >> 4, p = u & 15; const cplx z = s5_z(F.ap->in[I_SARE][ldg * 64 + n], F.ap->in[I_SAIM][ldg * 64 + n], dt);
            const cplx b = {F.ap->in[I_SBRE][(size_t)ldg * 1024 + u], F.ap->in[I_SBIM][(size_t)ldg * 1024 + u]}; const cplx bb = cmul(z, b); sbb[u * 2] = bb.re; sbb[u * 2 + 1] = bb.im; if (jq == 0) { float* BB = (float*)(F.ws + WS_S5BB); BB[((size_t)ldg * 1024 + u) * 2] = bb.re; BB[((size_t)ldg * 1024 + u) * 2 + 1] = bb.im; }
            const int pp = u >> 6, nn = u & 63; scc[u * 2] = F.ap->in[I_SCRE][(size_t)ldg * 1024 + pp * 64 + nn]; scc[u * 2 + 1] = F.ap->in[I_SCIM][(size_t)ldg * 1024 + pp * 64 + nn]; }
        __syncthreads();
#pragma unroll
        for (int e = 0; e < 4; ++e) { const int u = F.tid + e * NTHREADS, jj = u >> 8, p = (u >> 4) & 15, q = u & 15; float s = 0.f;
            for (int n = 0; n < 64; ++n) { const cplx c = {scc[(p * 64 + n) * 2], scc[(p * 64 + n) * 2 + 1]}, w = {spw[(jj * 64 + n) * 2], spw[(jj * 64 + n) * 2 + 1]}, b = {sbb[(n * 16 + q) * 2], sbb[(n * 16 + q) * 2 + 1]};
                const cplx cw = cmul(c, w); s += cw.re * b.re - cw.im * b.im; }
            KT[((size_t)ldg * 32 + j0 + jj) * 256 + p * 16 + q] = s; }
    }
    __syncthreads();
}
__device__ __forceinline__ void s5_task_T(Frame& F, const int l, const unsigned t) {
    const float* KT = (const float*)(F.ws + WS_S5KT); bf16_t* BC = (bf16_t*)(F.ws + WS_S5C);
    const int qh = (int)(t & 1), m2 = (int)((t >> 1) & 31), row = (int)((t >> 6) & 511), g = (int)(t >> 15), m = row >> 4, p = row & 15;
    float v[8];
#pragma unroll
    for (int j = 0; j < 8; ++j) v[j] = 0.f;
    if (m2 <= m) { const float* k = KT + ((size_t)((l * 2 + 0) * 32 + g) * 32 + (m - m2)) * 256 + p * 16 + qh * 8;
#pragma unroll
        for (int j = 0; j < 8; ++j) v[j] += k[j]; }
    if (m2 >= m) { const float* k = KT + ((size_t)((l * 2 + 1) * 32 + g) * 32 + (m2 - m)) * 256 + p * 16 + qh * 8;
#pragma unroll
        for (int j = 0; j < 8; ++j) v[j] += k[j]; }
    if (m2 == m && (p >> 3) == qh) v[p & 7] += F.ap->in[I_SD][l * 512 + g * 16 + p];
    *(u32x4*)(BC + ((size_t)(g * 512 + row)) * 768 + m2 * 16 + qh * 8) = epi::pack8(v);
}
__device__ __forceinline__ void s5_task_W(Frame& F, const int l, const unsigned t) {
    const float* PW = (const float*)(F.ws + WS_S5PW); bf16_t* BC = (bf16_t*)(F.ws + WS_S5C);
    const int n8 = (int)(t & 7), c = (int)((t >> 3) & 1), d = (int)((t >> 4) & 1), row = (int)((t >> 5) & 511), g = (int)(t >> 14), m = row >> 4, p = row & 15;
    const int ldg = (l * 2 + d) * 32 + g, e = d == 0 ? m + 1 : 32 - m; float v[8];
#pragma unroll
    for (int j = 0; j < 8; ++j) { const int n = n8 * 8 + j; const cplx cc = {F.ap->in[I_SCRE][(size_t)ldg * 1024 + p * 64 + n], F.ap->in[I_SCIM][(size_t)ldg * 1024 + p * 64 + n]};
        const cplx w = {PW[((size_t)ldg * 33 + e) * 128 + n * 2], PW[((size_t)ldg * 33 + e) * 128 + n * 2 + 1]}; const cplx cw = cmul(cc, w); v[j] = c == 0 ? cw.re : -cw.im; }
    *(u32x4*)(BC + ((size_t)(g * 512 + row)) * 768 + 512 + d * 128 + c * 64 + n8 * 8) = epi::pack8(v);
}
__device__ __forceinline__ void s5_task_V(Frame& F, const int l, const unsigned t) {
    const float* PW = (const float*)(F.ws + WS_S5PW); const float* BB = (const float*)(F.ws + WS_S5BB); bf16_t* VT = (bf16_t*)(F.ws + WS_S5V);
    const int qh = (int)(t & 1), m2 = (int)((t >> 1) & 31), vr = (int)((t >> 6) & 255), g = (int)(t >> 14), d = vr >> 7, c = (vr >> 6) & 1, n = vr & 63;
    const int ldg = (l * 2 + d) * 32 + g, e = d == 0 ? 31 - m2 : m2;
    const cplx w = {PW[((size_t)ldg * 33 + e) * 128 + n * 2], PW[((size_t)ldg * 33 + e) * 128 + n * 2 + 1]}; float v[8];
    const float* bp = BB + ((size_t)ldg * 1024 + n * 16 + qh * 8) * 2;
#pragma unroll
    for (int j = 0; j < 8; ++j) { const cplx b = {bp[j * 2], bp[j * 2 + 1]}; const cplx r = cmul(w, b); v[j] = c == 0 ? r.re : r.im; }
    *(u32x4*)(VT + ((size_t)(g * 256 + vr)) * 512 + m2 * 16 + qh * 8) = epi::pack8(v);
}
template <int L>
__device__ __forceinline__ void bg_s5fill(Frame& F) {
    volatile LAS unsigned* slot = (volatile LAS unsigned*)(F.lds + LDS_MISC + 64);
    for (;;) {
        __syncthreads();
        if (F.tid == 0) slot[0] = __hip_atomic_fetch_add(F.ctl + CW_WQ + 64 * (7 + L), 1u, __ATOMIC_RELAXED, __HIP_MEMORY_SCOPE_AGENT);
        __syncthreads();
        const unsigned blk = slot[0]; if (blk >= 1024u) break;
        if (blk < 512u) { for (int u = 0; u < 4; ++u) s5_task_T(F, L, (blk * 4 + u) * NTHREADS + F.tid); }
        else if (blk < 768u) { for (int u = 0; u < 4; ++u) s5_task_W(F, L, ((blk - 512u) * 4 + u) * NTHREADS + F.tid); }
        else { for (int u = 0; u < 4; ++u) s5_task_V(F, L, ((blk - 768u) * 4 + u) * NTHREADS + F.tid); }
    }
    __syncthreads();
}

struct ConvItem { const float* W; bf16_t* WT; int ldw, scol, ldo, drow, k0; };
__device__ __forceinline__ ConvItem small_item(Frame& F, int l, int it) {
    ConvItem m; const float* win = F.ap->in[I_WIN] + (size_t)l * D * N_IN; bf16_t* wm = (bf16_t*)(F.ws + WS_WMIX) + (size_t)l * NMIX * D; int nblk, loc;
    if (it < 1792) { loc = it; nblk = 112; m.W = win; m.ldw = N_IN; m.scol = 0; m.WT = wm; m.ldo = D; m.drow = 0; }
    else if (it < 2048) { loc = it - 1792; nblk = 16; m.W = win; m.ldw = N_IN; m.scol = 3616; m.WT = wm; m.ldo = D; m.drow = 4096; }
    else if (it < 2304) { loc = it - 2048; nblk = 16; m.W = win; m.ldw = N_IN; m.scol = 4128; m.WT = wm; m.ldo = D; m.drow = 4608; }
    else if (it < 3840) { loc = it - 2304; nblk = 96; m.W = win; m.ldw = N_IN; m.scol = 4640; m.WT = (bf16_t*)(F.ws + WS_WGATE) + (size_t)l * NGATE * D; m.ldo = D; m.drow = 0; }
    else if (it < 4608) { const int k = (it - 3840) >> 8; loc = (it - 3840) & 255; nblk = 32; m.W = F.ap->in[I_BRP] + (size_t)(l * 3 + k) * 512 * D; m.ldw = D; m.scol = 0; m.WT = (bf16_t*)(F.ws + WS_WBR) + (size_t)(l * 3 + k) * D * 512; m.ldo = 512; m.drow = 0; }
    else if (it < 5120) { loc = it - 4608; nblk = 32; m.W = F.ap->in[I_WOUT] + (size_t)l * D * D; m.ldw = D; m.scol = 0; m.WT = (bf16_t*)(F.ws + WS_WOUT) + (size_t)l * D * D; m.ldo = D; m.drow = 0; }
    else { loc = it - 5120; nblk = 16; m.W = F.ap->in[I_SGLU] + (size_t)l * 512 * 512; m.ldw = 512; m.scol = 0; m.WT = (bf16_t*)(F.ws + WS_WGLU) + (size_t)l * 512 * 512; m.ldo = 512; m.drow = 0; }
    const int nb = loc % nblk, kb = loc / nblk; m.scol += nb * 32; m.drow += nb * 32; m.k0 = kb * 64; return m;
}
__device__ __forceinline__ ConvItem ffn_item(Frame& F, int it) {
    ConvItem m; const int mat = it / 1792, loc = it % 1792;
    if (mat < 2) { const int nb = loc % 112, kb = loc / 112, n0 = nb * 32; m.W = F.ap->in[mat == 0 ? I_FW1 : I_FW3]; m.ldw = FFN; m.scol = n0; m.WT = (bf16_t*)(F.ws + WS_W13); m.ldo = D; m.drow = (n0 >> 7) * 256 + (n0 & 127) + (mat == 0 ? 0 : 128); m.k0 = kb * 64; }
    else { const int nb = loc % 32, kb = loc / 32; m.W = F.ap->in[I_FW2]; m.ldw = D; m.scol = nb * 32; m.WT = (bf16_t*)(F.ws + WS_W2); m.ldo = FFN; m.drow = nb * 32; m.k0 = kb * 64; }
    return m;
}
__device__ __forceinline__ ConvItem moe2_item(Frame& F, int it) {
    ConvItem m; const int e = it / 1792, loc = it % 1792, nb = loc % 32, kb = loc / 32;
    m.W = F.ap->in[I_MW2] + (size_t)e * FFN * D; m.ldw = D; m.scol = nb * 32; m.WT = (bf16_t*)(F.ws + WS_MW2) + (size_t)e * D * FFN; m.ldo = FFN; m.drow = nb * 32; m.k0 = kb * 64; return m;
}
template <int SET>
__device__ __forceinline__ void bg_drain(Frame& F) {
    constexpr int NITEMS = SET == 1 ? 8320 : (SET == 2 ? 5248 : 14336), NBLK = NITEMS / 8;
    LAS float* scr = (LAS float*)(F.lds + F.wave * 16384);
    volatile LAS unsigned* slot = (volatile LAS unsigned*)(F.lds + LDS_MISC + 64);
    float ra[32];
    int lane = F.lane; asm volatile("" : "+v"(lane));
    for (;;) {
        __syncthreads();
        if (F.tid == 0) slot[0] = __hip_atomic_fetch_add(F.ctl + CW_WQ + 64 * (3 + SET), 1u, __ATOMIC_RELAXED, __HIP_MEMORY_SCOPE_AGENT);
        __syncthreads();
        const int blk = (int)slot[0]; if (blk >= NBLK) break;
        const int it = blk * 8 + F.wave; ConvItem m;
        if (SET == 1) m = it < 2944 ? small_item(F, 0, 2304 + it) : ffn_item(F, it - 2944); else if (SET == 2) m = small_item(F, 1, it); else m = moe2_item(F, it);
        tr_load(m.W, m.ldw, m.scol, m.k0, lane, ra); tr_store(ra, m.WT, m.ldo, m.drow, m.k0, scr, lane);
    }
    __syncthreads();
}

__device__ __forceinline__ void phase_pre(Frame& F) {
    { const int gw = F.c * 8 + F.wave, NGW = F.G * 8; LAS float* scr = (LAS float*)(F.lds + F.wave * 16384); float ra[32];
        for (int it = gw; it < 2304; it += NGW) { const ConvItem m = small_item(F, 0, it); tr_load(m.W, m.ldw, m.scol, m.k0, F.lane, ra); tr_store(ra, m.WT, m.ldo, m.drow, m.k0, scr, F.lane); } }
    __syncthreads();
    const size_t gt = (size_t)F.c * NTHREADS + F.tid, NT = (size_t)F.G * NTHREADS;
    for (size_t t = gt; t < (size_t)2 * 2 * 256 * 128; t += NT) {
        const int k8 = (int)(t & 127), n = (int)((t >> 7) & 255), dir = (int)((t >> 15) & 1), l = (int)(t >> 16);
        const float* win = F.ap->in[I_WIN] + (size_t)l * D * N_IN + 3584 + 16 * dir; const float* up = F.ap->in[I_GUP] + (size_t)((l * 2 + dir) * 16) * 256 + n;
        float upv[16];
#pragma unroll
        for (int r = 0; r < 16; ++r) upv[r] = up[r * 256];
        float v[8];
#pragma unroll
        for (int j = 0; j < 8; ++j) { const float* wr = win + (size_t)(k8 * 8 + j) * N_IN; float s = 0.f;
#pragma unroll
            for (int r = 0; r < 16; ++r) s += wr[r] * upv[r];
            v[j] = s; }
        *(u32x4*)((bf16_t*)(F.ws + WS_WMIX) + ((size_t)l * NMIX + 3584 + 256 * dir + n) * D + k8 * 8) = epi::pack8(v);
    }
    {
        LAS float* cond = (LAS float*)F.lds;
        for (int u = F.tid; u < 5 * 1024; u += NTHREADS) { const int b = u >> 10, k = u & 1023; const float c = b < 4 ? F.ap->in[I_C][b * 1024 + k] : F.ap->in[I_CCTX][k]; cond[u] = fsilu(c); }
        __syncthreads();
        float* modacc = (float*)(F.ctl + CW_MOD);
        LAS float* red = cond + 5 * 1024;
        for (int blk = F.c; blk < 256; blk += F.G) {
            const int l = blk >> 7, col0 = (blk & 127) * 48;
            if (F.tid < 384) { const int cj = F.tid % 48, ks = F.tid / 48;
                const float* w = F.ap->in[I_ADAW] + (size_t)l * D * 6144 + (size_t)(ks * 128) * 6144 + col0 + cj; float a[5] = {0.f, 0.f, 0.f, 0.f, 0.f};
                for (int k0 = 0; k0 < 128; k0 += 32) { float wv[32];
#pragma unroll
                    for (int k = 0; k < 32; ++k) wv[k] = w[(size_t)(k0 + k) * 6144];
#pragma unroll
                    for (int k = 0; k < 32; ++k)
#pragma unroll
                        for (int b = 0; b < 5; ++b) a[b] += cond[b * 1024 + ks * 128 + k0 + k] * wv[k]; }
#pragma unroll
                for (int b = 0; b < 5; ++b) red[(ks * 48 + cj) * 5 + b] = a[b]; }
            __syncthreads();
            if (F.tid < 240) { const int cj = F.tid % 48, b = F.tid / 48; float sacc = 0.f;
#pragma unroll
                for (int ks = 0; ks < 8; ++ks) sacc += red[(ks * 48 + cj) * 5 + b];
                modacc[(l * 5 + b) * 6144 + col0 + cj] = sacc; }
            __syncthreads();
        }
        __syncthreads();
    }
    if (F.c == 0) { float* lbp = (float*)(F.ctl + CW_LB);
        for (int ch = F.tid; ch < 512; ch += NTHREADS) { const float l0 = F.ap->in[I_LBL][ch], l1 = F.ap->in[I_LBL][512 + ch];
            lbp[ch] = 0.f; lbp[1024 + ch] = 1.0f;
            lbp[512 + ch] = fsigmoid(l1 - l0); lbp[1024 + 512 + ch] = fsigmoid(l0 - l1); } }
    { float* PT = (float*)(F.ctl + CW_POS);
        for (size_t t = gt; t < (size_t)64 * 512; t += NT) { const int pp = (int)(t >> 9), q = (int)(t & 511), i = q & 255; const float om = exp2f(-(float)i * (13.287712379549449f / 256.0f)), a = (float)pp * om; PT[t] = q < 256 ? sinf(a) : cosf(a); } }
    s5_tables(F);
}

constexpr int RT_OFF = 5 * 2048 * 4, RT_SLOTS = 16, RW_OFF = 49152;
__device__ __forceinline__ void route_write(Frame& F, int tok, int i1, int i2, int rk1, int rk2, float w1, float w2) {
    int* te = (int*)(F.ctl + CW_TOKE); int* tr = (int*)(F.ctl + CW_TOKR); float* tw = (float*)(F.ctl + CW_TOKW);
    te[tok * 2] = i1; te[tok * 2 + 1] = i2; tr[tok * 2] = rk1; tr[tok * 2 + 1] = rk2; tw[tok * 2] = w1; tw[tok * 2 + 1] = w2;
    int* pm2 = (int*)(F.ctl + CW_PERM2); pm2[i1 * 16384 + rk1] = tok; pm2[i2 * 16384 + rk2] = tok;
}
template <int MODE>
__device__ __forceinline__ void norm_load(Frame& F, int row, f32x4 (&v)[4]) {
    const int lane = F.lane; const float* XW = (const float*)(F.ws + WS_XW);
    if (MODE == 0) {
        if (row < MCTX) {
#pragma unroll
            for (int j = 0; j < 4; ++j) v[j] = *(const f32x4*)(F.ap->in[I_CTX] + (size_t)row * D + 4 * lane + 256 * j);
        } else { const int rl = row - MCTX;
#pragma unroll
            for (int j = 0; j < 4; ++j) v[j] = *(const f32x4*)(F.ap->in[I_X] + (size_t)rl * D + 4 * lane + 256 * j); }
    } else {
#pragma unroll
        for (int j = 0; j < 4; ++j) v[j] = *(const f32x4*)(XW + (size_t)row * D + 4 * lane + 256 * j);
    }
}
template <int MODE>
__device__ __forceinline__ void norm_finish(Frame& F, int row, f32x4 (&v)[4], const int slot = -1) {
    const int bidx = row < MCTX ? 4 : ((row - MCTX) >> 12); const LAS float* GA = (const LAS float*)F.lds + bidx * 2048;
    float* XW = (float*)(F.ws + WS_XW); bf16_t* H = (bf16_t*)(F.ws + WS_H);
    const int lane = F.lane;
    if (MODE == 0) {
        if (row >= MCTX) { const int rl = row - MCTX, t = rl & 4095; const float* PT = (const float*)(F.ctl + CW_POS);
#pragma unroll
            for (int j = 0; j < 4; ++j) v[j] = v[j] + *(const f32x4*)(PT + ((j < 2 ? (t >> 6) : (t & 63)) * 512 + (j & 1) * 256 + 4 * lane)); }
#pragma unroll
        for (int j = 0; j < 4; ++j) *(f32x4*)(XW + (size_t)row * D + 4 * lane + 256 * j) = v[j];
    }
    float ss = 0.f;
#pragma unroll
    for (int j = 0; j < 4; ++j) ss += (v[j][0] * v[j][0] + v[j][1] * v[j][1]) + (v[j][2] * v[j][2] + v[j][3] * v[j][3]);
    const float rstd = 1.0f / sqrtf(wave_sum(ss) * (1.0f / D) + EPS);
    float lg[8];
#pragma unroll
    for (int e = 0; e < 8; ++e) lg[e] = 0.f;
#pragma unroll
    for (int j = 0; j < 4; ++j) { const int d0 = 4 * lane + 256 * j;
        const f32x4 h = (v[j] * rstd) * *(const LAS f32x4*)(GA + d0) + *(const LAS f32x4*)(GA + 1024 + d0);
        u32x2 w; w.x = pk2(h[0], h[1]); w.y = pk2(h[2], h[3]);
        *(u32x2*)(H + (size_t)row * D + d0) = w;
        if (MODE == 2) {
#pragma unroll
            for (int e = 0; e < 4; ++e) { const LAS float* rp = (const LAS float*)(F.lds + RW_OFF) + (lane + 64 * j) * 36 + e * 8; const f32x4 r0v = *(const LAS f32x4*)rp, r1v = *(const LAS f32x4*)(rp + 4);
                lg[0] += h[e] * r0v[0]; lg[1] += h[e] * r0v[1]; lg[2] += h[e] * r0v[2]; lg[3] += h[e] * r0v[3]; lg[4] += h[e] * r1v[0]; lg[5] += h[e] * r1v[1]; lg[6] += h[e] * r1v[2]; lg[7] += h[e] * r1v[3]; } }
    }
    if (MODE == 2) {
#pragma unroll
        for (int e = 0; e < 8; ++e) lg[e] = wave_sum(lg[e]);
        if (lane == 0) {
            int i1 = 0; float m1 = lg[0];
#pragma unroll
            for (int e = 1; e < 8; ++e) if (lg[e] > m1) { m1 = lg[e]; i1 = e; }
            int i2 = -1; float m2 = -3.0e38f;
#pragma unroll
            for (int e = 0; e < 8; ++e) if (e != i1 && lg[e] > m2) { m2 = lg[e]; i2 = e; }
            const float w1 = 1.0f / (1.0f + __expf(m2 - m1)), w2 = 1.0f - w1;
            const int tok = row - MCTX;
            if (slot >= 0) {
                LAS unsigned* lc = (LAS unsigned*)(F.lds + RT_OFF);
                const unsigned l1 = __hip_atomic_fetch_add(lc + i1, 1u, __ATOMIC_RELAXED, __HIP_MEMORY_SCOPE_WORKGROUP), l2 = __hip_atomic_fetch_add(lc + i2, 1u, __ATOMIC_RELAXED, __HIP_MEMORY_SCOPE_WORKGROUP);
                LAS int* ent = (LAS int*)(F.lds + RT_OFF + 128) + (F.wave * RT_SLOTS + slot) * 8;
                ent[0] = tok; ent[1] = i1; ent[2] = i2; ent[3] = (int)l1; ent[4] = (int)l2; ent[5] = __float_as_int(w1); ent[6] = __float_as_int(w2);
            } else {
                const int rk1 = (int)atomicAdd(F.ctl + CW_MOECNT + 64 * i1, 1u), rk2 = (int)atomicAdd(F.ctl + CW_MOECNT + 64 * i2, 1u);
                route_write(F, tok, i1, i2, rk1, rk2, w1, w2); }
        }
    }
}
template <int MODE>
__device__ __forceinline__ void norm_rows(Frame& F, int l, int moff  , const float* gain) {
    const float* modacc = (const float*)(F.ctl + CW_MOD) + (size_t)l * 5 * 6144; const float* adab = F.ap->in[I_ADAB] + (size_t)l * 6144;
    LAS float* GA = (LAS float*)F.lds;
    for (int u = F.tid; u < 5 * 1024; u += NTHREADS) { const int b = u >> 10, dd = u & 1023;
        const float sh = modacc[b * 6144 + moff + dd] + adab[moff + dd], sc = modacc[b * 6144 + moff + 1024 + dd] + adab[moff + 1024 + dd];
        GA[b * 2048 + dd] = gain[dd] * (sc + 1.0f); GA[b * 2048 + 1024 + dd] = sh; }
    const int gw = F.c * 8 + F.wave, NGW = F.G * 8;
    const int r0 = MODE == 2 ? MCTX : 0;
    const bool agg = MODE == 2 && (MLAT + NGW - 1) / NGW <= RT_SLOTS;
    if (MODE == 2 && F.tid < 16) ((LAS unsigned*)(F.lds + RT_OFF))[F.tid] = 0u;
    if (MODE == 2) { LAS float* RWL = (LAS float*)(F.lds + RW_OFF); for (int u = F.tid; u < 8192; u += NTHREADS) { const int d = u >> 3; RWL[(d >> 2) * 36 + (d & 3) * 8 + (u & 7)] = F.ap->in[I_RW][u]; } }
    __syncthreads();
    for (int row = r0 + gw; row < M; row += 2 * NGW) {
        const int rowB = row + NGW; const bool hasB = rowB < M;
        f32x4 va[4], vb[4];
        norm_load<MODE>(F, row, va);
        if (hasB) norm_load<MODE>(F, rowB, vb);
        const int slot = agg ? (row - r0 - gw) / NGW : -1;
        norm_finish<MODE>(F, row, va, slot);
        if (hasB) norm_finish<MODE>(F, rowB, vb, agg ? slot + 1 : -1);
    }
    __syncthreads();
    if (MODE == 2 && agg) {
        LAS unsigned* lc = (LAS unsigned*)(F.lds + RT_OFF);
        if (F.tid < 8) lc[8 + F.tid] = lc[F.tid] ? atomicAdd(F.ctl + CW_MOECNT + 64 * F.tid, lc[F.tid]) : 0u;
        __syncthreads();
        if (F.tid < 8 * RT_SLOTS) { const int w = F.tid / RT_SLOTS, k = F.tid % RT_SLOTS;
            if (F.c * 8 + w + k * NGW < MLAT) { const LAS int* ent = (const LAS int*)(F.lds + RT_OFF + 128) + F.tid * 8;
                const int i1 = ent[1], i2 = ent[2];
                route_write(F, ent[0], i1, i2, (int)lc[8 + i1] + ent[3], (int)lc[8 + i2] + ent[4], __int_as_float(ent[5]), __int_as_float(ent[6])); } }
        __syncthreads();
    }
}

struct MoeSeg { int cnt[NE], tstart[NE + 1]; };
__device__ __forceinline__ void moe_seg(Frame& F, MoeSeg& s) {
    int acc = 0;
#pragma unroll
    for (int e = 0; e < NE; ++e) { const int c = (int)__hip_atomic_load(F.ctl + CW_MOECNT + 64 * e, __ATOMIC_RELAXED, __HIP_MEMORY_SCOPE_AGENT); s.cnt[e] = c; s.tstart[e] = acc; acc += (c + 255) >> 8; }
    s.tstart[NE] = acc;
}
__device__ __forceinline__ void moe_scatter(Frame& F) {
    MoeSeg s; moe_seg(F, s);
    const int* te = (const int*)(F.ctl + CW_TOKE); const int* tr = (const int*)(F.ctl + CW_TOKR); int* perm = (int*)(F.ctl + CW_PERM);
    for (int t = F.c * NTHREADS + F.tid; t < 2 * MLAT; t += F.G * NTHREADS) { const int e = te[t], rk = tr[t]; int ts = 0;
#pragma unroll
        for (int k = 0; k < NE; ++k) ts = (e == k) ? s.tstart[k] : ts;
        perm[ts * 256 + rk] = t >> 1; }
}
struct MoeItem { const float* W; bf16_t* WT; int ldw, scol, K, drow, k0; };
__device__ __forceinline__ MoeItem moe_item(Frame& F, int it) {
    const int job = it / 1792, loc = it % 1792, e = job / 2, mat = job % 2; MoeItem m;
    if (mat < 2) { const int nb = loc % 112, kb = loc / 112, n0 = nb * 32; m.W = F.ap->in[mat == 0 ? I_MW1 : I_MW3] + (size_t)e * D * FFN; m.ldw = FFN; m.scol = n0; m.K = D; m.k0 = kb * 64;
        m.WT = (bf16_t*)(F.ws + WS_MW13) + (size_t)e * 7168 * D; m.drow = (n0 >> 7) * 256 + (n0 & 127) + (mat == 0 ? 0 : 128); }
    else { const int nb = loc % 32, kb = loc / 32; m.W = F.ap->in[I_MW2] + (size_t)e * FFN * D; m.ldw = D; m.scol = nb * 32; m.K = FFN; m.k0 = kb * 64; m.WT = (bf16_t*)(F.ws + WS_MW2) + (size_t)e * D * FFN; m.drow = nb * 32; }
    return m;
}
__device__ __forceinline__ void moe_convert(Frame& F, const int pmode = 0) {
    const int gw = F.c * 8 + F.wave, NGW = F.G * 8, nitems = NE * 2 * 1792;
    LAS float* scr = (LAS float*)(F.lds + F.wave * 16384);
    f32x4 ra[8], rb[8], rc[8];
    if (pmode & 1) { for (int i = 0; i < 8; ++i) { ra[i] = (f32x4){1.f, 2.f, 3.f, 4.f}; rb[i] = ra[i]; rc[i] = ra[i]; } }
    if (pmode & 4) return;
    int it = gw;
#define MC_LOAD(buf, i) do { if ((i) < nitems && !(pmode & 1)) { const MoeItem m_ = moe_item(F, (i)); tr_load4(m_.W, m_.ldw, m_.scol, m_.k0, F.lane, buf); } } while (0)
#define MC_STORE(buf, i) do { const MoeItem m_ = moe_item(F, (i)); if (!(pmode & 2)) tr_store4(buf, m_.WT, m_.K, m_.drow, m_.k0, scr, F.lane); else if (buf[0][0] == 1.2345e-30f) m_.WT[0] = (bf16_t)1; } while (0)
    MC_LOAD(ra, it); MC_LOAD(rb, it + NGW);
    while (it < nitems) {
        MC_LOAD(rc, it + 2 * NGW); MC_STORE(ra, it); it += NGW; if (it >= nitems) break;
        MC_LOAD(ra, it + 2 * NGW); MC_STORE(rb, it); it += NGW; if (it >= nitems) break;
        MC_LOAD(rb, it + 2 * NGW); MC_STORE(rc, it); it += NGW;
    }
#undef MC_LOAD
#undef MC_STORE
    __syncthreads();
}
__device__ __forceinline__ void phase_final(Frame& F) {
    MoeSeg s; moe_seg(F, s);
    const float* XW = (const float*)(F.ws + WS_XW); const bf16_t* SL = (const bf16_t*)(F.ws + WS_SLAB);
    const float* modacc = (const float*)(F.ctl + CW_MOD) + (size_t)1 * 5 * 6144; const float* adab = F.ap->in[I_ADAB] + (size_t)1 * 6144;
    const int* te = (const int*)(F.ctl + CW_TOKE); const int* tr = (const int*)(F.ctl + CW_TOKR); const float* tw = (const float*)(F.ctl + CW_TOKW);
    const int gw = F.c * 8 + F.wave, NGW = F.G * 8, lane = F.lane;
    for (int tok = gw; tok < MLAT; tok += NGW) {
        const int row = MCTX + tok, bidx = tok >> 12; int pos[2];
#pragma unroll
        for (int sl = 0; sl < 2; ++sl) { const int e = __hip_atomic_load(te + tok * 2 + sl, __ATOMIC_RELAXED, __HIP_MEMORY_SCOPE_AGENT); int ts = 0;
#pragma unroll
            for (int k = 0; k < NE; ++k) ts = (e == k) ? s.tstart[k] : ts;
            pos[sl] = ts * 256 + __hip_atomic_load(tr + tok * 2 + sl, __ATOMIC_RELAXED, __HIP_MEMORY_SCOPE_AGENT); }
        const float w0 = __hip_atomic_load(tw + tok * 2, __ATOMIC_RELAXED, __HIP_MEMORY_SCOPE_AGENT), w1 = __hip_atomic_load(tw + tok * 2 + 1, __ATOMIC_RELAXED, __HIP_MEMORY_SCOPE_AGENT);
        f32x4 v[4]; float ss = 0.f;
#pragma unroll
        for (int j = 0; j < 4; ++j) { const int d0 = 4 * lane + 256 * j;
            const f32x4 g2 = *(const f32x4*)(modacc + bidx * 6144 + 5120 + d0) + *(const f32x4*)(adab + 5120 + d0);
            const u32x2 a = *(const u32x2*)(SL + (size_t)pos[0] * D + d0), b = *(const u32x2*)(SL + (size_t)pos[1] * D + d0);
            f32x4 fa, fb; fa[0] = __uint_as_float(a.x << 16); fa[1] = __uint_as_float(a.x & 0xffff0000u); fa[2] = __uint_as_float(a.y << 16); fa[3] = __uint_as_float(a.y & 0xffff0000u);
            fb[0] = __uint_as_float(b.x << 16); fb[1] = __uint_as_float(b.x & 0xffff0000u); fb[2] = __uint_as_float(b.y << 16); fb[3] = __uint_as_float(b.y & 0xffff0000u);
            v[j] = *(const f32x4*)(XW + (size_t)row * D + d0) + g2 * (fa * w0 + fb * w1);
            ss += (v[j][0] * v[j][0] + v[j][1] * v[j][1]) + (v[j][2] * v[j][2] + v[j][3] * v[j][3]); }
        const float rstd = 1.0f / sqrtf(wave_sum(ss) * (1.0f / D) + EPS);
#pragma unroll
        for (int j = 0; j < 4; ++j) { const int d0 = 4 * lane + 256 * j; *(f32x4*)(F.ap->out + (size_t)tok * D + d0) = (v[j] * rstd) * *(const f32x4*)(F.ap->in[I_FNG] + d0); }
    }
}
constexpr int ML_QA = 0, ML_KA = 8704, ML_KBX = 17408, ML_KT = 21760, ML_VT = 32000, ML_AS = 42240, ML_PS = 44800, ML_EL = 46848, ML_E15 = 47360, ML_FLAG = 47872, ML_BC = 47888, ML_STG = 65296, ML_OS = 90896;
static_assert(ML_OS + 65536 <= LDS_MISC, "mixer LDS");


template <int NV> __device__ __forceinline__ void bfly_step(float (&a)[32], int lane, int xb) {
    const bool hi = (lane & xb) != 0;
#pragma unroll
    for (int i = 0; i < NV / 2; ++i) { const float keep = hi ? a[NV / 2 + i] : a[i], send = hi ? a[i] : a[NV / 2 + i]; a[i] = keep + __shfl_xor(send, xb); }
}

__device__ __forceinline__ int sc_row(int r0, int n, int dir) { return dir == 0 ? r0 + n : r0 + 255 - n; }

template <int DK, bool HG, bool OUT> struct Stg {
    static constexpr int KOFF = DK, VOFF = HG ? DK : 2 * DK, QOFF = VOFF + 128, SW = OUT ? QOFF + DK : QOFF, SWP = SW, NPC = SW / 8, NLD = (32 * NPC + NTHREADS - 1) / NTHREADS;
};
template <int DK, bool HG, bool OUT> struct ChunkIn { int unused; };
template <int DK, bool HG, bool OUT>
__device__ __forceinline__ void gla_load(Frame& F, const bf16_t* P, int r0, int c, int dir, int qcol, int gcol, int kcol, int vcol, ChunkIn<DK, HG, OUT>&) {
    typedef Stg<DK, HG, OUT> G;
#pragma unroll
    for (int j = 0; j < G::NLD; ++j) { const int pid = F.tid + NTHREADS * j;
        if (G::NLD * NTHREADS == 32 * G::NPC || F.wave * 64 + NTHREADS * j < 32 * G::NPC) {
            const int tau = pid / G::NPC, c8 = (pid % G::NPC) * 8;
            const int col = c8 < DK ? gcol + c8 : ((!HG && c8 < G::VOFF) ? kcol + c8 - G::KOFF : (c8 < G::QOFF ? vcol + c8 - G::VOFF : qcol + c8 - G::QOFF));
            __builtin_amdgcn_global_load_lds((const unsigned*)(P + (size_t)sc_row(r0, 32 * c + tau, dir) * LDP + col), (LAS unsigned*)(F.lds + ML_STG + (F.wave * 64 + NTHREADS * j) * 16), 16, 0, 0); } }
}
template <int DK, bool HG, bool OUT>
__device__ __forceinline__ void gla_stage(Frame& F, const ChunkIn<DK, HG, OUT>&) { asm volatile("s_waitcnt vmcnt(0)" ::: "memory"); }
template <int DK, bool HG, bool OUT, int VAR = 0>
__device__ __forceinline__ void gla_chunk(Frame& F, const bf16_t* P, ChunkIn<DK, HG, OUT>& N, bool have_next, int nr0, int nc, int ndir, int c, int dir, int qcol, int gcolf, int gcolb, int kcol, int vcol,
                                          f32x4 (&S)[DK / 16], float& gtot) {
    typedef Stg<DK, HG, OUT> G;
    LAS unsigned char* lds = F.lds;
    LAS float* BC = (LAS float*)(lds + ML_BC); LAS bf16_t* QA = (LAS bf16_t*)(lds + ML_QA); LAS bf16_t* KA = (LAS bf16_t*)(lds + ML_KA); LAS bf16_t* KBX = (LAS bf16_t*)(lds + ML_KBX); LAS bf16_t* STG = (LAS bf16_t*)(lds + ML_STG);
    LAS float* E15 = (LAS float*)(lds + ML_E15); volatile LAS unsigned* FLAG = (volatile LAS unsigned*)(lds + ML_FLAG);
    LAS unsigned char* KT = lds + ML_KT; LAS unsigned char* VT = lds + ML_VT; LAS unsigned char* AS = lds + ML_AS; LAS float* PS = (LAS float*)(lds + ML_PS); LAS float* EL = (LAS float*)(lds + ML_EL);
    LAS bf16_t* OS = (LAS bf16_t*)(lds + ML_OS);
    constexpr int NT = DK / 16, NPART = NTHREADS / DK, HS = DK + 8;
    const int tid = F.tid, lane = F.lane, w = F.wave;
    const int d = tid & (DK - 1), part = tid / DK, t0 = part * NT;
    float cs[NT], gg[NT], qq[NT], kk[NT];
    float off = 0.f, tot = 0.f, ref15 = 0.f;
    if (VAR != 4) {
#pragma unroll
        for (int pp = 0; pp < NPART; ++pp) { float ps = 0.f;
#pragma unroll
            for (int i = 0; i < NT; ++i) ps += bf2f(STG[(pp * NT + i) * G::SWP + d]);
            tot += ps; off += (pp < part) ? ps : 0.f; if (pp * NT < 16) ref15 += ps; }
        float run = 0.f;
#pragma unroll
        for (int i = 0; i < NT; ++i) { const LAS bf16_t* rp = STG + (t0 + i) * G::SWP;
            gg[i] = bf2f(rp[d]); if (OUT) qq[i] = bf2f(rp[G::QOFF + d]); if (!HG) kk[i] = bf2f(rp[G::KOFF + d]);
            run += gg[i]; cs[i] = run; }
        if (OUT && tid == 0) FLAG[(c + 1) & 1] = 0u;
        const int v = tid & 127, pv = tid >> 7; unsigned short vb[8];
#pragma unroll
        for (int i = 0; i < 8; ++i) vb[i] = STG[(8 * pv + i) * G::SWP + G::VOFF + v];
        u32x4 wv; wv.x = vb[0] | ((unsigned)vb[1] << 16); wv.y = vb[2] | ((unsigned)vb[3] << 16); wv.z = vb[4] | ((unsigned)vb[5] << 16); wv.w = vb[6] | ((unsigned)vb[7] << 16);
        *(LAS u32x4*)(VT + v * 80 + pv * 16) = wv;
    }
    float bcv[NT], kq[NT];
    if (VAR < 4) {
        float kh[NT];
        bool big = false;
        const float c0 = __expf(tot), c1 = __expf(tot - ref15), e15 = __expf(ref15);
        float qa[NT], ka[NT], kx[NT];
#pragma unroll
        for (int i = 0; i < NT; ++i) { const float bc = off + cs[i], f = __expf(gg[i]), k = HG ? 1.0f - f : kk[i]; const int tau = t0 + i; bcv[i] = bc; kq[i] = k;
            const bool hi = tau >= 16; const float X = (hi ? ref15 : 0.f) - bc;
            const float eX = __expf(fminf(X, 80.f)); ka[i] = k * eX;
            big |= X > 80.f;
            if (OUT && VAR < 2) { qa[i] = qq[i] * __builtin_amdgcn_rcpf(eX); kx[i] = ka[i] * e15; }
            kh[i] = ka[i] * (hi ? c1 : c0); }
        if (big) {
#pragma unroll
            for (int i = 0; i < NT; ++i) kh[i] = kq[i] * __expf(tot - bcv[i]); }
        if (OUT && VAR < 2) {
#pragma unroll
            for (int i = 0; i < NT; i += 2) { const int tau = t0 + i; const unsigned wq = pk2(qa[i], qa[i + 1]), wk2 = pk2(ka[i], ka[i + 1]);
                QA[tau * HS + d] = (bf16_t)(wq & 0xffffu); QA[(tau + 1) * HS + d] = (bf16_t)(wq >> 16); KA[tau * HS + d] = (bf16_t)(wk2 & 0xffffu); KA[(tau + 1) * HS + d] = (bf16_t)(wk2 >> 16);
                if (tau < 16) { const unsigned wx = pk2(kx[i], kx[i + 1]); KBX[tau * HS + d] = (bf16_t)(wx & 0xffffu); KBX[(tau + 1) * HS + d] = (bf16_t)(wx >> 16); } } }
        if (NT == 8) { u32x4 wk; wk.x = pk2(kh[0], kh[1]); wk.y = pk2(kh[2], kh[3]); wk.z = pk2(kh[4 % NT], kh[5 % NT]); wk.w = pk2(kh[6 % NT], kh[7 % NT]); *(LAS u32x4*)(KT + d * 80 + t0 * 2) = wk; }
        else { u32x2 wk; wk.x = pk2(kh[0], kh[1]); wk.y = pk2(kh[2], kh[3]); *(LAS u32x2*)(KT + d * 80 + t0 * 2) = wk; }
        if (OUT && big) FLAG[c & 1] = 1u;
        if (OUT && part == 0) E15[d] = __expf(ref15);
        if (part == 0) { EL[d] = __expf(tot); gtot += tot; }
    }
    __syncthreads();
    bool slow = false;
    if (OUT) slow = __builtin_amdgcn_readfirstlane((int)FLAG[c & 1]) != 0;
    if (OUT && slow) {
#pragma unroll
        for (int i = 0; i < NT; ++i) { const int tau = t0 + i; BC[tau * HS + d] = bcv[i] * 1.4426950408889634f; }
        __syncthreads();
        const int g4 = lane >> 4, r = lane & 15;
        for (int job = w; job < 11; job += 8) {
            const int lvl = job == 0 ? 4 : 3 - ((job - 1) >> 1), tt = job == 0 ? 1 : ((job - 1) & 1), ss = job == 0 ? 0 : tt;
            const int t = 16 * tt + r, sx = 16 * ss + r;
            bool va = true, vb = true; int reft = t, refs = sx;
            if (lvl >= 0) { const int bsz = 2 << lvl, hb = 1 << lvl; va = ((t >> lvl) & 1) != 0; vb = ((sx >> lvl) & 1) == 0; reft = (t & ~(bsz - 1)) + hb - 1; refs = (sx & ~(bsz - 1)) + hb - 1; }
            f32x4 acc = (f32x4){0.f, 0.f, 0.f, 0.f};
#pragma unroll
            for (int kk2 = 0; kk2 < DK / 32; ++kk2) { const int d0 = 32 * kk2 + 8 * g4;
                float qv[8], kv[8]; epi::unpack8(*(const LAS u32x4*)(STG + t * G::SWP + G::QOFF + d0), qv);
                if (HG) { epi::unpack8(*(const LAS u32x4*)(STG + sx * G::SWP + d0), kv);
#pragma unroll
                    for (int j = 0; j < 8; ++j) kv[j] = 1.0f - __expf(kv[j]); }
                else epi::unpack8(*(const LAS u32x4*)(STG + sx * G::SWP + G::KOFF + d0), kv);
                if (lvl >= 0) {
                    const f32x4 bt0 = *(const LAS f32x4*)(BC + t * HS + d0), bt1 = *(const LAS f32x4*)(BC + t * HS + d0 + 4), br0 = *(const LAS f32x4*)(BC + reft * HS + d0), br1 = *(const LAS f32x4*)(BC + reft * HS + d0 + 4);
                    const f32x4 bs0 = *(const LAS f32x4*)(BC + sx * HS + d0), bs1 = *(const LAS f32x4*)(BC + sx * HS + d0 + 4), bq0 = *(const LAS f32x4*)(BC + refs * HS + d0), bq1 = *(const LAS f32x4*)(BC + refs * HS + d0 + 4);
#pragma unroll
                    for (int j = 0; j < 4; ++j) { qv[j] = va ? qv[j] * __builtin_amdgcn_exp2f(bt0[j] - br0[j]) : 0.f; qv[4 + j] = va ? qv[4 + j] * __builtin_amdgcn_exp2f(bt1[j] - br1[j]) : 0.f;
                        kv[j] = vb ? kv[j] * __builtin_amdgcn_exp2f(bq0[j] - bs0[j]) : 0.f; kv[4 + j] = vb ? kv[4 + j] * __builtin_amdgcn_exp2f(bq1[j] - bs1[j]) : 0.f; }
                }
                const u32x4 af = epi::pack8(qv), bf = epi::pack8(kv);
                acc = __builtin_amdgcn_mfma_f32_16x16x32_bf16(__builtin_bit_cast(bf16x8, af), __builtin_bit_cast(bf16x8, bf), acc, 0, 0, 0);
            }
#pragma unroll
            for (int i = 0; i < 4; ++i) { const int to = 16 * tt + 4 * g4 + i, so = 16 * ss + r;
                bool valid; if (lvl >= 0) valid = (((to ^ so) >> (lvl + 1)) == 0) && (((to >> lvl) & 1) != 0) && (((so >> lvl) & 1) == 0); else valid = (to == so);
                if (valid) *(LAS bf16_t*)(AS + to * 80 + so * 2) = (bf16_t)f2bf(acc[i]);
                else if (lvl < 0 && so > to) *(LAS bf16_t*)(AS + to * 80 + so * 2) = (bf16_t)0;
                if (job == 0) *(LAS bf16_t*)(AS + (4 * g4 + i) * 80 + (16 + r) * 2) = (bf16_t)0;
            }
        }
        __syncthreads();
    }
    if (have_next && VAR < 4) gla_load<DK, HG, OUT>(F, P, nr0, nc, ndir, qcol, ndir == 0 ? gcolf : gcolb, kcol, vcol, N);
    {
        const int g4 = lane >> 4, r = lane & 15;
        const bf16x8 bV = *(const LAS bf16x8*)(VT + (16 * w + r) * 80 + g4 * 16);
        if (OUT && VAR < 1) {
            f32x4 o[2];
            if (!slow) {
                f32x4 t00 = (f32x4){0.f, 0.f, 0.f, 0.f}, t01 = t00, t11 = t00;
#pragma unroll
                for (int kk2 = 0; kk2 < DK / 32; ++kk2) { const int d0 = 32 * kk2 + 8 * g4;
                    const bf16x8 q0 = *(const LAS bf16x8*)(QA + r * HS + d0), q1 = *(const LAS bf16x8*)(QA + (16 + r) * HS + d0);
                    const bf16x8 k0 = *(const LAS bf16x8*)(KA + r * HS + d0), k1 = *(const LAS bf16x8*)(KA + (16 + r) * HS + d0), kx = *(const LAS bf16x8*)(KBX + r * HS + d0);
                    t00 = __builtin_amdgcn_mfma_f32_16x16x32_bf16(k0, q0, t00, 0, 0, 0); t01 = __builtin_amdgcn_mfma_f32_16x16x32_bf16(kx, q1, t01, 0, 0, 0); t11 = __builtin_amdgcn_mfma_f32_16x16x32_bf16(k1, q1, t11, 0, 0, 0); }
#pragma unroll
                for (int i = 0; i < 4; ++i) { const bool keep = (4 * g4 + i) <= r; t00[i] = keep ? t00[i] : 0.f; t11[i] = keep ? t11[i] : 0.f; }
                u32x4 a0, a1; a0.x = pk2(t00[0], t00[1]); a0.y = pk2(t00[2], t00[3]); a0.z = 0u; a0.w = 0u; a1.x = pk2(t01[0], t01[1]); a1.y = pk2(t01[2], t01[3]); a1.z = pk2(t11[0], t11[1]); a1.w = pk2(t11[2], t11[3]);
                const u32x2 vlo = *(const LAS u32x2*)(VT + (16 * w + r) * 80 + 8 * g4), vhi = *(const LAS u32x2*)(VT + (16 * w + r) * 80 + 32 + 8 * g4);
                u32x4 vp; vp.x = vlo.x; vp.y = vlo.y; vp.z = vhi.x; vp.w = vhi.y;
                o[0] = __builtin_amdgcn_mfma_f32_16x16x32_bf16(__builtin_bit_cast(bf16x8, a0), __builtin_bit_cast(bf16x8, vp), (f32x4){0.f, 0.f, 0.f, 0.f}, 0, 0, 0);
                o[1] = __builtin_amdgcn_mfma_f32_16x16x32_bf16(__builtin_bit_cast(bf16x8, a1), __builtin_bit_cast(bf16x8, vp), (f32x4){0.f, 0.f, 0.f, 0.f}, 0, 0, 0);
            } else {
#pragma unroll
                for (int tt = 0; tt < 2; ++tt) { const bf16x8 aS = *(const LAS bf16x8*)(AS + (16 * tt + r) * 80 + g4 * 16); o[tt] = __builtin_amdgcn_mfma_f32_16x16x32_bf16(aS, bV, (f32x4){0.f, 0.f, 0.f, 0.f}, 0, 0, 0); }
            }
#pragma unroll
            for (int kk2 = 0; kk2 < DK / 32; ++kk2) {
                const f32x4 e0 = *(const LAS f32x4*)(E15 + 32 * kk2 + 4 * g4), e1 = *(const LAS f32x4*)(E15 + 32 * kk2 + 16 + 4 * g4);
                u32x4 bs, bs2; bs.x = pk2(S[2 * kk2][0], S[2 * kk2][1]); bs.y = pk2(S[2 * kk2][2], S[2 * kk2][3]); bs.z = pk2(S[2 * kk2 + 1][0], S[2 * kk2 + 1][1]); bs.w = pk2(S[2 * kk2 + 1][2], S[2 * kk2 + 1][3]);
                bs2.x = pk2(S[2 * kk2][0] * e0[0], S[2 * kk2][1] * e0[1]); bs2.y = pk2(S[2 * kk2][2] * e0[2], S[2 * kk2][3] * e0[3]); bs2.z = pk2(S[2 * kk2 + 1][0] * e1[0], S[2 * kk2 + 1][1] * e1[1]); bs2.w = pk2(S[2 * kk2 + 1][2] * e1[2], S[2 * kk2 + 1][3] * e1[3]);
#pragma unroll
                for (int tt = 0; tt < 2; ++tt) { const u32x2 lo = *(const LAS u32x2*)(QA + (16 * tt + r) * HS + 32 * kk2 + 4 * g4), hi = *(const LAS u32x2*)(QA + (16 * tt + r) * HS + 32 * kk2 + 16 + 4 * g4);
                    u32x4 aq; aq.x = lo.x; aq.y = lo.y; aq.z = hi.x; aq.w = hi.y;
                    o[tt] = __builtin_amdgcn_mfma_f32_16x16x32_bf16(__builtin_bit_cast(bf16x8, aq), __builtin_bit_cast(bf16x8, tt == 0 ? bs : bs2), o[tt], 0, 0, 0); }
            }
#pragma unroll
            for (int tt = 0; tt < 2; ++tt)
#pragma unroll
                for (int i = 0; i < 4; ++i) { const int n = 32 * c + 16 * tt + 4 * g4 + i, nn = dir == 0 ? n : 255 - n; LAS bf16_t* op = OS + nn * 128 + 16 * w + r;
                    float val = o[tt][i]; if (dir == 1) val += bf2f(*op); *op = (bf16_t)f2bf(val); }
        }
#pragma unroll
        for (int dt = 0; dt < (VAR >= 3 ? 0 : DK / 16); ++dt) { const f32x4 el = *(const LAS f32x4*)(EL + 16 * dt + 4 * g4); const bf16x8 aK = *(const LAS bf16x8*)(KT + (16 * dt + r) * 80 + g4 * 16);
            S[dt] = __builtin_amdgcn_mfma_f32_16x16x32_bf16(aK, bV, S[dt] * el, 0, 0, 0); }
    }
    if (have_next && VAR < 4) gla_stage<DK, HG, OUT>(F, N);
    __syncthreads();
}

template <bool HG> struct MixCols {
    static __device__ __forceinline__ int q(int h) { return HG ? 128 * h : 2560 + 64 * h; }
    static __device__ __forceinline__ int g(int h, int dir) { return HG ? 512 + 512 * dir + 128 * h : 3584 + 256 * dir + 64 * h; }
    static __device__ __forceinline__ int k(int h) { return HG ? 0 : 2816 + 64 * h; }
    static __device__ __forceinline__ int v(int h) { return HG ? 1536 + 128 * h : 3072 + 128 * h; }
    static __device__ __forceinline__ int og(int h) { return HG ? 2048 + 128 * h : 4096 + 128 * h; }
};
__device__ __forceinline__ int sc_r0(int b, int sc) { return sc == 0 ? b * 256 : MCTX + b * 4096 + (sc - 1) * 256; }
__device__ __forceinline__ int sc_of_pos(int dir, int p) { return (dir == 0 || p == 0) ? p : 17 - p; }

template <int DK, bool HG>
__device__ __forceinline__ void gla_pass1_item(Frame& F, int b, int h, int dir, int p) {
    const bf16_t* P = (const bf16_t*)(F.ws + WS_P);
    constexpr int NDT = DK / 16, E = DK * 128;
    const int sc = sc_of_pos(dir, p), r0 = sc_r0(b, sc);
    float* ST = (float*)(F.ws + (HG ? WS_GST : WS_GST2)) + ((size_t)((b * 4 + h) * 2 + dir) * NSC + sc) * E;
    float* DEC = (float*)(F.ws + WS_GDEC) + (HG ? 0 : 4 * 4 * 2 * NSC * 128) + ((size_t)((b * 4 + h) * 2 + dir) * NSC + sc) * DK;
    f32x4 S[NDT];
#pragma unroll
    for (int i = 0; i < NDT; ++i) S[i] = (f32x4){0.f, 0.f, 0.f, 0.f};
    float gtot = 0.f;
    const int gcf = MixCols<HG>::g(h, 0), gcb = MixCols<HG>::g(h, 1), kc = MixCols<HG>::k(h), vc = MixCols<HG>::v(h);
    ChunkIn<DK, HG, false> N;
    gla_load<DK, HG, false>(F, P, r0, 0, dir, 0, dir == 0 ? gcf : gcb, kc, vc, N); gla_stage<DK, HG, false>(F, N); __syncthreads();
    for (int c = 0; c < 8; ++c) gla_chunk<DK, HG, false>(F, P, N, c < 7, r0, c + 1, dir, c, dir, 0, gcf, gcb, kc, vc, S, gtot);
#pragma unroll
    for (int dt = 0; dt < NDT; ++dt)
#pragma unroll
        for (int i = 0; i < 4; ++i) ST[((F.wave * NDT + dt) * 4 + i) * 64 + F.lane] = S[dt][i];
    if (F.tid < DK) DEC[F.tid] = __expf(gtot);
}
template <int DK, bool HG, int VAR = 0>
__device__ __forceinline__ void gla_pass3_item(Frame& F, int l, int b, int h, int sc) {
    const bf16_t* P = (const bf16_t*)(F.ws + WS_P); bf16_t* Y = (bf16_t*)(F.ws + WS_Y);
    constexpr int NDT = DK / 16, E = DK * 128;
    const int r0 = sc_r0(b, sc);
    const int qc = MixCols<HG>::q(h), gcf = MixCols<HG>::g(h, 0), gcb = MixCols<HG>::g(h, 1), kc = MixCols<HG>::k(h), vc = MixCols<HG>::v(h);
    ChunkIn<DK, HG, true> N;
    if (F.tid == 0) { volatile LAS unsigned* FLAG = (volatile LAS unsigned*)(F.lds + ML_FLAG); FLAG[0] = 0u; FLAG[1] = 0u; }
    gla_load<DK, HG, true>(F, P, r0, 0, 0, qc, gcf, kc, vc, N); gla_stage<DK, HG, true>(F, N); __syncthreads();
    for (int dir = 0; dir < 2; ++dir) {
        const float* ST = (const float*)(F.ws + (HG ? WS_GST : WS_GST2)) + ((size_t)((b * 4 + h) * 2 + dir) * NSC + sc) * E;
        f32x4 S[NDT];
#pragma unroll
        for (int dt = 0; dt < NDT; ++dt)
#pragma unroll
            for (int i = 0; i < 4; ++i) S[dt][i] = ST[((F.wave * NDT + dt) * 4 + i) * 64 + F.lane];
        float gtot = 0.f;
        for (int c = 0; c < 8; ++c) { const bool hn = !(dir == 1 && c == 7); const int nc = c < 7 ? c + 1 : 0, nd = c < 7 ? dir : 1;
            gla_chunk<DK, HG, true, VAR>(F, P, N, hn, r0, nc, nd, c, dir, qc, gcf, gcb, kc, vc, S, gtot); }
    }
    {
        const LAS bf16_t* OS = (const LAS bf16_t*)(F.lds + ML_OS);
        const int n = F.tid >> 1, hf = F.tid & 1; float o[64]; float ss = 0.f;
#pragma unroll
        for (int j = 0; j < 8; ++j) { float t8[8]; epi::unpack8(*(const LAS u32x4*)(OS + n * 128 + hf * 64 + j * 8), t8);
#pragma unroll
            for (int e = 0; e < 8; ++e) { o[j * 8 + e] = t8[e]; ss += t8[e] * t8[e]; } }
        ss += __shfl_xor(ss, 1);
        const float rstd = 1.0f / sqrtf(ss * (1.0f / 128.0f) + EPS);
        const float* gain = F.ap->in[HG ? I_HGNG : I_GLNG] + l * 512 + h * 128 + hf * 64;
        const bf16_t* og = P + (size_t)(r0 + n) * LDP + MixCols<HG>::og(h) + hf * 64;
        bf16_t* yo = Y + (size_t)(r0 + n) * 1536 + (HG ? 0 : 512) + h * 128 + hf * 64;
#pragma unroll
        for (int j = 0; j < 8; ++j) { float gt[8], v[8]; epi::unpack8(*(const u32x4*)(og + j * 8), gt);
#pragma unroll
            for (int e = 0; e < 8; ++e) v[e] = o[j * 8 + e] * rstd * gain[j * 8 + e] * gt[e];
            *(u32x4*)(yo + j * 8) = epi::pack8(v); }
    }
    __syncthreads();
}
__device__ __forceinline__ void gla_carry(Frame& F) {
    const size_t gt = (size_t)F.c * NTHREADS + F.tid, NTT = (size_t)F.G * NTHREADS;
    constexpr size_t EH = 16384, EG = 8192, NH = 32 * EH, NGL = 32 * EG;
    for (size_t t = gt; t < NH + NGL; t += NTT) {
        const bool hg = t < NH; const size_t tt = hg ? t : t - NH; const int E = hg ? (int)EH : (int)EG, DK = hg ? 128 : 64, NDT = DK / 16;
        const int chain = (int)(tt / E), e = (int)(tt % E), dir = chain & 1;
        const int ln = e & 63, i = (e >> 6) & 3, dt = (e >> 8) % NDT, dd = 16 * dt + 4 * (ln >> 4) + i;
        float* ST = (float*)(F.ws + (hg ? WS_GST : WS_GST2)) + (size_t)chain * NSC * E + e;
        const float* DEC = (const float*)(F.ws + WS_GDEC) + (hg ? 0 : 4 * 4 * 2 * NSC * 128) + (size_t)chain * NSC * DK + dd;
        float loc[16], dec[16];
#pragma unroll
        for (int p = 0; p < 16; ++p) { const int sc = sc_of_pos(dir, p); loc[p] = ST[(size_t)sc * E]; dec[p] = DEC[sc * DK]; }
        float S = 0.f;
#pragma unroll
        for (int p = 0; p < 16; ++p) { const int sc = sc_of_pos(dir, p); ST[(size_t)sc * E] = S; S = dec[p] * S + loc[p]; }
        ST[(size_t)sc_of_pos(dir, 16) * E] = S;
    }
}
__device__ __forceinline__ void s5_carry(Frame& F, int l) {
    const float* SL = (const float*)(F.ws + WS_SLOC); bf16_t* UG = (bf16_t*)(F.ws + WS_UG); const float* PW = (const float*)(F.ws + WS_S5PW);
    LAS float* EX = (LAS float*)F.lds;
    const int n = F.lane, j = F.wave;
    for (int it = F.c; it < NB * 32 * 2; it += F.G) {
        const int dir = it & 1, g = (it >> 1) & 31, b = it >> 6, ldg = (l * 2 + dir) * 32 + g;
        const cplx a = {PW[((size_t)ldg * 33 + 32) * 128 + n * 2], PW[((size_t)ldg * 33 + 32) * 128 + n * 2 + 1]};
        float lre[17], lim[17]; size_t rbs[17];
#pragma unroll
        for (int i = 0; i < 17; ++i) { const int p = 17 * j + i; int ck;
            if (p < 8) ck = 8 * b + (dir == 0 ? p : 7 - p); else ck = 32 + 128 * b + (dir == 0 ? p - 8 : 135 - p);
            rbs[i] = (size_t)(g * S5ROWS + ck); lre[i] = SL[rbs[i] * 256 + 128 * dir + n]; lim[i] = SL[rbs[i] * 256 + 128 * dir + 64 + n]; }
        float pre_re[17], pre_im[17]; cplx s = {0.f, 0.f};
#pragma unroll
        for (int i = 0; i < 17; ++i) { pre_re[i] = s.re; pre_im[i] = s.im; const cplx t = cmul(a, s); s.re = t.re + lre[i]; s.im = t.im + lim[i]; }
        __syncthreads();
        EX[(j * 64 + n) * 2] = s.re; EX[(j * 64 + n) * 2 + 1] = s.im;
        __syncthreads();
        cplx a2 = cmul(a, a), a4 = cmul(a2, a2), a8 = cmul(a4, a4), a16 = cmul(a8, a8), a17 = cmul(a16, a);
        cplx cin = {0.f, 0.f};
        for (int jj = 0; jj < j; ++jj) { const cplx t = cmul(a17, cin); cin.re = t.re + EX[(jj * 64 + n) * 2]; cin.im = t.im + EX[(jj * 64 + n) * 2 + 1]; }
        cplx wv = {1.f, 0.f};
#pragma unroll
        for (int i = 0; i < 17; ++i) { const cplx t = cmul(wv, cin); const float sre = pre_re[i] + t.re, sim = pre_im[i] + t.im;
            UG[rbs[i] * S5K + 512 + 128 * dir + n] = (bf16_t)f2bf(sre); UG[rbs[i] * S5K + 512 + 128 * dir + 64 + n] = (bf16_t)f2bf(sim);
            wv = cmul(wv, a); }
    }
    __syncthreads();
}
namespace pg8 {
struct S5LocSched { static constexpr bool GATHER = false; const char* UG; const char* VT; int G, c;
    __device__ __forceinline__ bool next(int i, GUnit& u) const { const int L = i * G + c; if (L >= 96) return false; const int g = L / 3, mt = L % 3;
        u.A = UG + ((size_t)(g * S5ROWS + mt * 256)) * (S5K * 2); u.B = VT + (size_t)g * 256 * 1024; u.i0 = g; u.i1 = mt; u.i2 = 0; u.i3 = 0; return true; } };
struct S5OutSched { static constexpr bool GATHER = false; const char* UG; const char* BC; int G, c;
    __device__ __forceinline__ bool next(int i, GUnit& u) const { const int L = i * G + c; if (L >= 192) return false; const int g = L / 6, rem = L % 6, mt = rem >> 1, pn = rem & 1;
        u.A = UG + ((size_t)(g * S5ROWS + mt * 256)) * (S5K * 2); u.B = BC + ((size_t)(g * 512 + pn * 256)) * (S5K * 2); u.i0 = g; u.i1 = mt; u.i2 = pn; u.i3 = 0; return true; } };
struct MergeSched { static constexpr bool GATHER = false; const char* Y; const char* WB; int nM, pm0, G, c, lim;
    __device__ __forceinline__ bool next(int i, GUnit& u) const { const int Lt = (i / 3) * G + c, k = i % 3; if (Lt >= lim) return false; const int pm = pm0 + (Lt >> 2), pn = Lt & 3;
        u.A = Y + (size_t)pm * 256 * 3072 + k * 1024; u.B = WB + ((size_t)(k * 1024 + pn * 256)) * 1024; u.i0 = pm; u.i1 = pn; u.i2 = k; u.i3 = 0; return true; } };
struct MergeTailSched { static constexpr bool GATHER = false; const char* Y; const char* WB; int nM, pm0, first, c;
    __device__ __forceinline__ bool next(int i, GUnit& u) const { if (i > 0) return false; const int Lt = first + c / 3, k = c % 3; if (Lt >= nM * 4) return false; const int pm = pm0 + (Lt >> 2), pn = Lt & 3;
        u.A = Y + (size_t)pm * 256 * 3072 + k * 1024; u.B = WB + ((size_t)(k * 1024 + pn * 256)) * 1024; u.i0 = pm; u.i1 = pn; u.i2 = c; u.i3 = k; return true; } };
struct GateEarlySched { static constexpr bool GATHER = false; const char* H; const char* W; int G, c;
    __device__ __forceinline__ bool next(int i, GUnit& u) const { if (c < 80 || G <= 80) return false; const int g = i * (G - 80) + c - 80; if (g >= 176) return false; const int pn = g < 128 ? 11 - (g >> 6) : 9, pm = 4 + (g < 128 ? (g & 63) : g - 128);
        u.A = H + (size_t)pm * 256 * 2048; u.B = W + (size_t)pn * 256 * 2048; u.i0 = pm; u.i1 = pn; u.i2 = 0; u.i3 = 0; return true; } };
struct GateCtxSched { static constexpr bool GATHER = false; const char* H; const char* W; int G, c;
    __device__ __forceinline__ bool next(int i, GUnit& u) const { const int w0 = G >= 144 ? 96 : 0; const int g = i * (G - w0) + c - w0; if (c < w0 || g >= 48) return false; const int pm = g / 12, pn = g % 12;
        u.A = H + (size_t)pm * 256 * 2048; u.B = W + (size_t)pn * 256 * 2048; u.i0 = pm; u.i1 = pn; u.i2 = 0; u.i3 = 0; return true; } };
struct GateRestSched { static constexpr bool GATHER = false; pg8::DenseSched D; int G, c;
    __device__ __forceinline__ bool next(int i, GUnit& u) const { const int L = i * G + c; if (L >= 592) return false; int pm, pn;
        if (L < 576) D.tile_of(L, pm, pn); else { pm = 52 + (L - 576); pn = 9; }
        u.A = D.A + (size_t)pm * 256 * 2048; u.B = D.B + (size_t)pn * 256 * 2048; u.i0 = pm; u.i1 = pn; u.i2 = 0; u.i3 = 0; return true; } };
struct MoeUpSched { static constexpr bool GATHER = true; const char* H; const char* W; const int* perm; int ntiles, ts[NE + 1], G, c;
    __device__ __forceinline__ bool next(int i, GUnit& u) const { const int L = i * G + c; if (L >= ntiles * 28) return false; const int tile = L / 28, pn = L % 28; int e = 0;
#pragma unroll
        for (int k = 1; k < NE; ++k) e += (tile >= ts[k]) ? 1 : 0;
        u.A = H; u.B = W + ((size_t)(e * 7168 + pn * 256)) * 2048; u.i0 = tile; u.i1 = pn; u.i2 = e; u.i3 = 0; return true; }
    __device__ __forceinline__ const int* rowtab(const GUnit& u) const { int t0 = 0;
#pragma unroll
        for (int k = 1; k < NE; ++k) t0 = (u.i2 == k) ? ts[k] : t0;
        return perm + u.i2 * 16384 + (u.i0 - t0) * 256; } };
struct MoeDownSched { static constexpr bool GATHER = false; const char* HID; const char* W; int ntiles, ts[NE + 1], G, c, lim;
    __device__ __forceinline__ bool next(int i, GUnit& u) const { const int L = i * G + c; if (L >= lim) return false; const int tile = L >> 2, pn = L & 3; int e = 0;
#pragma unroll
        for (int k = 1; k < NE; ++k) e += (tile >= ts[k]) ? 1 : 0;
        u.A = HID + (size_t)tile * 256 * 7168; u.B = W + ((size_t)(e * 1024 + pn * 256)) * 7168; u.i0 = tile; u.i1 = pn; u.i2 = e; u.i3 = 0; return true; } };
struct MoeDownTailSched { static constexpr bool GATHER = false; const char* HID; const char* W; int ntiles, ts[NE + 1], first, c;
    __device__ __forceinline__ bool next(int i, GUnit& u) const { if (i > 0) return false; const int L = first + (c >> 2), ks = c & 3; if (L >= ntiles * 4) return false; const int tile = L >> 2, pn = L & 3; int e = 0;
#pragma unroll
        for (int k = 1; k < NE; ++k) e += (tile >= ts[k]) ? 1 : 0;
        u.A = HID + (size_t)tile * 256 * 7168 + ks * 1792; u.B = W + ((size_t)(e * 1024 + pn * 256)) * 7168 + ks * 1792; u.i0 = tile; u.i1 = pn; u.i2 = c; u.i3 = ks; return true; } };
}

constexpr size_t WS_SLB_G = WS_BIG + 128 * MiB;
constexpr size_t WS_SLB_F = WS_BIG + 104 * MiB;
constexpr size_t WS_GSP = WS_BIG + 343 * MiB;
static_assert(WS_GSP + 22 * MiB <= WS_END, "ws");
constexpr size_t WS_SLB_M = WS_H;
__device__ __forceinline__ void combine_resid(Frame& F, const pg8::DenseSched& S, int first, int R, int SPL, const float* slab, const float* modacc, const float* adab) {
    float* XW = (float*)(F.ws + WS_XW);
    for (int t = F.c * NTHREADS + F.tid; t < R * 16384; t += F.G * NTHREADS) { const int r = t >> 14, e = t & 16383, row = e >> 6, c4 = (e & 63) * 4; int pm, pn; S.tile_of(first + r, pm, pn);
        f32x4 sum = (f32x4){0.f, 0.f, 0.f, 0.f};
        for (int ks = 0; ks < SPL; ++ks) sum += *(const f32x4*)(slab + (size_t)(r * SPL + ks) * 65536 + row * 256 + c4);
        const int bidx = pm < 4 ? 4 : ((pm - 4) >> 4), gcol = pn * 256 + c4; const f32x4 g = *(const f32x4*)(modacc + bidx * 6144 + gcol) + *(const f32x4*)(adab + gcol);
        f32x4* xp = (f32x4*)(XW + (size_t)(pm * 256 + row) * 1024 + gcol); *xp = *xp + g * sum; }
}
__device__ __forceinline__ void combine_merge(Frame& F, int nM, int pm0, int first, const float* slab) {
    const bf16_t* GT = (const bf16_t*)(F.ws + WS_P); bf16_t* MG = (bf16_t*)(F.ws + WS_H); const int R = nM * 4 - first;
    for (int t = F.c * NTHREADS + F.tid; t < R * 8192; t += F.G * NTHREADS) { const int r = t >> 13, e = t & 8191, row = e >> 5, c8 = (e & 31) * 8; const int Lt = first + r, pm = pm0 + (Lt >> 2), pn = Lt & 3;
        const size_t grow = (size_t)(pm * 256 + row); const int gcol = pn * 256 + c8; float v[8];
#pragma unroll
        for (int j = 0; j < 8; ++j) v[j] = 0.f;
#pragma unroll
        for (int k = 0; k < 3; ++k) { float gt[8]; epi::unpack8(*(const u32x4*)(GT + (size_t)(pm * 12 + k * 4 + pn) * 65536 + row * 256 + c8), gt); const float* sp = slab + (size_t)(r * 3 + k) * 65536 + row * 256 + c8;
            const f32x4 a = *(const f32x4*)sp, b = *(const f32x4*)(sp + 4);
#pragma unroll
            for (int j = 0; j < 4; ++j) { v[j] += gt[j] * a[j]; v[4 + j] += gt[4 + j] * b[j]; } }
        *(u32x4*)(MG + grow * 1024 + gcol) = epi::pack8(v); }
}
__device__ __forceinline__ void combine_moe(Frame& F, int first, int R, const float* slab) {
    bf16_t* SL = (bf16_t*)(F.ws + WS_SLAB);
    for (int t = F.c * NTHREADS + F.tid; t < R * 8192; t += F.G * NTHREADS) { const int r = t >> 13, e = t & 8191, row = e >> 5, c8 = (e & 31) * 8; const int L = first + r, tile = L >> 2, pn = L & 3; float v[8];
#pragma unroll
        for (int j = 0; j < 8; ++j) v[j] = 0.f;
#pragma unroll
        for (int ks = 0; ks < 4; ++ks) { const float* sp = slab + (size_t)(r * 4 + ks) * 65536 + row * 256 + c8; const f32x4 a = *(const f32x4*)sp, b = *(const f32x4*)(sp + 4);
#pragma unroll
            for (int j = 0; j < 4; ++j) { v[j] += a[j]; v[4 + j] += b[j]; } }
        *(u32x4*)(SL + (size_t)(tile * 256 + row) * 1024 + pn * 256 + c8) = epi::pack8(v); }
}

__device__ __forceinline__ int wq_pull(Frame& F, unsigned* head) {
    volatile LAS unsigned* slot = (volatile LAS unsigned*)(F.lds + LDS_MISC + 64);
    __syncthreads();
    if (F.tid == 0) slot[0] = __hip_atomic_fetch_add(head, 1u, __ATOMIC_RELAXED, __HIP_MEMORY_SCOPE_AGENT);
    __syncthreads();
    return (int)slot[0];
}
__device__ __forceinline__ bool launder(Frame& F) { unsigned char* w = F.ws; ArgsP a = F.ap; asm volatile("" : "+s"(w), "+s"(a)); F.ws = w; F.ap = a; F.ctl = (unsigned*)(w + WS_CTL); return true; }
constexpr int NPHASE = 26;
#define IN(k) (lo <= (k) && (k) < hi && launder(F))
#define SEAM(k) do { if ((k) + 1 < hi) xcd_barrier(bar); } while (0)
template <int l>
__device__ __forceinline__ void layer_phases(Frame& F, const XcdBarrier& bar, const int lo, const int hi) {
    const int G = F.G, c = F.c; LAS unsigned char* lds = F.lds;
    constexpr int pb = 1 + 12 * l;

        const int pm0 = l == 0 ? 0 : 4, nM = l == 0 ? 68 : 64;
        const float* modacc = (const float*)(F.ctl + CW_MOD) + (size_t)l * 5 * 6144; const float* adab = F.ap->in[I_ADAB] + (size_t)l * 6144;
        if (IN(pb + 0)) { if (l == 0) norm_rows<0>(F, 0, 0, F.ap->in[I_N1G]); else norm_rows<1>(F, 1, 0, F.ap->in[I_N1G] + D); SEAM(pb + 0); }
        if (IN(pb + 1)) {
            pg8::DenseSched S; S.init(F.ws + WS_H, F.ws + WS_WMIX + (size_t)l * NMIX * D * 2, 2048, 2048, 68, 20, 0, G, c);
            const float* lbp = (const float*)(F.ctl + CW_LB);
            epi::EpiWin E{(bf16_t*)(F.ws + WS_P), (bf16_t*)(F.ws + WS_UG), lbp + 512 * l, lbp + 1024 + 512 * l, F.ap->in[I_GB] + l * 512};
            pg8::gemm_phase(lds, S, E, 2048, 2048, 16);
            if (l == 0) { bg_drain<1>(F); bg_s5fill<0>(F); }
            else { pg8::GateEarlySched T{(const char*)(F.ws + WS_H), (const char*)(F.ws + WS_WGATE + (size_t)NGATE * D * 2), G, c}; epi::EpiGate EG{{(bf16_t*)(F.ws + WS_P), (bf16_t*)(F.ws + WS_GSP), 1}};
                pg8::gemm_phase(lds, T, EG, 2048, 2048, 16); }
            SEAM(pb + 1); }
        if (IN(pb + 2)) {
            { pg8::S5LocSched S{(const char*)(F.ws + WS_UG), (const char*)(F.ws + WS_S5V), G, c}; epi::EpiS5Loc E{(float*)(F.ws + WS_SLOC)}; pg8::gemm_phase(lds, S, E, S5K * 2, 1024, 8); }
            if (l == 0) { pg8::GateCtxSched T{(const char*)(F.ws + WS_H), (const char*)(F.ws + WS_WGATE), G, c}; epi::EpiGate EG{{(bf16_t*)(F.ws + WS_P), (bf16_t*)(F.ws + WS_GSP), 0}}; pg8::gemm_phase(lds, T, EG, 2048, 2048, 16); }
            __syncthreads();
            for (;;) { const int it = wq_pull(F, F.ctl + CW_WQ + 64 * (2 * l)); if (it >= 1024) break;
                const int br = it >> 9, r = it & 511, p = r & 15, dir = (r >> 4) & 1, h = (r >> 5) & 3, b = r >> 7;
                if (br == 0) gla_pass1_item<128, true>(F, b, h, dir, p); else gla_pass1_item<64, false>(F, b, h, dir, p); }
            SEAM(pb + 2); }
        if (IN(pb + 3)) { gla_carry(F); s5_carry(F, l); SEAM(pb + 3); }
        if (IN(pb + 4)) {
            { pg8::S5OutSched S{(const char*)(F.ws + WS_UG), (const char*)(F.ws + WS_S5C), G, (c + G - 64) % G}; epi::EpiS5Out E{(bf16_t*)(F.ws + WS_YPRE)}; pg8::gemm_phase(lds, S, E, S5K * 2, S5K * 2, 12); }
            __syncthreads();
            const int nsc = l == 0 ? 17 : 16, nit = 16 * nsc;
            for (;;) { const int q = wq_pull(F, F.ctl + CW_WQ + 64 * (2 * l + 1)); if (q >= 2 * nit) break;
                const int br = q >= nit, it = br ? q - nit : q, sc = (it % nsc) + (l == 0 ? 0 : 1), h = (it / nsc) & 3, b = it / (nsc * 4);
                if (br == 0) gla_pass3_item<128, true>(F, l, b, h, sc); else gla_pass3_item<64, false>(F, l, b, h, sc); }
            SEAM(pb + 4); }
        if (IN(pb + 5)) {
            if (l == 0) { pg8::DenseSched S; S.init(F.ws + WS_H, F.ws + WS_WGATE, 2048, 2048, 64, 12, 4, G, c); epi::EpiGate E{{(bf16_t*)(F.ws + WS_P), (bf16_t*)(F.ws + WS_GSP), 0}}; pg8::gemm_phase(lds, S, E, 2048, 2048, 16); }
            else { pg8::GateRestSched S; S.D.init(F.ws + WS_H, F.ws + WS_WGATE + (size_t)NGATE * D * 2, 2048, 2048, 64, 9, 4, G, c); S.G = G; S.c = c; epi::EpiGate E{{(bf16_t*)(F.ws + WS_P), (bf16_t*)(F.ws + WS_GSP), 1}}; pg8::gemm_phase(lds, S, E, 2048, 2048, 16); }
            { pg8::DenseSched S; S.init(F.ws + WS_YPRE, F.ws + WS_WGLU + (size_t)l * 512 * 512 * 2, 1024, 1024, nM, 2, pm0, G, (c + G - (l == 0 ? 768 : 592) % G) % G); epi::EpiGlu E{(const bf16_t*)(F.ws + WS_YPRE), (bf16_t*)(F.ws + WS_Y)}; pg8::gemm_phase(lds, S, E, 1024, 1024, 8); }
            if (l == 0) bg_drain<2>(F);
            SEAM(pb + 5); }
        if (IN(pb + 6)) {
            const int nT = nM * 4, fullT = (nT / G) * G; const bool split = (hi - lo > 1) && nT > fullT && (nT - fullT) * 3 <= G;
            pg8::MergeSched S{(const char*)(F.ws + WS_Y), (const char*)(F.ws + WS_WBR + (size_t)l * 3 * D * 512 * 2), nM, pm0, G, c, split ? fullT : nT}; epi::EpiMerge E{{(bf16_t*)(F.ws + WS_P), (bf16_t*)(F.ws + WS_GSP), l}, (bf16_t*)(F.ws + WS_H)};
#ifdef PROBE_MERGE
            E.pmode = (hi - lo == 1) ? PROBE_MERGE : 0;
#endif
            pg8::gemm_phase(lds, S, E, 3072, 1024, 8);
            if (split) { pg8::MergeTailSched T{(const char*)(F.ws + WS_Y), (const char*)(F.ws + WS_WBR + (size_t)l * 3 * D * 512 * 2), nM, pm0, fullT, c}; epi::EpiSlab ES{(float*)(F.ws + WS_SLB_F)};
                pg8::gemm_phase(lds, T, ES, 3072, 1024, 8); xcd_barrier(bar); combine_merge(F, nM, pm0, fullT, (const float*)(F.ws + WS_SLB_F)); }
            SEAM(pb + 6); }
        if (IN(pb + 7)) {
            pg8::DenseSched S; S.init(F.ws + WS_H, F.ws + WS_WOUT + (size_t)l * D * D * 2, 2048, 2048, nM, 4, pm0, G, c); epi::EpiResid E{(float*)(F.ws + WS_XW), modacc + 2048, adab + 2048};
            const int full = (S.nwg / G) * G; const bool split = (hi - lo > 1) && S.nwg > full && (S.nwg - full) * 4 <= G;
            if (split) S.lim = full;
            pg8::gemm_phase(lds, S, E, 2048, 2048, 16);
            if (split) { pg8::SplitSched T{S, full, 4, 512, c}; epi::EpiSlab ES{(float*)(F.ws + WS_SLB_G)}; pg8::gemm_phase(lds, T, ES, 2048, 2048, 4); xcd_barrier(bar);
                combine_resid(F, S, full, S.nwg - full, 4, (const float*)(F.ws + WS_SLB_G), modacc + 2048, adab + 2048); }
            SEAM(pb + 7); }
        if (IN(pb + 8)) { if (l == 0) norm_rows<1>(F, 0, 3072, F.ap->in[I_N2G]); else { norm_rows<2>(F, 1, 3072, F.ap->in[I_N2G] + D);
#ifdef PROBE_MC
            moe_convert(F, (hi - lo == 1) ? PROBE_MC : 0);
#else
            moe_convert(F);
#endif
            } SEAM(pb + 8); }
        if (IN(pb + 10)) {
            if (l == 0) { pg8::DenseSched S; S.init(F.ws + WS_H, F.ws + WS_W13, 2048, 2048, 68, 28, 0, G, c); epi::EpiSwiglu E{(bf16_t*)(F.ws + WS_HID)}; pg8::gemm_phase(lds, S, E, 2048, 2048, 16); bg_s5fill<1>(F); }
            else { MoeSeg sg; moe_seg(F, sg); pg8::MoeUpSched S; S.H = (const char*)(F.ws + WS_H) + (size_t)MCTX * 2048; S.W = (const char*)(F.ws + WS_MW13); S.perm = (const int*)(F.ctl + CW_PERM2); S.ntiles = sg.tstart[NE]; S.G = G; S.c = c;
#pragma unroll
                for (int e = 0; e <= NE; ++e) S.ts[e] = sg.tstart[e];
                epi::EpiSwiglu E{(bf16_t*)(F.ws + WS_MHID)}; pg8::gemm_phase(lds, S, E, 2048, 2048, 16);
                bg_drain<3>(F); }
            SEAM(pb + 10); }
        if (IN(pb + 11)) {
            if (l == 0) { pg8::DenseSched S; S.init(F.ws + WS_HID, F.ws + WS_W2, 7168, 7168, 68, 4, 0, G, c); epi::EpiResid E{(float*)(F.ws + WS_XW), modacc + 5120, adab + 5120};
                const int full = (S.nwg / G) * G; const bool split = (hi - lo > 1) && S.nwg > full && (S.nwg - full) * 14 <= G;
                if (split) S.lim = full;
                pg8::gemm_phase(lds, S, E, 7168, 7168, 56);
                if (split) { pg8::SplitSched T{S, full, 14, 512, c}; epi::EpiSlab ES{(float*)(F.ws + WS_SLB_G)}; pg8::gemm_phase(lds, T, ES, 7168, 7168, 4); xcd_barrier(bar);
                    combine_resid(F, S, full, S.nwg - full, 14, (const float*)(F.ws + WS_SLB_G), modacc + 5120, adab + 5120); } }
            else { MoeSeg sg; moe_seg(F, sg); pg8::MoeDownSched S; S.HID = (const char*)(F.ws + WS_MHID); S.W = (const char*)(F.ws + WS_MW2); S.ntiles = sg.tstart[NE]; S.G = G; S.c = c;
#pragma unroll
                for (int e = 0; e <= NE; ++e) S.ts[e] = sg.tstart[e];
                const int nU = sg.tstart[NE] * 4, full = (nU / G) * G; const bool split = (hi - lo > 1) && nU > full && (nU - full) * 4 <= G;
                S.lim = split ? full : nU;
                epi::EpiStoreBf16 E{(bf16_t*)(F.ws + WS_SLAB), 1024}; pg8::gemm_phase(lds, S, E, 7168, 7168, 56);
                if (split) { pg8::MoeDownTailSched T; T.HID = S.HID; T.W = S.W; T.ntiles = S.ntiles; T.first = full; T.c = c;
#pragma unroll
                    for (int e = 0; e <= NE; ++e) T.ts[e] = sg.tstart[e];
                    epi::EpiSlab ES{(float*)(F.ws + WS_SLB_M)}; pg8::gemm_phase(lds, T, ES, 7168, 7168, 14); xcd_barrier(bar); combine_moe(F, full, nU - full, (const float*)(F.ws + WS_SLB_M)); } }
            SEAM(pb + 11); }
    }

__global__ void __launch_bounds__(NTHREADS, 2) fwd_kernel(Args args) {
    extern __shared__ __attribute__((aligned(16))) unsigned char lds_raw[];
    Frame F;
    F.lds = (LAS unsigned char*)lds_raw; F.ws = args.ws; F.ctl = (unsigned*)(args.ws + WS_CTL);
    F.tid = threadIdx.x; F.lane = F.tid & 63; F.wave = __builtin_amdgcn_readfirstlane(F.tid >> 6); F.G = gridDim.x; F.c = blockIdx.x;
    F.ap = (ArgsP)__builtin_amdgcn_kernarg_segment_ptr();
    volatile LAS unsigned* MISC = (volatile LAS unsigned*)(F.lds + LDS_MISC);
    for (int u = F.tid; u < (LDS_BYTES - LDS_MISC) / 4; u += NTHREADS) MISC[u] = 0u;
    __syncthreads();
    XcdBarrier bar; bar.bar = F.ctl + CW_BAR; bar.x = 0; bar.st = nullptr;
    const int lo = args.ph_lo, hi = args.ph_hi;
    if (hi - lo > 1) bar = xcd_barrier_post(F.ctl + CW_BAR, MISC + 8);

    if (IN(0)) { phase_pre(F); SEAM(0); }

    layer_phases<0>(F, bar, lo, hi);
    layer_phases<1>(F, bar, lo, hi);
    if (IN(25)) phase_final(F);
#ifdef PROBE_GEMM
    if (IN(40)) { pg8::DenseSched S; S.init(F.ws + PROBE_A, F.ws + PROBE_B, PROBE_LD, PROBE_LD, 68, 28, 0, F.G, F.c); S.lim = PROBE_LIM; PROBE_EPI; pg8::gemm_phase(F.lds, S, E, PROBE_LD, PROBE_LD, PROBE_NT); }
#endif
#ifdef PROBE_VARIANTS
#define PV_ITEMS(V) do { for (int it = F.c; it < 272; it += F.G) { const int sc = it % 17, h = (it / 17) & 3, b = it / 68; gla_pass3_item<128, true, V>(F, 0, b, h, sc); } \
        if (F.c >= 16) for (int it = F.c - 16; it < 272; it += 240) { const int sc = it % 17, h = (it / 17) & 3, b = it / 68; gla_pass3_item<64, false, V>(F, 0, b, h, sc); } } while (0)
    if (IN(30)) PV_ITEMS(0);
    if (IN(31)) PV_ITEMS(1);
    if (IN(32)) PV_ITEMS(2);
    if (IN(33)) PV_ITEMS(3);
    if (IN(34)) PV_ITEMS(4);
    if (IN(35)) PV_ITEMS(5);
#endif

#undef IN
#undef SEAM
}

extern "C" void kernel_launch(void* const* d_in, const int* in_sizes, int n_in, void* d_out, int out_size, void* d_ws, size_t ws_size, hipStream_t stream) {
    static int grid = 0;
    if (grid == 0) {
        if (n_in != 33 || ws_size < WS_END) { fprintf(stderr, "kernel_launch: need 33 inputs and %zu bytes of workspace (got %d, %zu)\n", (size_t)WS_END, n_in, ws_size); grid = -1; return; }
        int dev = 0, cus = 0, per_cu = 0;
        if (hipGetDevice(&dev) != hipSuccess || hipDeviceGetAttribute(&cus, hipDeviceAttributeMultiprocessorCount, dev) != hipSuccess) { grid = -1; return; }
        if (hipFuncSetAttribute((const void*)fwd_kernel, hipFuncAttributeMaxDynamicSharedMemorySize, LDS_BYTES) != hipSuccess) { fprintf(stderr, "kernel_launch: hipFuncSetAttribute failed\n"); grid = -1; return; }
        if (hipOccupancyMaxActiveBlocksPerMultiprocessor(&per_cu, (const void*)fwd_kernel, NTHREADS, LDS_BYTES) != hipSuccess || per_cu < 1) fprintf(stderr, "kernel_launch: occupancy query says %d\n", per_cu);
        (void)hipGetLastError();
        grid = cus;
    }
    if (grid < 0) return;
    (void)hipMemsetAsync((char*)d_ws + WS_CTL, 0, CTL_BYTES, stream);
    Args a{};
    for (int i = 0; i < 33; ++i) a.in[i] = (const float*)d_in[i];
    a.out = (float*)d_out; a.ws = (unsigned char*)d_ws;
#if MK_N_LAUNCHES == 1
    a.ph_lo = 0; a.ph_hi = NPHASE;
    hipLaunchKernelGGL(fwd_kernel, dim3(grid), dim3(NTHREADS), LDS_BYTES, stream, a);
#ifdef PROBE_PHASES
    { const int pl[] = {PROBE_PHASES}; for (int k : pl) { a.ph_lo = k; a.ph_hi = k + 1; hipLaunchKernelGGL(fwd_kernel, dim3(grid), dim3(NTHREADS), LDS_BYTES, stream, a); } }
#endif
#else
    for (int k = 0; k < NPHASE; ++k) { if (k == 10) continue; a.ph_lo = k; a.ph_hi = k + 1; hipLaunchKernelGGL(fwd_kernel, dim3(grid), dim3(NTHREADS), LDS_BYTES, stream, a); }
#endif
}
```

```cpp
#include <hip/hip_runtime.h>
#include <cstdio>
#include <cstdint>

#ifndef MK_N_LAUNCHES
#define MK_N_LAUNCHES 1
#endif

#define GAS __attribute__((address_space(1)))
#define LAS __attribute__((address_space(3)))
typedef unsigned short bf16_t;
typedef short bf16x8 __attribute__((ext_vector_type(8)));
typedef short bf16x4 __attribute__((ext_vector_type(4)));
typedef float f32x4 __attribute__((ext_vector_type(4)));
typedef float f32x2 __attribute__((ext_vector_type(2)));
typedef unsigned u32x4 __attribute__((ext_vector_type(4)));
typedef unsigned u32x2 __attribute__((ext_vector_type(2)));

constexpr int D = 1024, NB = 4, SEQ = 4096, CTX = 256, FFN = 3584, NE = 8;
constexpr int MCTX = NB * CTX;
constexpr int MLAT = NB * SEQ;
constexpr int M = MCTX + MLAT;
constexpr int NMIX = 5120, NGATE = 3072, LDP = 4608;
constexpr int N_IN = 7712;
constexpr int NSC = 17;
constexpr int S5L = 32, S5CH = M / S5L;
constexpr int S5ROWS = 768;
constexpr int S5K = 768;
constexpr float EPS = 1e-6f;
constexpr int MOE_ROWS = 2 * MLAT + NE * 256;
constexpr int MOE_TILES = MOE_ROWS / 256;

constexpr size_t MiB = (size_t)1 << 20;
constexpr size_t WS_CTL = 0, CTL_BYTES = 2 * MiB;
constexpr size_t WS_XW = 2 * MiB;
constexpr size_t WS_H = 70 * MiB;
constexpr size_t WS_WSM = 104 * MiB;
constexpr size_t WS_WMIX = WS_WSM;
constexpr size_t WS_WGATE = WS_WMIX + 20 * MiB;
constexpr size_t WS_WBR = WS_WGATE + 12 * MiB;
constexpr size_t WS_WOUT = WS_WBR + 6 * MiB;
constexpr size_t WS_WGLU = WS_WOUT + 4 * MiB;
constexpr size_t WS_W13 = WS_WGLU + 1 * MiB;
constexpr size_t WS_W2 = WS_W13 + 14 * MiB;
constexpr size_t WS_MW2 = WS_WSM;
constexpr size_t WS_S5C = 168 * MiB;
constexpr size_t WS_S5V = WS_S5C + 24 * MiB;
constexpr size_t WS_BIG = 200 * MiB;
constexpr size_t WS_P = WS_BIG;
constexpr size_t WS_Y = WS_BIG + 153 * MiB;
constexpr size_t WS_YPRE = WS_BIG + 204 * MiB;
constexpr size_t WS_UG = WS_BIG + 221 * MiB;
constexpr size_t WS_SLOC = WS_BIG + 257 * MiB;
constexpr size_t WS_GST = WS_BIG + 281 * MiB;
constexpr size_t WS_GST2 = WS_GST + 34 * MiB;
constexpr size_t WS_GDEC = WS_BIG + 332 * MiB;
constexpr size_t WS_HID = WS_BIG;
constexpr size_t WS_MW13 = WS_BIG;
constexpr size_t WS_MHID = WS_BIG + 112 * MiB;
constexpr size_t WS_SLAB = WS_BIG;
constexpr size_t WS_END = 578 * MiB;
static_assert(WS_MHID + (size_t)MOE_ROWS * FFN * 2 <= WS_END, "ws map");
static_assert(WS_GDEC + 1 * MiB <= WS_END, "ws map");

constexpr int CW_BAR = 0;
constexpr int CW_MOECNT = 4096;
constexpr int CW_WQ = 5120;
constexpr int CW_MOD = 8192;
constexpr int CW_LB = CW_MOD + 61440;
constexpr int CW_TOKE = CW_LB + 2048;
constexpr int CW_TOKR = CW_TOKE + 32768;
constexpr int CW_TOKW = CW_TOKR + 32768;
constexpr int CW_PERM = CW_TOKW + 32768;
constexpr int CW_END = CW_PERM + MOE_ROWS;
constexpr int CW_POS = 262144;
constexpr int CW_PERM2 = 327680;
static_assert(CW_END <= CW_POS && (size_t)(CW_POS + 64 * 512) * 4 <= CTL_BYTES, "ctl pos");
static_assert(CW_POS + 64 * 512 <= CW_PERM2 && (size_t)(CW_PERM2 + 8 * 16384) * 4 <= CTL_BYTES, "ctl perm2");
static_assert((size_t)CW_END * 4 <= CTL_BYTES, "ctl");

constexpr int NTHREADS = 512;
constexpr int LDS_BYTES = 161792;
constexpr int LDS_MISC = 160768;

__device__ __forceinline__ float bf2f(bf16_t v) { return __uint_as_float(((unsigned)v) << 16); }
__device__ __forceinline__ unsigned f2bf(float f) { unsigned u = __float_as_uint(f); return (u + 0x7fffu + ((u >> 16) & 1u)) >> 16; }
typedef __bf16 bf16v2_t __attribute__((ext_vector_type(2)));
__device__ __forceinline__ unsigned pk2(float lo, float hi) { const f32x2 v = {lo, hi}; return __builtin_bit_cast(unsigned, __builtin_convertvector(v, bf16v2_t)); }
template <bool NT = false> __device__ __forceinline__ f32x4 xw_ld4(const bf16_t* p) { const u32x2 w = NT ? __builtin_nontemporal_load((const u32x2*)p) : *(const u32x2*)p; f32x4 r; r[0] = __uint_as_float(w.x << 16); r[1] = __uint_as_float(w.x & 0xffff0000u); r[2] = __uint_as_float(w.y << 16); r[3] = __uint_as_float(w.y & 0xffff0000u); return r; }
__device__ __forceinline__ void xw_st4(bf16_t* p, const f32x4 v) { u32x2 w; w.x = pk2(v[0], v[1]); w.y = pk2(v[2], v[3]); *(u32x2*)p = w; }
__device__ __forceinline__ float fsigmoid(float x) { return __builtin_amdgcn_rcpf(1.0f + __expf(-x)); }
__device__ __forceinline__ float fsilu(float x) { return x * __builtin_amdgcn_rcpf(1.0f + __expf(-x)); }
__device__ __forceinline__ float flogsig(float x) { return fminf(x, 0.f) - __logf(1.0f + __expf(-fabsf(x))); }
__device__ __forceinline__ float wave_sum(float v) {
#pragma unroll
    for (int o = 1; o < 64; o <<= 1) v += __shfl_xor(v, o);
    return v;
}
#define LDS_WAIT() asm volatile("s_waitcnt lgkmcnt(0)" ::: "memory")
#define VM_WAIT() asm volatile("s_waitcnt vmcnt(0)" ::: "memory")

#define XB_TMO      128
#define XB_XCNT(j)  (256  + 64 * (j))
#define XB_XSUB(j)  (1280 + 64 * (j))
#define XB_XGEN(j)  (2304 + 64 * (j))
#define XB_TOP      3328
#define XB_TOPGEN   3392
#define XCD_BAR_WORDS 3456
#define XB_SPIN_CAP (1u << 22)
__device__ __forceinline__ unsigned xb_ld(unsigned* p)              { return __hip_atomic_load(p, __ATOMIC_RELAXED, __HIP_MEMORY_SCOPE_AGENT); }
__device__ __forceinline__ unsigned xb_add(unsigned* p, unsigned v) { return __hip_atomic_fetch_add(p, v, __ATOMIC_RELAXED, __HIP_MEMORY_SCOPE_AGENT); }
__device__ __forceinline__ unsigned xb_xcc_id() { return (unsigned)__builtin_amdgcn_s_getreg((3 << 11) | 20) & 0xFu; }
#define XB_SPIN(cond, bar) do { unsigned _sp = 0; while (cond) { __builtin_amdgcn_s_sleep(1); \
    if ((++_sp & 255u) == 0u) { if (xb_ld(&(bar)[XB_TMO])) break; if (_sp > XB_SPIN_CAP) { atomicAdd(&(bar)[XB_TMO], 1u); break; } } } } while (0)
struct XcdBarrier { unsigned* bar; unsigned x; volatile LAS unsigned* st; };
__device__ __forceinline__ XcdBarrier xcd_barrier_post(unsigned* bar, volatile LAS unsigned* st) {
    XcdBarrier b; b.bar = bar; b.x = xb_xcc_id(); b.st = st;
    if (threadIdx.x == 0) (void)xb_add(&bar[XB_XCNT(b.x)], 1u);
    return b;
}
__device__ __forceinline__ void xcd_barrier_complete(unsigned* bar, unsigned x, unsigned& nloc, unsigned& nx) {
    const unsigned G = gridDim.x * gridDim.y * gridDim.z;
    unsigned sum, cnt, mine, sp = 0u;
    for (;;) {
        sum = 0u; cnt = 0u; mine = 0u;
#pragma unroll
        for (unsigned j = 0; j < 16; ++j) { const unsigned c = xb_ld(&bar[XB_XCNT(j)]); sum += c; cnt += (c > 0u) ? 1u : 0u; mine = (j == x) ? c : mine; }
        if (sum == G) break;
        __builtin_amdgcn_s_sleep(1);
        if ((++sp & 255u) == 0u) { if (xb_ld(&bar[XB_TMO])) break; if (sp > XB_SPIN_CAP) { atomicAdd(&bar[XB_TMO], 1u); break; } }
    }
    nloc = mine > 0u ? mine : 1u; nx = cnt > 0u ? cnt : 1u;
}
__device__ __forceinline__ void xcd_barrier(const XcdBarrier& b) {
    asm volatile("s_waitcnt vmcnt(0)" ::: "memory");
    __syncthreads();
    if (threadIdx.x == 0) {
        unsigned* bar = b.bar;
        __builtin_amdgcn_s_waitcnt(0);
        unsigned nloc = b.st[0], nx = b.st[1];
        if (nloc == 0u) { xcd_barrier_complete(bar, b.x, nloc, nx); b.st[0] = nloc; b.st[1] = nx; }
        const unsigned old = xb_add(&bar[XB_XSUB(b.x)], 1u);
        const unsigned gen = old / nloc;
        if (old + 1u == (gen + 1u) * nloc) {
            __builtin_amdgcn_fence(__ATOMIC_RELEASE, "agent");
            asm volatile("s_waitcnt vmcnt(0)" ::: "memory");
            const unsigned og = xb_add(&bar[XB_TOP], 1u);
            const unsigned tg = og / nx;
            if (og + 1u == (tg + 1u) * nx) xb_add(&bar[XB_TOPGEN], 1u);
            else XB_SPIN(xb_ld(&bar[XB_TOPGEN]) == tg, bar);
            xb_add(&bar[XB_XGEN(b.x)], 1u);
            __builtin_amdgcn_fence(__ATOMIC_ACQUIRE, "agent");
            asm volatile("s_waitcnt vmcnt(0)" ::: "memory");
        } else {
            XB_SPIN(xb_ld(&bar[XB_XGEN(b.x)]) == gen, bar);
            __builtin_amdgcn_fence(__ATOMIC_ACQUIRE, "agent");
            asm volatile("s_waitcnt vmcnt(0)" ::: "memory");
        }
    }
    __syncthreads();
}
namespace pg8 {
constexpr int BM = 256, BK = 64, HALF = 128, HTB = HALF * BK * 2, STAGE_BYTES = 8 * HTB;
__host__ __device__ __forceinline__ int lds_byte(int r, int c) { const int st = (r >> 4) * 2 + (c >> 5), rr = r & 15, cc = c & 31, ob = rr * 64 + cc * 2; return st * 1024 + (ob ^ (((ob >> 9) & 1) << 5)); }
__host__ __device__ __forceinline__ void stage_rc(int b, int& R, int& C) { const int st = b / 1024, sb = b % 1024, swz = sb ^ (((sb >> 9) & 1) << 5); R = (st >> 1) * 16 + swz / 64; C = (st & 1) * 32 + (swz % 64) / 2; }
__host__ __device__ __forceinline__ int perm32(int rho) { const int n = rho >> 4, i = rho & 15; return 8 * (i >> 2) + 4 * n + (i & 3); }

struct GUnit { const char* A; const char* B; int i0, i1, i2, i3; };

template <class Sched, class Epi>
__device__ __forceinline__ void gemm_phase(LAS unsigned char* lds, const Sched& S, const Epi& E, const int lda, const int ldb, const int nt) {
    int tid_ = threadIdx.x; asm volatile("" : "+v"(tid_));
    const int tid = tid_, wid = __builtin_amdgcn_readfirstlane(tid >> 6), lane = tid & 63, wr = wid >> 2, wc = wid & 3, fr = lane & 15, fq = lane >> 4;
    constexpr bool GATHER = Sched::GATHER;
    unsigned voffA[2], voffB[2]; int RA[2], CA[2];
#pragma unroll
    for (int i = 0; i < 2; ++i) { int R, C; stage_rc(tid * 16 + i * 8192, R, C); const int Rb = Epi::PERM ? ((R & ~31) + perm32(R & 31)) : R;
        RA[i] = R; CA[i] = C; voffA[i] = (unsigned)(R * lda + C * 2); voffB[i] = (unsigned)(Rb * ldb + C * 2); }
    unsigned gAc[2], gAn[2];
    const size_t kstep = (size_t)(BK * 2);
    const size_t hstepA = GATHER ? 0 : (size_t)HALF * lda, hstepB = (size_t)HALF * ldb;
    const unsigned ldsw = (unsigned)wid * 1024u;
    const int aoff = lds_byte(wr * 64 + fr, fq * 8), boff = lds_byte(wc * 32 + fr, fq * 8);
#define PG8_SA(b, h) (((b) * 2 + (h)) * HTB)
#define PG8_SB(b, h) ((4 + (b) * 2 + (h)) * HTB)
#define PG8_STAGE(bufoff, gbase, voff) do { _Pragma("unroll") for (int _i = 0; _i < 2; ++_i) \
        __builtin_amdgcn_global_load_lds((const unsigned*)((const char*)(gbase) + (voff)[_i]), (LAS unsigned*)(lds + (bufoff) + ldsw + _i * 8192), 16, 0, 0); } while (0)
#define PG8_STAGE_A(bufoff, gbase, h, nx) do { if constexpr (GATHER) { const unsigned _pk = (nx) ? gAn[h] : gAc[h]; unsigned _vo[2]; _vo[0] = (_pk & 0xffffu) * (unsigned)lda + (unsigned)(CA[0] * 2); _vo[1] = (_pk >> 16) * (unsigned)lda + (unsigned)(CA[1] * 2); \
        PG8_STAGE(bufoff, gbase, _vo); } else PG8_STAGE(bufoff, (gbase) + (h) * hstepA, voffA); } while (0)
#define PG8_LDA(dst, b, h) do { _Pragma("unroll") for (int m = 0; m < 4; ++m) _Pragma("unroll") for (int k = 0; k < 2; ++k) dst[m][k] = *(const LAS bf16x8*)(lds + PG8_SA(b, h) + aoff + m * 2048 + k * 1024); } while (0)
#define PG8_LDB(dst, b, h) do { _Pragma("unroll") for (int n = 0; n < 2; ++n) _Pragma("unroll") for (int k = 0; k < 2; ++k) dst[n][k] = *(const LAS bf16x8*)(lds + PG8_SB(b, h) + boff + n * 2048 + k * 1024); } while (0)
#define PG8_MMA(ai, bj, At, Bt) do { __builtin_amdgcn_s_setprio(1); _Pragma("unroll") for (int m = 0; m < 4; ++m) _Pragma("unroll") for (int n = 0; n < 2; ++n) _Pragma("unroll") for (int k = 0; k < 2; ++k) \
        acc[ai][bj][m][n] = __builtin_amdgcn_mfma_f32_16x16x32_bf16(Bt[n][k], At[m][k], acc[ai][bj][m][n], 0, 0, 0); __builtin_amdgcn_s_setprio(0); } while (0)
#define PG8_WAIT_V(n) asm volatile("s_waitcnt vmcnt(" #n ")" ::: "memory")
#define PG8_WAIT_L(n) asm volatile("s_waitcnt lgkmcnt(" #n ")" ::: "memory")
#define PG8_BAR __builtin_amdgcn_s_barrier()
#define PG8_SCHED __builtin_amdgcn_sched_barrier(0)
#define PG8_GVOFF(dst, u) do { if constexpr (GATHER) { const int* _rt = S.rowtab(u); _Pragma("unroll") for (int _h = 0; _h < 2; ++_h) \
        dst[_h] = (unsigned)_rt[_h * HALF + RA[0]] | ((unsigned)_rt[_h * HALF + RA[1]] << 16); } } while (0)
    GUnit cur, nxt; int ui = 0;
    if (!S.next(0, cur)) return;
    f32x4 acc[2][2][4][2];
#pragma unroll
    for (int a = 0; a < 2; ++a)
#pragma unroll
        for (int b = 0; b < 2; ++b)
#pragma unroll
            for (int m = 0; m < 4; ++m)
#pragma unroll
                for (int n = 0; n < 2; ++n) acc[a][b][m][n] = (f32x4){0.f, 0.f, 0.f, 0.f};
    bf16x8 At[4][2], B0[2][2], B1[2][2];
    const char* cA = cur.A; const char* cB = cur.B;
    PG8_GVOFF(gAc, cur);
    PG8_STAGE(PG8_SB(0, 0), cB, voffB); PG8_STAGE_A(PG8_SA(0, 0), cA, 0, false); PG8_STAGE(PG8_SB(0, 1), cB + hstepB, voffB); PG8_STAGE_A(PG8_SA(0, 1), cA, 1, false);
    if (wr == 1) PG8_BAR;
    PG8_WAIT_V(4); PG8_BAR;
    PG8_STAGE(PG8_SB(1, 0), cB + kstep, voffB); PG8_STAGE_A(PG8_SA(1, 0), cA + kstep, 0, false); PG8_STAGE(PG8_SB(1, 1), cB + hstepB + kstep, voffB);
    PG8_WAIT_V(6); PG8_BAR;
    for (;;) {
        const bool has_next = S.next(ui + 1, nxt);
        const char* nA = has_next ? nxt.A : cA; const char* nB = has_next ? nxt.B : cB;
        if constexpr (GATHER) { if (has_next) { PG8_GVOFF(gAn, nxt); } else { gAn[0] = gAc[0]; gAn[1] = gAc[1]; } }
        for (int t = 0; t < nt; t += 2) {
            const bool last = (t == nt - 2);
            const char* a1 = cA + (size_t)(t + 1) * kstep;
            const char* a2 = last ? nA : cA + (size_t)(t + 2) * kstep; const char* b2 = last ? nB : cB + (size_t)(t + 2) * kstep;
            const char* a3 = a2 + kstep; const char* b3 = b2 + kstep;
            PG8_LDB(B0, 0, 0); PG8_SCHED; PG8_LDA(At, 0, 0); PG8_STAGE_A(PG8_SA(1, 1), a1, 1, false);
            PG8_WAIT_L(8); PG8_BAR; PG8_WAIT_L(0); PG8_MMA(0, 0, At, B0); PG8_BAR; PG8_SCHED;
            PG8_LDB(B1, 0, 1); PG8_STAGE(PG8_SB(0, 0), b2, voffB);
            PG8_BAR; PG8_WAIT_L(0); PG8_MMA(0, 1, At, B1); PG8_BAR;
            PG8_LDA(At, 0, 1); PG8_STAGE_A(PG8_SA(0, 0), a2, 0, last);
            PG8_BAR; PG8_WAIT_L(0); PG8_MMA(1, 0, At, B0); PG8_BAR; PG8_SCHED;
            PG8_STAGE(PG8_SB(0, 1), b2 + hstepB, voffB);
            PG8_WAIT_V(6); PG8_BAR; PG8_MMA(1, 1, At, B1); PG8_BAR;
            PG8_LDB(B0, 1, 0); PG8_SCHED; PG8_LDA(At, 1, 0); PG8_STAGE_A(PG8_SA(0, 1), a2, 1, last);
            PG8_WAIT_L(8); PG8_BAR; PG8_WAIT_L(0); PG8_MMA(0, 0, At, B0); PG8_BAR; PG8_SCHED;
            PG8_LDB(B1, 1, 1); PG8_STAGE(PG8_SB(1, 0), b3, voffB);
            PG8_BAR; PG8_WAIT_L(0); PG8_MMA(0, 1, At, B1); PG8_BAR;
            PG8_LDA(At, 1, 1); PG8_STAGE_A(PG8_SA(1, 0), a3, 0, last);
            PG8_BAR; PG8_WAIT_L(0); PG8_MMA(1, 0, At, B0); PG8_BAR; PG8_SCHED;
            PG8_STAGE(PG8_SB(1, 1), b3 + hstepB, voffB);
            PG8_WAIT_V(6); PG8_BAR; PG8_MMA(1, 1, At, B1); PG8_BAR;
        }
        E(acc, cur, wr, wc, fr, fq);
        if (!has_next) break;
#pragma unroll
        for (int a = 0; a < 2; ++a)
#pragma unroll
            for (int b = 0; b < 2; ++b)
#pragma unroll
                for (int m = 0; m < 4; ++m)
#pragma unroll
                    for (int n = 0; n < 2; ++n) acc[a][b][m][n] = (f32x4){0.f, 0.f, 0.f, 0.f};
        cur = nxt; cA = nA; cB = nB; ++ui;
        if constexpr (GATHER) { gAc[0] = gAn[0]; gAc[1] = gAn[1]; }
    }
    PG8_WAIT_V(0);
    if (wr == 0) PG8_BAR;
    PG8_BAR;
#undef PG8_SA
#undef PG8_SB
#undef PG8_STAGE
#undef PG8_STAGE_A
#undef PG8_LDA
#undef PG8_LDB
#undef PG8_MMA
#undef PG8_WAIT_V
#undef PG8_WAIT_L
#undef PG8_BAR
#undef PG8_SCHED
#undef PG8_GVOFF
}

#ifndef DGR
#define DGR 8
#endif
struct DenseSched {
    static constexpr bool GATHER = false;
    const char* A; const char* B; int lda, ldb, nM, nN, pm0, nwg, G, c, lim;
    __device__ void init(const void* A_, const void* B_, int lda_, int ldb_, int nM_, int nN_, int pm0_, int G_, int c_) { A = (const char*)A_; B = (const char*)B_; lda = lda_; ldb = ldb_; nM = nM_; nN = nN_; pm0 = pm0_; nwg = nM * nN; G = G_; c = c_; lim = nwg; }
    __device__ __forceinline__ void tile_of(int L, int& pm, int& pn) const {
        int wgid = L; { const int q = nwg / 8, r = nwg % 8, xcd = wgid % 8, off = wgid / 8; wgid = (xcd < r ? xcd * (q + 1) : r * (q + 1) + (xcd - r) * q) + off; }
        const int nig = DGR * nN, gid = wgid / nig, fm = gid * DGR, gsz = (nM - fm) < DGR ? (nM - fm) : DGR;
        pm = fm + ((wgid % nig) % gsz) + pm0; pn = (wgid % nig) / gsz; }
    __device__ __forceinline__ bool next(int i, GUnit& u) const {
        const long L = (long)i * G + c; if (L >= lim) return false;
        int wgid = (int)L; { const int q = nwg / 8, r = nwg % 8, xcd = wgid % 8, off = wgid / 8; wgid = (xcd < r ? xcd * (q + 1) : r * (q + 1) + (xcd - r) * q) + off; }
        const int nig = DGR * nN, gid = wgid / nig, fm = gid * DGR, gsz = (nM - fm) < DGR ? (nM - fm) : DGR;
        const int pm = fm + ((wgid % nig) % gsz) + pm0, pn = (wgid % nig) / gsz;
        u.A = A + (size_t)pm * 256 * lda; u.B = B + (size_t)pn * 256 * ldb; u.i0 = pm; u.i1 = pn; u.i2 = 0; u.i3 = 0; return true;
    }
};
struct SplitSched {
    static constexpr bool GATHER = false;
    DenseSched D; int first, S, kbytes, c;
    __device__ __forceinline__ bool next(int i, GUnit& u) const {
        if (i > 0) return false; const int L = first + c / S, ks = c % S; if (L >= D.nwg) return false;
        int pm, pn; D.tile_of(L, pm, pn);
        u.A = D.A + (size_t)pm * 256 * D.lda + (size_t)ks * kbytes; u.B = D.B + (size_t)pn * 256 * D.ldb + (size_t)ks * kbytes; u.i0 = pm; u.i1 = pn; u.i2 = c; u.i3 = ks; return true; }
};
}
namespace epi {
using pg8::GUnit;
__device__ __forceinline__ void unpack8(const u32x4 w, float (&o)[8]) {
    o[0] = __uint_as_float(w.x << 16); o[1] = __uint_as_float(w.x & 0xffff0000u); o[2] = __uint_as_float(w.y << 16); o[3] = __uint_as_float(w.y & 0xffff0000u);
    o[4] = __uint_as_float(w.z << 16); o[5] = __uint_as_float(w.z & 0xffff0000u); o[6] = __uint_as_float(w.w << 16); o[7] = __uint_as_float(w.w & 0xffff0000u);
}
__device__ __forceinline__ u32x4 pack8(const float (&v)[8]) { u32x4 w; w.x = pk2(v[0], v[1]); w.y = pk2(v[2], v[3]); w.z = pk2(v[4], v[5]); w.w = pk2(v[6], v[7]); return w; }
#define EPI_ROWS_BEGIN(pmrow0) _Pragma("unroll") for (int ai = 0; ai < 2; ++ai) _Pragma("unroll") for (int m = 0; m < 4; ++m) { const int row = (pmrow0) + ai * 128 + wr * 64 + m * 16 + fr;
#define EPI_ROWS_END asm volatile("" ::: "memory"); }

struct EpiWin {
    static constexpr bool PERM = true;
    bf16_t* P; bf16_t* UG; const float* loglb; const float* logub; const float* gbias;
    bool lb0;
#ifdef PROBE_SPLIT
    int pmode;
#endif
    template <int TYPE>
    __device__ __forceinline__ void body(const f32x4 (&acc)[2][2][4][2], const GUnit& u, int wr, int wc, int fr, int fq) const {
        const int pm = u.i0, pn = u.i1;
#pragma unroll
        for (int bj = 0; bj < 2; ++bj) {
            const int col = pn * 256 + bj * 128 + wc * 32 + 8 * fq;
            float pa[8], pb[8];
#pragma unroll
            for (int j = 0; j < 8; ++j) { pa[j] = 0.f; pb[j] = 0.f; }
            if (TYPE == 1) { const int ch = col & 511;
#pragma unroll
                for (int j = 0; j < 8; ++j) { pa[j] = loglb[ch + j]; pb[j] = logub[ch + j]; } }
            if (TYPE == 4) { const int n = col - 3584;
#pragma unroll
                for (int j = 0; j < 8; ++j) pa[j] = gbias[n + j]; }
            EPI_ROWS_BEGIN(pm * 256)
                float v[8];
#pragma unroll
                for (int j = 0; j < 4; ++j) { v[j] = acc[ai][bj][m][0][j]; v[4 + j] = acc[ai][bj][m][1][j]; }
                if (TYPE == 1 && lb0) {
#pragma unroll
                    for (int j = 0; j < 8; ++j) { const float z = v[j]; v[j] = fminf(z, 0.f) - __logf(1.0f + __expf(-fabsf(z))); }
                } else if (TYPE == 1) {
#pragma unroll
                    for (int j = 0; j < 8; ++j) { const float z = v[j], t = __expf(-fabsf(z)), rc = __builtin_amdgcn_rcpf(1.0f + t), sg = z >= 0.f ? rc : t * rc;
                        const bool pos = pa[j] > 0.f; const float L = __logf(pos ? pa[j] + pb[j] * sg : 1.0f + t); v[j] = pos ? L : fminf(z, 0.f) - L; }
                } else if (TYPE == 2) {
#pragma unroll
                    for (int j = 0; j < 8; ++j) v[j] = fsilu(v[j]);
                } else if (TYPE == 3) {
#pragma unroll
                    for (int j = 0; j < 8; ++j) v[j] *= 0.125f;
                } else if (TYPE == 4) {
#pragma unroll
                    for (int j = 0; j < 8; ++j) v[j] = flogsig(v[j] + pa[j]) * 0.0625f;
                }
                const u32x4 w = pack8(v);
                if (TYPE == 5) { const int c0 = col - 4608, g = c0 >> 4, p0 = c0 & 15, ck = row >> 5, mm = row & 31;
                    *(u32x4*)(UG + ((size_t)(g * S5ROWS + ck) * S5K + mm * 16 + p0)) = w; }
                else *(u32x4*)(P + (size_t)row * LDP + col) = w;
            EPI_ROWS_END
        }
    }
    __device__ __forceinline__ void operator()(const f32x4 (&acc)[2][2][4][2], const GUnit& u, int wr, int wc, int fr, int fq) const {
        const int pn = u.i1;
#ifdef PROBE_SPLIT
        if (pmode & 1) { body<0>(acc, u, wr, wc, fr, fq); return; }
#endif
        if (pn >= 2 && pn <= 5) body<1>(acc, u, wr, wc, fr, fq);
        else if (pn == 8 || pn == 9 || pn == 16 || pn == 17) body<2>(acc, u, wr, wc, fr, fq);
        else if (pn == 10) body<3>(acc, u, wr, wc, fr, fq);
        else if (pn == 14 || pn == 15) body<4>(acc, u, wr, wc, fr, fq);
        else if (pn >= 18) body<5>(acc, u, wr, wc, fr, fq);
        else body<0>(acc, u, wr, wc, fr, fq);
    }
};
typedef unsigned char gate_t;
__device__ __forceinline__ u32x2 gate_pack8(const float (&g)[8]) { u32x2 w; w.x = 0u; w.y = 0u;
    w.x = __builtin_amdgcn_cvt_pk_u8_f32(__builtin_rintf(g[0] * 255.0f), 0, w.x); w.x = __builtin_amdgcn_cvt_pk_u8_f32(__builtin_rintf(g[1] * 255.0f), 1, w.x);
    w.x = __builtin_amdgcn_cvt_pk_u8_f32(__builtin_rintf(g[2] * 255.0f), 2, w.x); w.x = __builtin_amdgcn_cvt_pk_u8_f32(__builtin_rintf(g[3] * 255.0f), 3, w.x);
    w.y = __builtin_amdgcn_cvt_pk_u8_f32(__builtin_rintf(g[4] * 255.0f), 0, w.y); w.y = __builtin_amdgcn_cvt_pk_u8_f32(__builtin_rintf(g[5] * 255.0f), 1, w.y);
    w.y = __builtin_amdgcn_cvt_pk_u8_f32(__builtin_rintf(g[6] * 255.0f), 2, w.y); w.y = __builtin_amdgcn_cvt_pk_u8_f32(__builtin_rintf(g[7] * 255.0f), 3, w.y); return w; }
__device__ __forceinline__ void gate_unpack8(const u32x2 w, float (&g)[8]) {
#pragma unroll
    for (int j = 0; j < 4; ++j) { g[j] = (float)((w.x >> (8 * j)) & 255u) * (1.0f / 255.0f); g[4 + j] = (float)((w.y >> (8 * j)) & 255u) * (1.0f / 255.0f); } }
struct GateMap { gate_t* G; gate_t* SP; int mode;
    __device__ __forceinline__ gate_t* loc(int pm, int pn) const {
        int g = -1;
        if (mode == 1) { if (pn >= 8) g = (11 - pn) * 64 + (pm - 4); }
        else if (pm < 4) g = pm * 12 + pn;
        return g >= 0 ? SP + (size_t)g * 65536 : G + (size_t)(pm * 12 + pn) * 65536; } };
struct EpiGate {
    static constexpr bool PERM = true;
    GateMap GM;
    __device__ __forceinline__ void operator()(const f32x4 (&acc)[2][2][4][2], const GUnit& u, int wr, int wc, int fr, int fq) const {
        gate_t* base = GM.loc(u.i0, u.i1);
#pragma unroll
        for (int bj = 0; bj < 2; ++bj) { const int col = bj * 128 + wc * 32 + 8 * fq;
            EPI_ROWS_BEGIN(0)
                float v[8];
#pragma unroll
                for (int j = 0; j < 4; ++j) { v[j] = fsigmoid(acc[ai][bj][m][0][j]); v[4 + j] = fsigmoid(acc[ai][bj][m][1][j]); }
                *(u32x2*)(base + row * 256 + col) = gate_pack8(v);
            EPI_ROWS_END }
    }
};
struct EpiS5Loc {
    static constexpr bool PERM = false;
    float* SL;
    __device__ __forceinline__ void operator()(const f32x4 (&acc)[2][2][4][2], const GUnit& u, int wr, int wc, int fr, int fq) const {
        const int g = u.i0, mt = u.i1;
        EPI_ROWS_BEGIN(mt * 256)
            float* rp = SL + ((size_t)(g * S5ROWS + row)) * 256 + wc * 32 + 4 * fq;
#pragma unroll
            for (int bj = 0; bj < 2; ++bj)
#pragma unroll
                for (int n = 0; n < 2; ++n) *(f32x4*)(rp + bj * 128 + n * 16) = acc[ai][bj][m][n];
        EPI_ROWS_END
    }
};
struct EpiS5Out {
    static constexpr bool PERM = true;
    bf16_t* YP;
    __device__ __forceinline__ void operator()(const f32x4 (&acc)[2][2][4][2], const GUnit& u, int wr, int wc, int fr, int fq) const {
        const int g = u.i0, mt = u.i1, pn = u.i2;
#pragma unroll
        for (int bj = 0; bj < 2; ++bj) { const int col = pn * 256 + bj * 128 + wc * 32 + 8 * fq, mm = col >> 4, p0 = col & 15;
            EPI_ROWS_BEGIN(mt * 256)
                if (row < S5CH) {
                    float v[8];
#pragma unroll
                    for (int j = 0; j < 4; ++j) { v[j] = acc[ai][bj][m][0][j]; v[4 + j] = acc[ai][bj][m][1][j]; }
#pragma unroll
                    for (int j = 0; j < 8; ++j) { const float x = v[j]; v[j] = x * fsigmoid(1.5957691216057308f * (x + 0.044715f * x * x * x)); }
                    *(u32x4*)(YP + (size_t)(row * S5L + mm) * 512 + g * 16 + p0) = pack8(v);
                }
            EPI_ROWS_END }
    }
};
struct EpiGlu {
    static constexpr bool PERM = true;
    const bf16_t* YP; bf16_t* Y;
    __device__ __forceinline__ void operator()(const f32x4 (&acc)[2][2][4][2], const GUnit& u, int wr, int wc, int fr, int fq) const {
        const int col0 = u.i1 * 256 + wc * 32 + 8 * fq;
#pragma unroll
        for (int ai = 0; ai < 2; ++ai) { u32x4 yv[4][2];
#pragma unroll
            for (int m = 0; m < 4; ++m)
#pragma unroll
                for (int bj = 0; bj < 2; ++bj) yv[m][bj] = *(const u32x4*)(YP + (size_t)(u.i0 * 256 + ai * 128 + wr * 64 + m * 16 + fr) * 512 + col0 + bj * 128);
#pragma unroll
            for (int m = 0; m < 4; ++m)
#pragma unroll
                for (int bj = 0; bj < 2; ++bj) { const int row = u.i0 * 256 + ai * 128 + wr * 64 + m * 16 + fr; float y[8], v[8]; unpack8(yv[m][bj], y);
#pragma unroll
                    for (int j = 0; j < 4; ++j) { v[j] = y[j] * fsigmoid(acc[ai][bj][m][0][j]); v[4 + j] = y[4 + j] * fsigmoid(acc[ai][bj][m][1][j]); }
                    *(u32x4*)(Y + (size_t)row * 1536 + 1024 + col0 + bj * 128) = pack8(v); }
            asm volatile("" ::: "memory"); }
    }
};
struct EpiMerge {
    static constexpr bool PERM = true;
    GateMap GM; bf16_t* MG;
#ifdef PROBE_MERGE
    int pmode;
#endif
    __device__ __forceinline__ void operator()(const f32x4 (&acc)[2][2][4][2], const GUnit& u, int wr, int wc, int fr, int fq) const {
        const int k = u.i2, col0 = u.i1 * 256 + wc * 32 + 8 * fq;
        const gate_t* gb = GM.loc(u.i0, k * 4 + u.i1) + wc * 32 + 8 * fq;
#pragma unroll
        for (int ai = 0; ai < 2; ++ai) { u32x2 gv[4][2]; u32x4 pv[4][2];
#pragma unroll
            for (int m = 0; m < 4; ++m)
#pragma unroll
                for (int bj = 0; bj < 2; ++bj) { const size_t row = (size_t)(u.i0 * 256 + ai * 128 + wr * 64 + m * 16 + fr);
#ifdef PROBE_MERGE
                    gv[m][bj] = (pmode & 2) ? (u32x2){0xffffffffu, 0xffffffffu} : *(const u32x2*)(gb + (ai * 128 + wr * 64 + m * 16 + fr) * 256 + bj * 128);
                    pv[m][bj] = (k > 0 && !(pmode & 1)) ? *(const u32x4*)(MG + row * 1024 + col0 + bj * 128) : (u32x4){0u, 0u, 0u, 0u}; }
#else
                    gv[m][bj] = *(const u32x2*)(gb + (ai * 128 + wr * 64 + m * 16 + fr) * 256 + bj * 128);
                    pv[m][bj] = k > 0 ? *(const u32x4*)(MG + row * 1024 + col0 + bj * 128) : (u32x4){0u, 0u, 0u, 0u}; }
#endif
#pragma unroll
            for (int m = 0; m < 4; ++m)
#pragma unroll
                for (int bj = 0; bj < 2; ++bj) { const size_t row = (size_t)(u.i0 * 256 + ai * 128 + wr * 64 + m * 16 + fr); float gt[8], pr[8], v[8]; gate_unpack8(gv[m][bj], gt); unpack8(pv[m][bj], pr);
#pragma unroll
                    for (int j = 0; j < 4; ++j) { v[j] = gt[j] * acc[ai][bj][m][0][j] + pr[j]; v[4 + j] = gt[4 + j] * acc[ai][bj][m][1][j] + pr[4 + j]; }
                    *(u32x4*)(MG + row * 1024 + col0 + bj * 128) = pack8(v); }
            asm volatile("" ::: "memory"); }
    }
};
struct EpiResid {
    static constexpr bool PERM = true;
    bf16_t* XW; const float* modacc; const float* adab;
    __device__ __forceinline__ void operator()(const f32x4 (&acc)[2][2][4][2], const GUnit& u, int wr, int wc, int fr, int fq) const {
        const int pm = u.i0, bidx = pm < 4 ? 4 : ((pm - 4) >> 4);
        const int col0 = u.i1 * 256 + wc * 32 + 8 * fq;
        f32x4 gv[2][2];
#pragma unroll
        for (int bj = 0; bj < 2; ++bj)
#pragma unroll
            for (int n = 0; n < 2; ++n) gv[bj][n] = *(const f32x4*)(modacc + bidx * 6144 + col0 + bj * 128 + n * 4) + *(const f32x4*)(adab + col0 + bj * 128 + n * 4);
#pragma unroll
        for (int ai = 0; ai < 2; ++ai) { u32x4 xv[4][2];
#pragma unroll
            for (int m = 0; m < 4; ++m) { const bf16_t* rp = XW + (size_t)(pm * 256 + ai * 128 + wr * 64 + m * 16 + fr) * 1024 + col0;
#pragma unroll
                for (int bj = 0; bj < 2; ++bj) xv[m][bj] = *(const u32x4*)(rp + bj * 128); }
#pragma unroll
            for (int m = 0; m < 4; ++m) { bf16_t* rp = XW + (size_t)(pm * 256 + ai * 128 + wr * 64 + m * 16 + fr) * 1024 + col0;
#pragma unroll
                for (int bj = 0; bj < 2; ++bj) { float x8[8], v[8]; unpack8(xv[m][bj], x8);
#pragma unroll
                    for (int j = 0; j < 4; ++j) { v[j] = x8[j] + gv[bj][0][j] * acc[ai][bj][m][0][j]; v[4 + j] = x8[4 + j] + gv[bj][1][j] * acc[ai][bj][m][1][j]; }
                    *(u32x4*)(rp + bj * 128) = pack8(v); } }
            asm volatile("" ::: "memory"); }
    }
};
struct EpiSwiglu {
    static constexpr bool PERM = true;
    bf16_t* HID;
    __device__ __forceinline__ void operator()(const f32x4 (&acc)[2][2][4][2], const GUnit& u, int wr, int wc, int fr, int fq) const {
        const int col = u.i1 * 128 + wc * 32 + 8 * fq;
        EPI_ROWS_BEGIN(u.i0 * 256)
            float v[8];
#pragma unroll
            for (int j = 0; j < 4; ++j) { v[j] = fsilu(acc[ai][0][m][0][j]) * acc[ai][1][m][0][j]; v[4 + j] = fsilu(acc[ai][0][m][1][j]) * acc[ai][1][m][1][j]; }
            *(u32x4*)(HID + (size_t)row * FFN + col) = pack8(v);
        EPI_ROWS_END
    }
};
struct EpiStoreBf16 {
    static constexpr bool PERM = true;
    bf16_t* O; int ld;
    __device__ __forceinline__ void operator()(const f32x4 (&acc)[2][2][4][2], const GUnit& u, int wr, int wc, int fr, int fq) const {
#pragma unroll
        for (int bj = 0; bj < 2; ++bj) { const int col = u.i1 * 256 + bj * 128 + wc * 32 + 8 * fq;
            EPI_ROWS_BEGIN(u.i0 * 256)
                float v[8];
#pragma unroll
                for (int j = 0; j < 4; ++j) { v[j] = acc[ai][bj][m][0][j]; v[4 + j] = acc[ai][bj][m][1][j]; }
                *(u32x4*)(O + (size_t)row * ld + col) = pack8(v);
            EPI_ROWS_END }
    }
};
#ifdef PROBE_GEMM
struct EpiNull {
    static constexpr bool PERM = false;
    float* O;
    __device__ __forceinline__ void operator()(const f32x4 (&acc)[2][2][4][2], const GUnit& u, int wr, int wc, int fr, int fq) const {
        f32x4 t = acc[0][0][0][0];
#pragma unroll
        for (int ai = 0; ai < 2; ++ai)
#pragma unroll
            for (int bj = 0; bj < 2; ++bj)
#pragma unroll
                for (int m = 0; m < 4; ++m) { t += acc[ai][bj][m][0]; t += acc[ai][bj][m][1]; }
        if (t[0] + t[1] + t[2] + t[3] == 12345.678f) O[fq] = t[0];
    }
};
#endif
struct EpiSlab {
    static constexpr bool PERM = true;
    bf16_t* SLB;
    __device__ __forceinline__ void operator()(const f32x4 (&acc)[2][2][4][2], const GUnit& u, int wr, int wc, int fr, int fq) const {
        bf16_t* base = SLB + (size_t)u.i2 * 65536 + wc * 32 + 8 * fq;
#pragma unroll
        for (int ai = 0; ai < 2; ++ai)
#pragma unroll
            for (int m = 0; m < 4; ++m) { bf16_t* rp = base + (ai * 128 + wr * 64 + m * 16 + fr) * 256;
#pragma unroll
                for (int bj = 0; bj < 2; ++bj) { float v[8];
#pragma unroll
                    for (int j = 0; j < 4; ++j) { v[j] = acc[ai][bj][m][0][j]; v[4 + j] = acc[ai][bj][m][1][j]; }
                    *(u32x4*)(rp + bj * 128) = pack8(v); } }
    }
};
}
struct Args { const float* in[33]; float* out; unsigned char* ws; int ph_lo, ph_hi, qsel; };
typedef const __attribute__((address_space(4))) Args* ArgsP;
struct Frame {
    LAS unsigned char* lds;
    unsigned* ctl; unsigned char* ws;
    int tid, lane, wave, G, c;
    ArgsP ap;
};
enum { I_X = 0, I_C, I_CTX, I_CCTX, I_N1G, I_N2G, I_ADAW, I_ADAB, I_WIN, I_LBL, I_HGNG, I_GUP, I_GB, I_GLNG, I_SARE, I_SAIM, I_SLOG, I_SBRE, I_SBIM, I_SCRE, I_SCIM, I_SD, I_SGLU, I_BRP, I_WOUT,
       I_FW1, I_FW3, I_FW2, I_RW, I_MW1, I_MW3, I_MW2, I_FNG };

__device__ __forceinline__ void tr_load(const float* W, int ldw, int scol0, int k0, int lane, float (&r)[32]) {
#pragma unroll
    for (int i = 0; i < 32; ++i) r[i] = __builtin_nontemporal_load(W + (size_t)(k0 + 2 * i + (lane >> 5)) * ldw + scol0 + (lane & 31));
}
__device__ __forceinline__ void tr_store(const float (&r)[32], bf16_t* WT, int K, int drow0, int k0, LAS float* scr, int lane) {
#pragma unroll
    for (int i = 0; i < 32; ++i) scr[(2 * i + (lane >> 5)) * 33 + (lane & 31)] = r[i];
    LDS_WAIT(); asm volatile("" ::: "memory");
    const int c = lane & 7;
#pragma unroll
    for (int j = 0; j < 4; ++j) { const int n = (lane >> 3) + 8 * j; const LAS float* s = scr + (8 * c) * 33 + n;
        u32x4 o; o.x = pk2(s[0 * 33], s[1 * 33]); o.y = pk2(s[2 * 33], s[3 * 33]); o.z = pk2(s[4 * 33], s[5 * 33]); o.w = pk2(s[6 * 33], s[7 * 33]);
        *(u32x4*)(WT + (size_t)(drow0 + n) * K + k0 + 8 * c) = o; }
    LDS_WAIT(); asm volatile("" ::: "memory");
}
__device__ __forceinline__ void tr_load4(const float* W, int ldw, int scol0, int k0, int lane, f32x4 (&r)[8]) {
#pragma unroll
    for (int i = 0; i < 8; ++i) r[i] = __builtin_nontemporal_load((const f32x4*)(W + (size_t)(k0 + 8 * i + (lane >> 3)) * ldw + scol0 + 4 * (lane & 7)));
}
__device__ __forceinline__ void tr_store4(const f32x4 (&r)[8], bf16_t* WT, int K, int drow0, int k0, LAS float* scr, int lane) {
#pragma unroll
    for (int i = 0; i < 8; ++i)
#pragma unroll
        for (int j = 0; j < 4; ++j) scr[(8 * i + (lane >> 3)) * 33 + 4 * (lane & 7) + j] = r[i][j];
    LDS_WAIT(); asm volatile("" ::: "memory");
    const int c = lane & 7;
#pragma unroll
    for (int j = 0; j < 4; ++j) { const int n = (lane >> 3) + 8 * j; const LAS float* s = scr + (8 * c) * 33 + n;
        u32x4 o; o.x = pk2(s[0 * 33], s[1 * 33]); o.y = pk2(s[2 * 33], s[3 * 33]); o.z = pk2(s[4 * 33], s[5 * 33]); o.w = pk2(s[6 * 33], s[7 * 33]);
        *(u32x4*)(WT + (size_t)(drow0 + n) * K + k0 + 8 * c) = o; }
    LDS_WAIT(); asm volatile("" ::: "memory");
}
__device__ __forceinline__ void tr_job(Frame& F, int& base, const float* W, int ldw, int scol0, int ncols, int K, bf16_t* WT, int drow0, int dmap) {
    const int gw = F.c * 8 + F.wave, NGW = F.G * 8, nblk = ncols / 32, nitems = (K / 64) * nblk;
    LAS float* scr = (LAS float*)(F.lds + F.wave * 16384);
    int first = gw - (base % NGW); if (first < 0) first += NGW;
    float ra[32], rb[32];
    int it = first;
    if (it < nitems) tr_load(W, ldw, scol0 + (it % nblk) * 32, (it / nblk) * 64, F.lane, ra);
    while (it < nitems) {
        const int nx = it + NGW;
        if (nx < nitems) tr_load(W, ldw, scol0 + (nx % nblk) * 32, (nx / nblk) * 64, F.lane, rb);
        { const int n0 = (it % nblk) * 32; const int dr = dmap == 0 ? drow0 + n0 : drow0 + (n0 >> 7) * 256 + (n0 & 127); tr_store(ra, WT, K, dr, (it / nblk) * 64, scr, F.lane); }
        it = nx;
        if (it >= nitems) break;
        const int nx2 = it + NGW;
        if (nx2 < nitems) tr_load(W, ldw, scol0 + (nx2 % nblk) * 32, (nx2 / nblk) * 64, F.lane, ra);
        { const int n0 = (it % nblk) * 32; const int dr = dmap == 0 ? drow0 + n0 : drow0 + (n0 >> 7) * 256 + (n0 & 127); tr_store(rb, WT, K, dr, (it / nblk) * 64, scr, F.lane); }
        it = nx2;
    }
    base += nitems;
}

struct cplx { float re, im; };
__device__ __forceinline__ cplx cmul(cplx a, cplx b) { return {a.re * b.re - a.im * b.im, a.re * b.im + a.im * b.re}; }
__device__ __forceinline__ cplx s5_pow(float are, float aim, float dt, int j) {
    const float mag = __expf((float)j * are * dt);
    double ang = (double)j * (double)aim * (double)dt; ang -= 6.283185307179586476925 * rint(ang * 0.15915494309189533577);
    const float sn = sinf((float)ang), cs = cosf((float)ang);
    return {mag * cs, mag * sn};
}
__device__ __forceinline__ cplx s5_z(float are, float aim, float dt) {
    const float x = are * dt; double ang = (double)aim * (double)dt; ang -= 6.283185307179586476925 * rint(ang * 0.15915494309189533577);
    const float th = (float)ang, sh = sinf(0.5f * th), em1 = expm1f(x), ex = em1 + 1.0f;
    const float cm1 = -2.0f * sh * sh;
    const float nre = em1 * (1.0f + cm1) + cm1, nim = ex * sinf(th);
    const float den = are * are + aim * aim;
    return {(nre * are + nim * aim) / den, (nim * are - nre * aim) / den};
}
constexpr size_t WS_S5PW = WS_BIG + 334 * MiB;
constexpr size_t WS_S5KT = WS_BIG + 338 * MiB;
constexpr size_t WS_S5BB = WS_BIG + 342 * MiB;
static_assert(WS_S5BB + 1 * MiB <= WS_END, "ws");

__device__ __forceinline__ void s5_table_item(Frame& F, const int it) {
    float* PW = (float*)(F.ws + WS_S5PW); float* KT = (float*)(F.ws + WS_S5KT);
    LAS float* spw = (LAS float*)F.lds;
    LAS float* sbb = spw + 9 * 128;
    LAS float* scc = sbb + 2048;
    LAS float* szz = scc + 2048;
    {
        const int jq = it & 3, g = (it >> 2) & 31, d = (it >> 7) & 1, l = it >> 8, ldg = (l * 2 + d) * 32 + g, j0 = jq * 8;
        const float dt = __expf(F.ap->in[I_SLOG][ldg]);
        __syncthreads();
        for (int u = F.tid; u < 9 * 64; u += NTHREADS) { const int j = j0 + u / 64, n = u % 64; if (j <= 32) { const cplx p = s5_pow(F.ap->in[I_SARE][ldg * 64 + n], F.ap->in[I_SAIM][ldg * 64 + n], dt, j);
            spw[u * 2] = p.re; spw[u * 2 + 1] = p.im; PW[((size_t)ldg * 33 + j) * 128 + n * 2] = p.re; PW[((size_t)ldg * 33 + j) * 128 + n * 2 + 1] = p.im; } }
        if (F.tid >= 64 && F.tid < 128) { const int n = F.tid - 64; const cplx z = s5_z(F.ap->in[I_SARE][ldg * 64 + n], F.ap->in[I_SAIM][ldg * 64 + n], dt); szz[n * 2] = z.re; szz[n * 2 + 1] = z.im; }
        __syncthreads();
        for (int u = F.tid; u < 1024; u += NTHREADS) { const int n = u >> 4; const cplx z = {szz[n * 2], szz[n * 2 + 1]};
            const cplx b = {F.ap->in[I_SBRE][(size_t)ldg * 1024 + u], F.ap->in[I_SBIM][(size_t)ldg * 1024 + u]}; const cplx bb = cmul(z, b); sbb[u * 2] = bb.re; sbb[u * 2 + 1] = bb.im; if (jq == 0) { float* BB = (float*)(F.ws + WS_S5BB); BB[((size_t)ldg * 1024 + u) * 2] = bb.re; BB[((size_t)ldg * 1024 + u) * 2 + 1] = bb.im; }
            const int pp = u >> 6, nn = u & 63; scc[u * 2] = F.ap->in[I_SCRE][(size_t)ldg * 1024 + pp * 64 + nn]; scc[u * 2 + 1] = F.ap->in[I_SCIM][(size_t)ldg * 1024 + pp * 64 + nn]; }
        __syncthreads();
        { const int jj = F.tid >> 6, p = (F.tid >> 2) & 15, q4 = (F.tid & 3) * 4; float s0 = 0.f, s1 = 0.f, s2 = 0.f, s3 = 0.f;
            for (int n = 0; n < 64; ++n) { const cplx c = {scc[(p * 64 + n) * 2], scc[(p * 64 + n) * 2 + 1]}, w = {spw[(jj * 64 + n) * 2], spw[(jj * 64 + n) * 2 + 1]};
                const cplx cw = cmul(c, w); const f32x4 b0 = *(const LAS f32x4*)(sbb + (n * 16 + q4) * 2), b1 = *(const LAS f32x4*)(sbb + (n * 16 + q4) * 2 + 4);
                s0 += cw.re * b0[0] - cw.im * b0[1]; s1 += cw.re * b0[2] - cw.im * b0[3]; s2 += cw.re * b1[0] - cw.im * b1[1]; s3 += cw.re * b1[2] - cw.im * b1[3]; }
            *(f32x4*)(KT + ((size_t)ldg * 32 + j0 + jj) * 256 + p * 16 + q4) = (f32x4){s0, s1, s2, s3}; }
    }
    __syncthreads();
}
__device__ __forceinline__ void s5_tables(Frame& F, int first, int last) { for (int it = first + F.c; it < last; it += F.G) s5_table_item(F, it); }
__device__ __forceinline__ void s5_task_T(Frame& F, const int l, const unsigned t) {
    const float* KT = (const float*)(F.ws + WS_S5KT); bf16_t* BC = (bf16_t*)(F.ws + WS_S5C);
    const int qh = (int)(t & 1), m2 = (int)((t >> 1) & 31), row = (int)((t >> 6) & 511), g = (int)(t >> 15), m = row >> 4, p = row & 15;
    float v[8];
#pragma unroll
    for (int j = 0; j < 8; ++j) v[j] = 0.f;
    if (m2 <= m) { const float* k = KT + ((size_t)((l * 2 + 0) * 32 + g) * 32 + (m - m2)) * 256 + p * 16 + qh * 8;
#pragma unroll
        for (int j = 0; j < 8; ++j) v[j] += k[j]; }
    if (m2 >= m) { const float* k = KT + ((size_t)((l * 2 + 1) * 32 + g) * 32 + (m2 - m)) * 256 + p * 16 + qh * 8;
#pragma unroll
        for (int j = 0; j < 8; ++j) v[j] += k[j]; }
    if (m2 == m && (p >> 3) == qh) v[p & 7] += F.ap->in[I_SD][l * 512 + g * 16 + p];
    *(u32x4*)(BC + ((size_t)(g * 512 + row)) * 768 + m2 * 16 + qh * 8) = epi::pack8(v);
}
__device__ __forceinline__ void s5_task_W(Frame& F, const int l, const unsigned t) {
    const float* PW = (const float*)(F.ws + WS_S5PW); bf16_t* BC = (bf16_t*)(F.ws + WS_S5C);
    const int n8 = (int)(t & 7), c = (int)((t >> 3) & 1), d = (int)((t >> 4) & 1), row = (int)((t >> 5) & 511), g = (int)(t >> 14), m = row >> 4, p = row & 15;
    const int ldg = (l * 2 + d) * 32 + g, e = d == 0 ? m + 1 : 32 - m; float v[8];
#pragma unroll
    for (int j = 0; j < 8; ++j) { const int n = n8 * 8 + j; const cplx cc = {F.ap->in[I_SCRE][(size_t)ldg * 1024 + p * 64 + n], F.ap->in[I_SCIM][(size_t)ldg * 1024 + p * 64 + n]};
        const cplx w = {PW[((size_t)ldg * 33 + e) * 128 + n * 2], PW[((size_t)ldg * 33 + e) * 128 + n * 2 + 1]}; const cplx cw = cmul(cc, w); v[j] = c == 0 ? cw.re : -cw.im; }
    *(u32x4*)(BC + ((size_t)(g * 512 + row)) * 768 + 512 + d * 128 + c * 64 + n8 * 8) = epi::pack8(v);
}
__device__ __forceinline__ void s5_task_V(Frame& F, const int l, const unsigned t) {
    const float* PW = (const float*)(F.ws + WS_S5PW); const float* BB = (const float*)(F.ws + WS_S5BB); bf16_t* VT = (bf16_t*)(F.ws + WS_S5V);
    const int qh = (int)(t & 1), m2 = (int)((t >> 1) & 31), vr = (int)((t >> 6) & 255), g = (int)(t >> 14), d = vr >> 7, c = (vr >> 6) & 1, n = vr & 63;
    const int ldg = (l * 2 + d) * 32 + g, e = d == 0 ? 31 - m2 : m2;
    const cplx w = {PW[((size_t)ldg * 33 + e) * 128 + n * 2], PW[((size_t)ldg * 33 + e) * 128 + n * 2 + 1]}; float v[8];
    const float* bp = BB + ((size_t)ldg * 1024 + n * 16 + qh * 8) * 2;
#pragma unroll
    for (int j = 0; j < 8; ++j) { const cplx b = {bp[j * 2], bp[j * 2 + 1]}; const cplx r = cmul(w, b); v[j] = c == 0 ? r.re : r.im; }
    *(u32x4*)(VT + ((size_t)(g * 256 + vr)) * 512 + m2 * 16 + qh * 8) = epi::pack8(v);
}
template <int L>
__device__ __forceinline__ void bg_s5fill(Frame& F) {
    volatile LAS unsigned* slot = (volatile LAS unsigned*)(F.lds + LDS_MISC + 64);
    for (;;) {
        __syncthreads();
        if (F.tid == 0) slot[0] = __hip_atomic_fetch_add(F.ctl + CW_WQ + 64 * (7 + L), 1u, __ATOMIC_RELAXED, __HIP_MEMORY_SCOPE_AGENT);
        __syncthreads();
        const unsigned blk = slot[0]; if (blk >= 512u) break;
        if (blk < 256u) { for (int u = 0; u < 8; ++u) s5_task_T(F, L, (blk * 8 + u) * NTHREADS + F.tid); }
        else if (blk < 384u) { for (int u = 0; u < 8; ++u) s5_task_W(F, L, ((blk - 256u) * 8 + u) * NTHREADS + F.tid); }
        else { for (int u = 0; u < 8; ++u) s5_task_V(F, L, ((blk - 384u) * 8 + u) * NTHREADS + F.tid); }
    }
    __syncthreads();
}

struct ConvItem { const float* W; bf16_t* WT; int ldw, scol, ldo, drow, k0; };
__device__ __forceinline__ ConvItem small_item(Frame& F, int l, int it) {
    ConvItem m; const float* win = F.ap->in[I_WIN] + (size_t)l * D * N_IN; bf16_t* wm = (bf16_t*)(F.ws + WS_WMIX) + (size_t)l * NMIX * D; int nblk, loc;
    if (it < 1792) { loc = it; nblk = 112; m.W = win; m.ldw = N_IN; m.scol = 0; m.WT = wm; m.ldo = D; m.drow = 0; }
    else if (it < 2048) { loc = it - 1792; nblk = 16; m.W = win; m.ldw = N_IN; m.scol = 3616; m.WT = wm; m.ldo = D; m.drow = 4096; }
    else if (it < 2304) { loc = it - 2048; nblk = 16; m.W = win; m.ldw = N_IN; m.scol = 4128; m.WT = wm; m.ldo = D; m.drow = 4608; }
    else if (it < 3840) { loc = it - 2304; nblk = 96; m.W = win; m.ldw = N_IN; m.scol = 4640; m.WT = (bf16_t*)(F.ws + WS_WGATE) + (size_t)l * NGATE * D; m.ldo = D; m.drow = 0; }
    else if (it < 4608) { const int k = (it - 3840) >> 8; loc = (it - 3840) & 255; nblk = 32; m.W = F.ap->in[I_BRP] + (size_t)(l * 3 + k) * 512 * D; m.ldw = D; m.scol = 0; m.WT = (bf16_t*)(F.ws + WS_WBR) + (size_t)(l * 3 + k) * D * 512; m.ldo = 512; m.drow = 0; }
    else if (it < 5120) { loc = it - 4608; nblk = 32; m.W = F.ap->in[I_WOUT] + (size_t)l * D * D; m.ldw = D; m.scol = 0; m.WT = (bf16_t*)(F.ws + WS_WOUT) + (size_t)l * D * D; m.ldo = D; m.drow = 0; }
    else { loc = it - 5120; nblk = 16; m.W = F.ap->in[I_SGLU] + (size_t)l * 512 * 512; m.ldw = 512; m.scol = 0; m.WT = (bf16_t*)(F.ws + WS_WGLU) + (size_t)l * 512 * 512; m.ldo = 512; m.drow = 0; }
    const int nb = loc % nblk, kb = loc / nblk; m.scol += nb * 32; m.drow += nb * 32; m.k0 = kb * 64; return m;
}
__device__ __forceinline__ ConvItem ffn_item(Frame& F, int it) {
    ConvItem m; const int mat = it / 1792, loc = it % 1792;
    if (mat < 2) { const int nb = loc % 112, kb = loc / 112, n0 = nb * 32; m.W = F.ap->in[mat == 0 ? I_FW1 : I_FW3]; m.ldw = FFN; m.scol = n0; m.WT = (bf16_t*)(F.ws + WS_W13); m.ldo = D; m.drow = (n0 >> 7) * 256 + (n0 & 127) + (mat == 0 ? 0 : 128); m.k0 = kb * 64; }
    else { const int nb = loc % 32, kb = loc / 32; m.W = F.ap->in[I_FW2]; m.ldw = D; m.scol = nb * 32; m.WT = (bf16_t*)(F.ws + WS_W2); m.ldo = FFN; m.drow = nb * 32; m.k0 = kb * 64; }
    return m;
}
__device__ __forceinline__ ConvItem moe2_item(Frame& F, int it) {
    ConvItem m; const int e = it / 1792, loc = it % 1792, nb = loc % 32, kb = loc / 32;
    m.W = F.ap->in[I_MW2] + (size_t)e * FFN * D; m.ldw = D; m.scol = nb * 32; m.WT = (bf16_t*)(F.ws + WS_MW2) + (size_t)e * D * FFN; m.ldo = FFN; m.drow = nb * 32; m.k0 = kb * 64; return m;
}
template <int SET>
__device__ __forceinline__ void bg_drain(Frame& F) {
    constexpr int NITEMS = SET == 1 ? 8320 : (SET == 2 ? 5248 : (SET == 3 ? 10752 : 3584)), NBLK = NITEMS / 32;
    constexpr int HEAD = SET == 4 ? 11 : 3 + SET, IT0 = SET == 3 ? 3584 : 0;
    static_assert(NITEMS % 32 == 0, "bg items");
    LAS float* scr = (LAS float*)(F.lds + F.wave * 16384);
    volatile LAS unsigned* slot = (volatile LAS unsigned*)(F.lds + LDS_MISC + 64);
    f32x4 ra[8], rb[8], rc[8], rd[8];
    int lane = F.lane; asm volatile("" : "+v"(lane));
    for (;;) {
        __syncthreads();
        if (F.tid == 0) slot[0] = __hip_atomic_fetch_add(F.ctl + CW_WQ + 64 * HEAD, 1u, __ATOMIC_RELAXED, __HIP_MEMORY_SCOPE_AGENT);
        __syncthreads();
        const int blk = (int)slot[0]; if (blk >= NBLK) break;
        const int it0 = IT0 + blk * 32 + F.wave; ConvItem m0, m1, m2, m3;
        if (SET == 1) { m0 = it0 < 2944 ? small_item(F, 0, 2304 + it0) : ffn_item(F, it0 - 2944); m1 = it0 + 8 < 2944 ? small_item(F, 0, 2304 + it0 + 8) : ffn_item(F, it0 + 8 - 2944);
            m2 = it0 + 16 < 2944 ? small_item(F, 0, 2304 + it0 + 16) : ffn_item(F, it0 + 16 - 2944); m3 = it0 + 24 < 2944 ? small_item(F, 0, 2304 + it0 + 24) : ffn_item(F, it0 + 24 - 2944); }
        else if (SET == 2) { m0 = small_item(F, 1, it0); m1 = small_item(F, 1, it0 + 8); m2 = small_item(F, 1, it0 + 16); m3 = small_item(F, 1, it0 + 24); }
        else { m0 = moe2_item(F, it0); m1 = moe2_item(F, it0 + 8); m2 = moe2_item(F, it0 + 16); m3 = moe2_item(F, it0 + 24); }
        tr_load4(m0.W, m0.ldw, m0.scol, m0.k0, lane, ra); tr_load4(m1.W, m1.ldw, m1.scol, m1.k0, lane, rb); tr_load4(m2.W, m2.ldw, m2.scol, m2.k0, lane, rc); tr_load4(m3.W, m3.ldw, m3.scol, m3.k0, lane, rd);
        tr_store4(ra, m0.WT, m0.ldo, m0.drow, m0.k0, scr, lane); tr_store4(rb, m1.WT, m1.ldo, m1.drow, m1.k0, scr, lane);
        tr_store4(rc, m2.WT, m2.ldo, m2.drow, m2.k0, scr, lane); tr_store4(rd, m3.WT, m3.ldo, m3.drow, m3.k0, scr, lane);
    }
    __syncthreads();
}

__device__ __forceinline__ void weff_block(Frame& F, const int blk) {
    LAS float* WL = (LAS float*)F.lds;
    const int nb = blk & 63, dir = (blk >> 6) & 1, l = blk >> 7;
    const float* win = F.ap->in[I_WIN] + (size_t)l * D * N_IN + 3584 + 16 * dir;
    __syncthreads();
    for (int u = F.tid; u < 16384; u += NTHREADS) { const int k = u >> 4, r = u & 15; WL[r * 1028 + k] = win[(size_t)k * N_IN + r]; }
    __syncthreads();
    const int k8 = F.tid & 127, n = nb * 4 + (F.tid >> 7);
    const float* up = F.ap->in[I_GUP] + (size_t)((l * 2 + dir) * 16) * 256 + n;
    float v[8];
#pragma unroll
    for (int j = 0; j < 8; ++j) v[j] = 0.f;
#pragma unroll
    for (int r = 0; r < 16; ++r) { const float uv = up[r * 256]; const f32x4 a = *(const LAS f32x4*)(WL + r * 1028 + k8 * 8), b2 = *(const LAS f32x4*)(WL + r * 1028 + k8 * 8 + 4);
#pragma unroll
        for (int j = 0; j < 4; ++j) { v[j] += a[j] * uv; v[4 + j] += b2[j] * uv; } }
    *(u32x4*)((bf16_t*)(F.ws + WS_WMIX) + ((size_t)l * NMIX + 3584 + 256 * dir + n) * D + k8 * 8) = epi::pack8(v);
}
__device__ __forceinline__ void mod_stage(Frame& F) {
    LAS float* cond = (LAS float*)F.lds;
    __syncthreads();
    for (int u = F.tid; u < 5 * 1024; u += NTHREADS) { const int b = u >> 10, k = u & 1023; const float c = b < 4 ? F.ap->in[I_C][b * 1024 + k] : F.ap->in[I_CCTX][k]; cond[u] = fsilu(c); }
    __syncthreads();
}
__device__ __forceinline__ void mod_block(Frame& F, const int blk) {
    const LAS float* cond = (const LAS float*)F.lds; LAS float* red = (LAS float*)F.lds + 5 * 1024;
    float* modacc = (float*)(F.ctl + CW_MOD);
    const int l = blk >> 8, col0 = (blk & 255) * 24;
    if (F.tid < 384) { const int cj = F.tid % 24, ks = F.tid / 24;
        const float* w = F.ap->in[I_ADAW] + (size_t)l * D * 6144 + (size_t)(ks * 64) * 6144 + col0 + cj; float a[5] = {0.f, 0.f, 0.f, 0.f, 0.f};
        float wv[64];
#pragma unroll
        for (int k = 0; k < 64; ++k) wv[k] = __builtin_nontemporal_load(w + (size_t)k * 6144);
#pragma unroll
        for (int k = 0; k < 64; ++k)
#pragma unroll
            for (int b = 0; b < 5; ++b) a[b] += cond[b * 1024 + ks * 64 + k] * wv[k];
#pragma unroll
        for (int b = 0; b < 5; ++b) red[(ks * 24 + cj) * 5 + b] = a[b]; }
    __syncthreads();
    if (F.tid < 120) { const int cj = F.tid % 24, b = F.tid / 24; float sacc = 0.f;
#pragma unroll
        for (int ks = 0; ks < 16; ++ks) sacc += red[(ks * 24 + cj) * 5 + b];
        modacc[(l * 5 + b) * 6144 + col0 + cj] = sacc; }
    __syncthreads();
}
template <int SET>
__device__ __forceinline__ void bg_wgtasks(Frame& F) {
    volatile LAS unsigned* slot = (volatile LAS unsigned*)(F.lds + LDS_MISC + 64);
    constexpr int NT = SET == 0 ? 256 : 256 + 128;
    bool staged = false;
    for (;;) {
        __syncthreads();
        if (F.tid == 0) slot[0] = __hip_atomic_fetch_add(F.ctl + CW_WQ + 64 * (9 + SET), 1u, __ATOMIC_RELAXED, __HIP_MEMORY_SCOPE_AGENT);
        __syncthreads();
        const int t = (int)slot[0]; if (t >= NT) break;
        if (SET == 0) s5_table_item(F, 256 + t);
        else if (t < 256) { if (!staged) { mod_stage(F); staged = true; } mod_block(F, 256 + t); }
        else weff_block(F, 128 + (t - 256));
        if (SET == 1 && t >= 256) staged = false;
    }
    __syncthreads();
}

__device__ __forceinline__ void phase_pre2(Frame& F) {
    { const int gw = F.c * 8 + F.wave, NGW = F.G * 8; LAS float* scr = (LAS float*)(F.lds + F.wave * 16384); float ra[32];
        for (int it = gw; it < 2304; it += NGW) { const ConvItem m = small_item(F, 0, it); tr_load(m.W, m.ldw, m.scol, m.k0, F.lane, ra); tr_store(ra, m.WT, m.ldo, m.drow, m.k0, scr, F.lane); } }
    __syncthreads();
    for (int blk = F.c; blk < 128; blk += F.G) weff_block(F, blk);
    s5_tables(F, 0, 256);
}
__device__ __forceinline__ void phase_pre(Frame& F) {
    const size_t gt = (size_t)F.c * NTHREADS + F.tid, NT = (size_t)F.G * NTHREADS;
    mod_stage(F);
    for (int blk = F.c; blk < 256; blk += F.G) mod_block(F, blk);
    if (F.c == 0) { float* lbp = (float*)(F.ctl + CW_LB);
        for (int ch = F.tid; ch < 512; ch += NTHREADS) { const float l0 = F.ap->in[I_LBL][ch], l1 = F.ap->in[I_LBL][512 + ch];
            lbp[ch] = 0.f; lbp[1024 + ch] = 1.0f;
            lbp[512 + ch] = fsigmoid(l1 - l0); lbp[1024 + 512 + ch] = fsigmoid(l0 - l1); } }
    { float* PT = (float*)(F.ctl + CW_POS);
        for (size_t t = gt; t < (size_t)64 * 512; t += NT) { const int pp = (int)(t >> 9), q = (int)(t & 511), i = q & 255; const float om = exp2f(-(float)i * (13.287712379549449f / 256.0f)), a = (float)pp * om; PT[t] = q < 256 ? sinf(a) : cosf(a); } }
}

constexpr int RT_OFF = 5 * 2048 * 4, RT_SLOTS = 16, RW_OFF = 49152;
__device__ __forceinline__ void route_write(Frame& F, int tok, int i1, int i2, int rk1, int rk2, float w1, float w2) {
    int* te = (int*)(F.ctl + CW_TOKE); int* tr = (int*)(F.ctl + CW_TOKR); float* tw = (float*)(F.ctl + CW_TOKW);
    te[tok * 2] = i1; te[tok * 2 + 1] = i2; tr[tok * 2] = rk1; tr[tok * 2 + 1] = rk2; tw[tok * 2] = w1; tw[tok * 2 + 1] = w2;
    int* pm2 = (int*)(F.ctl + CW_PERM2); pm2[i1 * 16384 + rk1] = tok; pm2[i2 * 16384 + rk2] = tok;
}
template <int MODE>
__device__ __forceinline__ void norm_load(Frame& F, int row, f32x4 (&v)[4]) {
    const int lane = F.lane; const bf16_t* XW = (const bf16_t*)(F.ws + WS_XW);
    if (MODE == 0) {
        if (row < MCTX) {
#pragma unroll
            for (int j = 0; j < 4; ++j) v[j] = __builtin_nontemporal_load((const f32x4*)(F.ap->in[I_CTX] + (size_t)row * D + 4 * lane + 256 * j));
        } else { const int rl = row - MCTX;
#pragma unroll
            for (int j = 0; j < 4; ++j) v[j] = __builtin_nontemporal_load((const f32x4*)(F.ap->in[I_X] + (size_t)rl * D + 4 * lane + 256 * j)); }
    } else {
#pragma unroll
        for (int j = 0; j < 4; ++j) v[j] = xw_ld4(XW + (size_t)row * D + 4 * lane + 256 * j);
    }
}
template <int MODE>
__device__ __forceinline__ void norm_finish(Frame& F, int row, f32x4 (&v)[4], const int slot = -1) {
    const int bidx = row < MCTX ? 4 : ((row - MCTX) >> 12); const LAS float* GA = (const LAS float*)F.lds + bidx * 2048;
    bf16_t* XW = (bf16_t*)(F.ws + WS_XW); bf16_t* H = (bf16_t*)(F.ws + WS_H);
    const int lane = F.lane;
    if (MODE == 0) {
        if (row >= MCTX) { const int rl = row - MCTX, t = rl & 4095; const float* PT = (const float*)(F.ctl + CW_POS);
#pragma unroll
            for (int j = 0; j < 4; ++j) v[j] = v[j] + *(const f32x4*)(PT + ((j < 2 ? (t >> 6) : (t & 63)) * 512 + (j & 1) * 256 + 4 * lane)); }
#pragma unroll
        for (int j = 0; j < 4; ++j) xw_st4(XW + (size_t)row * D + 4 * lane + 256 * j, v[j]);
    }
    float ss = 0.f;
#pragma unroll
    for (int j = 0; j < 4; ++j) ss += (v[j][0] * v[j][0] + v[j][1] * v[j][1]) + (v[j][2] * v[j][2] + v[j][3] * v[j][3]);
    const float rstd = 1.0f / sqrtf(wave_sum(ss) * (1.0f / D) + EPS);
    float lg[8];
#pragma unroll
    for (int e = 0; e < 8; ++e) lg[e] = 0.f;
#pragma unroll
    for (int j = 0; j < 4; ++j) { const int d0 = 4 * lane + 256 * j;
        const f32x4 h = (v[j] * rstd) * *(const LAS f32x4*)(GA + d0) + *(const LAS f32x4*)(GA + 1024 + d0);
        u32x2 w; w.x = pk2(h[0], h[1]); w.y = pk2(h[2], h[3]);
        *(u32x2*)(H + (size_t)row * D + d0) = w;
        if (MODE == 2) {
#pragma unroll
            for (int e = 0; e < 4; ++e) { const LAS float* rp = (const LAS float*)(F.lds + RW_OFF) + (lane + 64 * j) * 36 + e * 8; const f32x4 r0v = *(const LAS f32x4*)rp, r1v = *(const LAS f32x4*)(rp + 4);
                lg[0] += h[e] * r0v[0]; lg[1] += h[e] * r0v[1]; lg[2] += h[e] * r0v[2]; lg[3] += h[e] * r0v[3]; lg[4] += h[e] * r1v[0]; lg[5] += h[e] * r1v[1]; lg[6] += h[e] * r1v[2]; lg[7] += h[e] * r1v[3]; } }
    }
    if (MODE == 2) {
#pragma unroll
        for (int e = 0; e < 8; ++e) lg[e] = wave_sum(lg[e]);
        if (lane == 0) {
            int i1 = 0; float m1 = lg[0];
#pragma unroll
            for (int e = 1; e < 8; ++e) if (lg[e] > m1) { m1 = lg[e]; i1 = e; }
            int i2 = -1; float m2 = -3.0e38f;
#pragma unroll
            for (int e = 0; e < 8; ++e) if (e != i1 && lg[e] > m2) { m2 = lg[e]; i2 = e; }
            const float w1 = 1.0f / (1.0f + __expf(m2 - m1)), w2 = 1.0f - w1;
            const int tok = row - MCTX;
            if (slot >= 0) {
                LAS unsigned* lc = (LAS unsigned*)(F.lds + RT_OFF);
                const unsigned l1 = __hip_atomic_fetch_add(lc + i1, 1u, __ATOMIC_RELAXED, __HIP_MEMORY_SCOPE_WORKGROUP), l2 = __hip_atomic_fetch_add(lc + i2, 1u, __ATOMIC_RELAXED, __HIP_MEMORY_SCOPE_WORKGROUP);
                LAS int* ent = (LAS int*)(F.lds + RT_OFF + 128) + (F.wave * RT_SLOTS + slot) * 8;
                ent[0] = tok; ent[1] = i1; ent[2] = i2; ent[3] = (int)l1; ent[4] = (int)l2; ent[5] = __float_as_int(w1); ent[6] = __float_as_int(w2);
            } else {
                const int rk1 = (int)atomicAdd(F.ctl + CW_MOECNT + 64 * i1, 1u), rk2 = (int)atomicAdd(F.ctl + CW_MOECNT + 64 * i2, 1u);
                route_write(F, tok, i1, i2, rk1, rk2, w1, w2); }
        }
    }
}
template <int MODE>
__device__ __forceinline__ void norm_rows(Frame& F, int l, int moff  , const float* gain) {
    const float* modacc = (const float*)(F.ctl + CW_MOD) + (size_t)l * 5 * 6144; const float* adab = F.ap->in[I_ADAB] + (size_t)l * 6144;
    LAS float* GA = (LAS float*)F.lds;
    for (int u = F.tid; u < 5 * 1024; u += NTHREADS) { const int b = u >> 10, dd = u & 1023;
        const float sh = modacc[b * 6144 + moff + dd] + adab[moff + dd], sc = modacc[b * 6144 + moff + 1024 + dd] + adab[moff + 1024 + dd];
        GA[b * 2048 + dd] = gain[dd] * (sc + 1.0f); GA[b * 2048 + 1024 + dd] = sh; }
    const int gw = F.c * 8 + F.wave, NGW = F.G * 8;
    const int r0 = MODE == 2 ? MCTX : 0;
    const bool agg = MODE == 2 && (MLAT + NGW - 1) / NGW <= RT_SLOTS;
    if (MODE == 2 && F.tid < 16) ((LAS unsigned*)(F.lds + RT_OFF))[F.tid] = 0u;
    if (MODE == 2) { LAS float* RWL = (LAS float*)(F.lds + RW_OFF); for (int u = F.tid; u < 8192; u += NTHREADS) { const int d = u >> 3; RWL[(d >> 2) * 36 + (d & 3) * 8 + (u & 7)] = F.ap->in[I_RW][u]; } }
    __syncthreads();
    for (int row = r0 + gw; row < M; row += 2 * NGW) {
        const int rowB = row + NGW; const bool hasB = rowB < M;
        f32x4 va[4], vb[4];
        norm_load<MODE>(F, row, va);
        if (hasB) norm_load<MODE>(F, rowB, vb);
        const int slot = agg ? (row - r0 - gw) / NGW : -1;
        norm_finish<MODE>(F, row, va, slot);
        if (hasB) norm_finish<MODE>(F, rowB, vb, agg ? slot + 1 : -1);
    }
    __syncthreads();
    if (MODE == 2 && agg) {
        LAS unsigned* lc = (LAS unsigned*)(F.lds + RT_OFF);
        if (F.tid < 8) lc[8 + F.tid] = lc[F.tid] ? atomicAdd(F.ctl + CW_MOECNT + 64 * F.tid, lc[F.tid]) : 0u;
        __syncthreads();
        if (F.tid < 8 * RT_SLOTS) { const int w = F.tid / RT_SLOTS, k = F.tid % RT_SLOTS;
            if (F.c * 8 + w + k * NGW < MLAT) { const LAS int* ent = (const LAS int*)(F.lds + RT_OFF + 128) + F.tid * 8;
                const int i1 = ent[1], i2 = ent[2];
                route_write(F, ent[0], i1, i2, (int)lc[8 + i1] + ent[3], (int)lc[8 + i2] + ent[4], __int_as_float(ent[5]), __int_as_float(ent[6])); } }
        __syncthreads();
    }
}

struct MoeSeg { int cnt[NE], tstart[NE + 1]; };
__device__ __forceinline__ void moe_seg(Frame& F, MoeSeg& s) {
    int acc = 0;
#pragma unroll
    for (int e = 0; e < NE; ++e) { const int c = (int)__hip_atomic_load(F.ctl + CW_MOECNT + 64 * e, __ATOMIC_RELAXED, __HIP_MEMORY_SCOPE_AGENT); s.cnt[e] = c; s.tstart[e] = acc; acc += (c + 255) >> 8; }
    s.tstart[NE] = acc;
}
__device__ __forceinline__ void moe_scatter(Frame& F) {
    MoeSeg s; moe_seg(F, s);
    const int* te = (const int*)(F.ctl + CW_TOKE); const int* tr = (const int*)(F.ctl + CW_TOKR); int* perm = (int*)(F.ctl + CW_PERM);
    for (int t = F.c * NTHREADS + F.tid; t < 2 * MLAT; t += F.G * NTHREADS) { const int e = te[t], rk = tr[t]; int ts = 0;
#pragma unroll
        for (int k = 0; k < NE; ++k) ts = (e == k) ? s.tstart[k] : ts;
        perm[ts * 256 + rk] = t >> 1; }
}
struct MoeItem { const float* W; bf16_t* WT; int ldw, scol, K, drow, k0; };
__device__ __forceinline__ MoeItem moe_item(Frame& F, int it) {
    const int job = it / 1792, loc = it % 1792, e = job / 2, mat = job % 2; MoeItem m;
    if (mat < 2) { const int nb = loc % 112, kb = loc / 112, n0 = nb * 32; m.W = F.ap->in[mat == 0 ? I_MW1 : I_MW3] + (size_t)e * D * FFN; m.ldw = FFN; m.scol = n0; m.K = D; m.k0 = kb * 64;
        m.WT = (bf16_t*)(F.ws + WS_MW13) + (size_t)e * 7168 * D; m.drow = (n0 >> 7) * 256 + (n0 & 127) + (mat == 0 ? 0 : 128); }
    else { const int nb = loc % 32, kb = loc / 32; m.W = F.ap->in[I_MW2] + (size_t)e * FFN * D; m.ldw = D; m.scol = nb * 32; m.K = FFN; m.k0 = kb * 64; m.WT = (bf16_t*)(F.ws + WS_MW2) + (size_t)e * D * FFN; m.drow = nb * 32; }
    return m;
}
__device__ __forceinline__ void moe_convert(Frame& F, const int pmode = 0) {
    const int gw = F.c * 8 + F.wave, NGW = F.G * 8, nitems = NE * 2 * 1792;
    LAS float* scr = (LAS float*)(F.lds + F.wave * 16384);
    f32x4 ra[8], rb[8], rc[8];
    if (pmode & 1) { for (int i = 0; i < 8; ++i) { ra[i] = (f32x4){1.f, 2.f, 3.f, 4.f}; rb[i] = ra[i]; rc[i] = ra[i]; } }
    if (pmode & 4) return;
    int it = gw;
#define MC_LOAD(buf, i) do { if ((i) < nitems && !(pmode & 1)) { const MoeItem m_ = moe_item(F, (i)); tr_load4(m_.W, m_.ldw, m_.scol, m_.k0, F.lane, buf); } } while (0)
#define MC_STORE(buf, i) do { const MoeItem m_ = moe_item(F, (i)); if (!(pmode & 2)) tr_store4(buf, m_.WT, m_.K, m_.drow, m_.k0, scr, F.lane); else if (buf[0][0] == 1.2345e-30f) m_.WT[0] = (bf16_t)1; } while (0)
    MC_LOAD(ra, it); MC_LOAD(rb, it + NGW);
    while (it < nitems) {
        MC_LOAD(rc, it + 2 * NGW); MC_STORE(ra, it); it += NGW; if (it >= nitems) break;
        MC_LOAD(ra, it + 2 * NGW); MC_STORE(rb, it); it += NGW; if (it >= nitems) break;
        MC_LOAD(rb, it + 2 * NGW); MC_STORE(rc, it); it += NGW;
    }
#undef MC_LOAD
#undef MC_STORE
    __syncthreads();
}
__device__ __forceinline__ void phase_final(Frame& F) {
    MoeSeg s; moe_seg(F, s);
    const bf16_t* XW = (const bf16_t*)(F.ws + WS_XW); const bf16_t* SL = (const bf16_t*)(F.ws + WS_SLAB);
    const float* modacc = (const float*)(F.ctl + CW_MOD) + (size_t)1 * 5 * 6144; const float* adab = F.ap->in[I_ADAB] + (size_t)1 * 6144;
    const int* te = (const int*)(F.ctl + CW_TOKE); const int* tr = (const int*)(F.ctl + CW_TOKR); const float* tw = (const float*)(F.ctl + CW_TOKW);
    const int gw = F.c * 8 + F.wave, NGW = F.G * 8, lane = F.lane;
    for (int tok = gw; tok < MLAT; tok += NGW) {
        const int row = MCTX + tok, bidx = tok >> 12; int pos[2];
#pragma unroll
        for (int sl = 0; sl < 2; ++sl) { const int e = __hip_atomic_load(te + tok * 2 + sl, __ATOMIC_RELAXED, __HIP_MEMORY_SCOPE_AGENT); int ts = 0;
#pragma unroll
            for (int k = 0; k < NE; ++k) ts = (e == k) ? s.tstart[k] : ts;
            pos[sl] = ts * 256 + __hip_atomic_load(tr + tok * 2 + sl, __ATOMIC_RELAXED, __HIP_MEMORY_SCOPE_AGENT); }
        const float w0 = __hip_atomic_load(tw + tok * 2, __ATOMIC_RELAXED, __HIP_MEMORY_SCOPE_AGENT), w1 = __hip_atomic_load(tw + tok * 2 + 1, __ATOMIC_RELAXED, __HIP_MEMORY_SCOPE_AGENT);
        f32x4 v[4]; float ss = 0.f;
#pragma unroll
        for (int j = 0; j < 4; ++j) { const int d0 = 4 * lane + 256 * j;
            const f32x4 g2 = *(const f32x4*)(modacc + bidx * 6144 + 5120 + d0) + *(const f32x4*)(adab + 5120 + d0);
            const u32x2 a = __builtin_nontemporal_load((const u32x2*)(SL + (size_t)pos[0] * D + d0)), b = __builtin_nontemporal_load((const u32x2*)(SL + (size_t)pos[1] * D + d0));
            f32x4 fa, fb; fa[0] = __uint_as_float(a.x << 16); fa[1] = __uint_as_float(a.x & 0xffff0000u); fa[2] = __uint_as_float(a.y << 16); fa[3] = __uint_as_float(a.y & 0xffff0000u);
            fb[0] = __uint_as_float(b.x << 16); fb[1] = __uint_as_float(b.x & 0xffff0000u); fb[2] = __uint_as_float(b.y << 16); fb[3] = __uint_as_float(b.y & 0xffff0000u);
            v[j] = xw_ld4<true>(XW + (size_t)row * D + d0) + g2 * (fa * w0 + fb * w1);
            ss += (v[j][0] * v[j][0] + v[j][1] * v[j][1]) + (v[j][2] * v[j][2] + v[j][3] * v[j][3]); }
        const float rstd = 1.0f / sqrtf(wave_sum(ss) * (1.0f / D) + EPS);
#pragma unroll
        for (int j = 0; j < 4; ++j) { const int d0 = 4 * lane + 256 * j; __builtin_nontemporal_store((v[j] * rstd) * *(const f32x4*)(F.ap->in[I_FNG] + d0), (f32x4*)(F.ap->out + (size_t)tok * D + d0)); }
    }
}
constexpr int ML_QA = 0, ML_KA = 8704, ML_KBX = 17408, ML_KT = 21760, ML_VT = 32000, ML_AS = 42240, ML_PS = 44800, ML_EL = 46848, ML_E15 = 47360, ML_FLAG = 47872, ML_BC = 47888, ML_STG = 65296, ML_OS = 90896;
static_assert(ML_OS + 65536 <= LDS_MISC, "mixer LDS");


template <int NV> __device__ __forceinline__ void bfly_step(float (&a)[32], int lane, int xb) {
    const bool hi = (lane & xb) != 0;
#pragma unroll
    for (int i = 0; i < NV / 2; ++i) { const float keep = hi ? a[NV / 2 + i] : a[i], send = hi ? a[i] : a[NV / 2 + i]; a[i] = keep + __shfl_xor(send, xb); }
}

__device__ __forceinline__ int sc_row(int r0, int n, int dir) { return dir == 0 ? r0 + n : r0 + 255 - n; }

template <int DK, bool HG, bool OUT> struct Stg {
    static constexpr int KOFF = DK, VOFF = HG ? DK : 2 * DK, QOFF = VOFF + 128, SW = OUT ? QOFF + DK : QOFF, SWP = SW, NPC = SW / 8, NLD = (32 * NPC + NTHREADS - 1) / NTHREADS;
};
template <int DK, bool HG, bool OUT> struct ChunkIn { int unused; };
template <int DK, bool HG, bool OUT>
__device__ __forceinline__ void gla_load(Frame& F, const bf16_t* P, int r0, int c, int dir, int qcol, int gcol, int kcol, int vcol, ChunkIn<DK, HG, OUT>&) {
    typedef Stg<DK, HG, OUT> G;
#pragma unroll
    for (int j = 0; j < G::NLD; ++j) { const int pid = F.tid + NTHREADS * j;
        if (G::NLD * NTHREADS == 32 * G::NPC || F.wave * 64 + NTHREADS * j < 32 * G::NPC) {
            const int tau = pid / G::NPC, c8 = (pid % G::NPC) * 8;
            const int col = c8 < DK ? gcol + c8 : ((!HG && c8 < G::VOFF) ? kcol + c8 - G::KOFF : (c8 < G::QOFF ? vcol + c8 - G::VOFF : qcol + c8 - G::QOFF));
            __builtin_amdgcn_global_load_lds((const unsigned*)(P + (size_t)sc_row(r0, 32 * c + tau, dir) * LDP + col), (LAS unsigned*)(F.lds + ML_STG + (F.wave * 64 + NTHREADS * j) * 16), 16, 0, OUT ? 2 : 0); } }
}
template <int DK, bool HG, bool OUT>
__device__ __forceinline__ void gla_stage(Frame& F, const ChunkIn<DK, HG, OUT>&) { asm volatile("s_waitcnt vmcnt(0)" ::: "memory"); }
template <int DK, bool HG, bool OUT, int VAR = 0>
__device__ __forceinline__ void gla_chunk(Frame& F, const bf16_t* P, ChunkIn<DK, HG, OUT>& N, bool have_next, int nr0, int nc, int ndir, int c, int dir, int qcol, int gcolf, int gcolb, int kcol, int vcol,
                                          f32x4 (&S)[DK / 16], float& gtot) {
    typedef Stg<DK, HG, OUT> G;
    LAS unsigned char* lds = F.lds;
    LAS float* BC = (LAS float*)(lds + ML_BC); LAS bf16_t* QA = (LAS bf16_t*)(lds + ML_QA); LAS bf16_t* KA = (LAS bf16_t*)(lds + ML_KA); LAS bf16_t* KBX = (LAS bf16_t*)(lds + ML_KBX); LAS bf16_t* STG = (LAS bf16_t*)(lds + ML_STG);
    LAS float* E15 = (LAS float*)(lds + ML_E15); volatile LAS unsigned* FLAG = (volatile LAS unsigned*)(lds + ML_FLAG);
    LAS unsigned char* KT = lds + ML_KT; LAS unsigned char* VT = lds + ML_VT; LAS unsigned char* AS = lds + ML_AS; LAS float* PS = (LAS float*)(lds + ML_PS); LAS float* EL = (LAS float*)(lds + ML_EL);
    LAS bf16_t* OS = (LAS bf16_t*)(lds + ML_OS);
    constexpr int NT = DK / 16, NPART = NTHREADS / DK, HS = DK + 8;
    const int tid = F.tid, lane = F.lane, w = F.wave;
    const int d = tid & (DK - 1), part = tid / DK, t0 = part * NT;
    float cs[NT], gg[NT], qq[NT], kk[NT];
    float off = 0.f, tot = 0.f, ref15 = 0.f;
    if (VAR != 4) {
#pragma unroll
        for (int pp = 0; pp < NPART; ++pp) { float ps = 0.f;
#pragma unroll
            for (int i = 0; i < NT; ++i) ps += bf2f(STG[(pp * NT + i) * G::SWP + d]);
            tot += ps; off += (pp < part) ? ps : 0.f; if (pp * NT < 16) ref15 += ps; }
        float run = 0.f;
#pragma unroll
        for (int i = 0; i < NT; ++i) { const LAS bf16_t* rp = STG + (t0 + i) * G::SWP;
            gg[i] = bf2f(rp[d]); if (OUT) qq[i] = bf2f(rp[G::QOFF + d]); if (!HG) kk[i] = bf2f(rp[G::KOFF + d]);
            run += gg[i]; cs[i] = run; }
        if (OUT && tid == 0) FLAG[(c + 1) & 1] = 0u;
        const int v = tid & 127, pv = tid >> 7; unsigned short vb[8];
#pragma unroll
        for (int i = 0; i < 8; ++i) vb[i] = STG[(8 * pv + i) * G::SWP + G::VOFF + v];
        u32x4 wv; wv.x = vb[0] | ((unsigned)vb[1] << 16); wv.y = vb[2] | ((unsigned)vb[3] << 16); wv.z = vb[4] | ((unsigned)vb[5] << 16); wv.w = vb[6] | ((unsigned)vb[7] << 16);
        *(LAS u32x4*)(VT + v * 80 + pv * 16) = wv;
    }
    float bcv[NT], kq[NT];
    if (VAR < 4) {
        float kh[NT];
        bool big = false;
        const float c0 = __expf(tot), c1 = __expf(tot - ref15), e15 = __expf(ref15);
        float qa[NT], ka[NT], kx[NT];
#pragma unroll
        for (int i = 0; i < NT; ++i) { const float bc = off + cs[i], f = __expf(gg[i]), k = HG ? 1.0f - f : kk[i]; const int tau = t0 + i; bcv[i] = bc; kq[i] = k;
            const bool hi = tau >= 16; const float X = (hi ? ref15 : 0.f) - bc;
            const float eX = __expf(fminf(X, 80.f)); ka[i] = k * eX;
            big |= X > 80.f;
            if (OUT && VAR < 2) { qa[i] = qq[i] * __builtin_amdgcn_rcpf(eX); kx[i] = ka[i] * e15; }
            kh[i] = ka[i] * (hi ? c1 : c0); }
        if (big) {
#pragma unroll
            for (int i = 0; i < NT; ++i) kh[i] = kq[i] * __expf(tot - bcv[i]); }
        if (OUT && VAR < 2) {
#pragma unroll
            for (int i = 0; i < NT; i += 2) { const int tau = t0 + i; const unsigned wq = pk2(qa[i], qa[i + 1]), wk2 = pk2(ka[i], ka[i + 1]);
                QA[tau * HS + d] = (bf16_t)(wq & 0xffffu); QA[(tau + 1) * HS + d] = (bf16_t)(wq >> 16); KA[tau * HS + d] = (bf16_t)(wk2 & 0xffffu); KA[(tau + 1) * HS + d] = (bf16_t)(wk2 >> 16);
                if (tau < 16) { const unsigned wx = pk2(kx[i], kx[i + 1]); KBX[tau * HS + d] = (bf16_t)(wx & 0xffffu); KBX[(tau + 1) * HS + d] = (bf16_t)(wx >> 16); } } }
        if (NT == 8) { u32x4 wk; wk.x = pk2(kh[0], kh[1]); wk.y = pk2(kh[2], kh[3]); wk.z = pk2(kh[4 % NT], kh[5 % NT]); wk.w = pk2(kh[6 % NT], kh[7 % NT]); *(LAS u32x4*)(KT + d * 80 + t0 * 2) = wk; }
        else { u32x2 wk; wk.x = pk2(kh[0], kh[1]); wk.y = pk2(kh[2], kh[3]); *(LAS u32x2*)(KT + d * 80 + t0 * 2) = wk; }
        if (OUT && big) FLAG[c & 1] = 1u;
        if (OUT && part == 0) E15[d] = __expf(ref15);
        if (part == 0) { EL[d] = __expf(tot); gtot += tot; }
    }
    __syncthreads();
    bool slow = false;
    if (OUT) slow = __builtin_amdgcn_readfirstlane((int)FLAG[c & 1]) != 0;
    if (OUT && slow) {
#pragma unroll
        for (int i = 0; i < NT; ++i) { const int tau = t0 + i; BC[tau * HS + d] = bcv[i] * 1.4426950408889634f; }
        __syncthreads();
        const int g4 = lane >> 4, r = lane & 15;
        for (int job = w; job < 11; job += 8) {
            const int lvl = job == 0 ? 4 : 3 - ((job - 1) >> 1), tt = job == 0 ? 1 : ((job - 1) & 1), ss = job == 0 ? 0 : tt;
            const int t = 16 * tt + r, sx = 16 * ss + r;
            bool va = true, vb = true; int reft = t, refs = sx;
            if (lvl >= 0) { const int bsz = 2 << lvl, hb = 1 << lvl; va = ((t >> lvl) & 1) != 0; vb = ((sx >> lvl) & 1) == 0; reft = (t & ~(bsz - 1)) + hb - 1; refs = (sx & ~(bsz - 1)) + hb - 1; }
            f32x4 acc = (f32x4){0.f, 0.f, 0.f, 0.f};
#pragma unroll
            for (int kk2 = 0; kk2 < DK / 32; ++kk2) { const int d0 = 32 * kk2 + 8 * g4;
                float qv[8], kv[8]; epi::unpack8(*(const LAS u32x4*)(STG + t * G::SWP + G::QOFF + d0), qv);
                if (HG) { epi::unpack8(*(const LAS u32x4*)(STG + sx * G::SWP + d0), kv);
#pragma unroll
                    for (int j = 0; j < 8; ++j) kv[j] = 1.0f - __expf(kv[j]); }
                else epi::unpack8(*(const LAS u32x4*)(STG + sx * G::SWP + G::KOFF + d0), kv);
                if (lvl >= 0) {
                    const f32x4 bt0 = *(const LAS f32x4*)(BC + t * HS + d0), bt1 = *(const LAS f32x4*)(BC + t * HS + d0 + 4), br0 = *(const LAS f32x4*)(BC + reft * HS + d0), br1 = *(const LAS f32x4*)(BC + reft * HS + d0 + 4);
                    const f32x4 bs0 = *(const LAS f32x4*)(BC + sx * HS + d0), bs1 = *(const LAS f32x4*)(BC + sx * HS + d0 + 4), bq0 = *(const LAS f32x4*)(BC + refs * HS + d0), bq1 = *(const LAS f32x4*)(BC + refs * HS + d0 + 4);
#pragma unroll
                    for (int j = 0; j < 4; ++j) { qv[j] = va ? qv[j] * __builtin_amdgcn_exp2f(bt0[j] - br0[j]) : 0.f; qv[4 + j] = va ? qv[4 + j] * __builtin_amdgcn_exp2f(bt1[j] - br1[j]) : 0.f;
                        kv[j] = vb ? kv[j] * __builtin_amdgcn_exp2f(bq0[j] - bs0[j]) : 0.f; kv[4 + j] = vb ? kv[4 + j] * __builtin_amdgcn_exp2f(bq1[j] - bs1[j]) : 0.f; }
                }
                const u32x4 af = epi::pack8(qv), bf = epi::pack8(kv);
                acc = __builtin_amdgcn_mfma_f32_16x16x32_bf16(__builtin_bit_cast(bf16x8, af), __builtin_bit_cast(bf16x8, bf), acc, 0, 0, 0);
            }
#pragma unroll
            for (int i = 0; i < 4; ++i) { const int to = 16 * tt + 4 * g4 + i, so = 16 * ss + r;
                bool valid; if (lvl >= 0) valid = (((to ^ so) >> (lvl + 1)) == 0) && (((to >> lvl) & 1) != 0) && (((so >> lvl) & 1) == 0); else valid = (to == so);
                if (valid) *(LAS bf16_t*)(AS + to * 80 + so * 2) = (bf16_t)f2bf(acc[i]);
                else if (lvl < 0 && so > to) *(LAS bf16_t*)(AS + to * 80 + so * 2) = (bf16_t)0;
                if (job == 0) *(LAS bf16_t*)(AS + (4 * g4 + i) * 80 + (16 + r) * 2) = (bf16_t)0;
            }
        }
        __syncthreads();
    }
    if (have_next && VAR < 4) gla_load<DK, HG, OUT>(F, P, nr0, nc, ndir, qcol, ndir == 0 ? gcolf : gcolb, kcol, vcol, N);
    {
        const int g4 = lane >> 4, r = lane & 15;
        const bf16x8 bV = *(const LAS bf16x8*)(VT + (16 * w + r) * 80 + g4 * 16);
        if (OUT && VAR < 1) {
            f32x4 o[2];
            if (!slow) {
                f32x4 t00 = (f32x4){0.f, 0.f, 0.f, 0.f}, t01 = t00, t11 = t00;
#pragma unroll
                for (int kk2 = 0; kk2 < DK / 32; ++kk2) { const int d0 = 32 * kk2 + 8 * g4;
                    const bf16x8 q0 = *(const LAS bf16x8*)(QA + r * HS + d0), q1 = *(const LAS bf16x8*)(QA + (16 + r) * HS + d0);
                    const bf16x8 k0 = *(const LAS bf16x8*)(KA + r * HS + d0), k1 = *(const LAS bf16x8*)(KA + (16 + r) * HS + d0), kx = *(const LAS bf16x8*)(KBX + r * HS + d0);
                    t00 = __builtin_amdgcn_mfma_f32_16x16x32_bf16(k0, q0, t00, 0, 0, 0); t01 = __builtin_amdgcn_mfma_f32_16x16x32_bf16(kx, q1, t01, 0, 0, 0); t11 = __builtin_amdgcn_mfma_f32_16x16x32_bf16(k1, q1, t11, 0, 0, 0); }
#pragma unroll
                for (int i = 0; i < 4; ++i) { const bool keep = (4 * g4 + i) <= r; t00[i] = keep ? t00[i] : 0.f; t11[i] = keep ? t11[i] : 0.f; }
                u32x4 a0, a1; a0.x = pk2(t00[0], t00[1]); a0.y = pk2(t00[2], t00[3]); a0.z = 0u; a0.w = 0u; a1.x = pk2(t01[0], t01[1]); a1.y = pk2(t01[2], t01[3]); a1.z = pk2(t11[0], t11[1]); a1.w = pk2(t11[2], t11[3]);
                const u32x2 vlo = *(const LAS u32x2*)(VT + (16 * w + r) * 80 + 8 * g4), vhi = *(const LAS u32x2*)(VT + (16 * w + r) * 80 + 32 + 8 * g4);
                u32x4 vp; vp.x = vlo.x; vp.y = vlo.y; vp.z = vhi.x; vp.w = vhi.y;
                o[0] = __builtin_amdgcn_mfma_f32_16x16x32_bf16(__builtin_bit_cast(bf16x8, a0), __builtin_bit_cast(bf16x8, vp), (f32x4){0.f, 0.f, 0.f, 0.f}, 0, 0, 0);
                o[1] = __builtin_amdgcn_mfma_f32_16x16x32_bf16(__builtin_bit_cast(bf16x8, a1), __builtin_bit_cast(bf16x8, vp), (f32x4){0.f, 0.f, 0.f, 0.f}, 0, 0, 0);
            } else {
#pragma unroll
                for (int tt = 0; tt < 2; ++tt) { const bf16x8 aS = *(const LAS bf16x8*)(AS + (16 * tt + r) * 80 + g4 * 16); o[tt] = __builtin_amdgcn_mfma_f32_16x16x32_bf16(aS, bV, (f32x4){0.f, 0.f, 0.f, 0.f}, 0, 0, 0); }
            }
#pragma unroll
            for (int kk2 = 0; kk2 < DK / 32; ++kk2) {
                const f32x4 e0 = *(const LAS f32x4*)(E15 + 32 * kk2 + 4 * g4), e1 = *(const LAS f32x4*)(E15 + 32 * kk2 + 16 + 4 * g4);
                u32x4 bs, bs2; bs.x = pk2(S[2 * kk2][0], S[2 * kk2][1]); bs.y = pk2(S[2 * kk2][2], S[2 * kk2][3]); bs.z = pk2(S[2 * kk2 + 1][0], S[2 * kk2 + 1][1]); bs.w = pk2(S[2 * kk2 + 1][2], S[2 * kk2 + 1][3]);
                bs2.x = pk2(S[2 * kk2][0] * e0[0], S[2 * kk2][1] * e0[1]); bs2.y = pk2(S[2 * kk2][2] * e0[2], S[2 * kk2][3] * e0[3]); bs2.z = pk2(S[2 * kk2 + 1][0] * e1[0], S[2 * kk2 + 1][1] * e1[1]); bs2.w = pk2(S[2 * kk2 + 1][2] * e1[2], S[2 * kk2 + 1][3] * e1[3]);
#pragma unroll
                for (int tt = 0; tt < 2; ++tt) { const u32x2 lo = *(const LAS u32x2*)(QA + (16 * tt + r) * HS + 32 * kk2 + 4 * g4), hi = *(const LAS u32x2*)(QA + (16 * tt + r) * HS + 32 * kk2 + 16 + 4 * g4);
                    u32x4 aq; aq.x = lo.x; aq.y = lo.y; aq.z = hi.x; aq.w = hi.y;
                    o[tt] = __builtin_amdgcn_mfma_f32_16x16x32_bf16(__builtin_bit_cast(bf16x8, aq), __builtin_bit_cast(bf16x8, tt == 0 ? bs : bs2), o[tt], 0, 0, 0); }
            }
#pragma unroll
            for (int tt = 0; tt < 2; ++tt)
#pragma unroll
                for (int i = 0; i < 4; ++i) { const int n = 32 * c + 16 * tt + 4 * g4 + i, nn = dir == 0 ? n : 255 - n; LAS bf16_t* op = OS + nn * 128 + 16 * w + r;
                    float val = o[tt][i]; if (dir == 1) val += bf2f(*op); *op = (bf16_t)f2bf(val); }
        }
#pragma unroll
        for (int dt = 0; dt < (VAR >= 3 ? 0 : DK / 16); ++dt) { const f32x4 el = *(const LAS f32x4*)(EL + 16 * dt + 4 * g4); const bf16x8 aK = *(const LAS bf16x8*)(KT + (16 * dt + r) * 80 + g4 * 16);
            S[dt] = __builtin_amdgcn_mfma_f32_16x16x32_bf16(aK, bV, S[dt] * el, 0, 0, 0); }
    }
    if (have_next && VAR < 4) gla_stage<DK, HG, OUT>(F, N);
    __syncthreads();
}

template <bool HG> struct MixCols {
    static __device__ __forceinline__ int q(int h) { return HG ? 128 * h : 2560 + 64 * h; }
    static __device__ __forceinline__ int g(int h, int dir) { return HG ? 512 + 512 * dir + 128 * h : 3584 + 256 * dir + 64 * h; }
    static __device__ __forceinline__ int k(int h) { return HG ? 0 : 2816 + 64 * h; }
    static __device__ __forceinline__ int v(int h) { return HG ? 1536 + 128 * h : 3072 + 128 * h; }
    static __device__ __forceinline__ int og(int h) { return HG ? 2048 + 128 * h : 4096 + 128 * h; }
};
__device__ __forceinline__ int sc_r0(int b, int sc) { return sc == 0 ? b * 256 : MCTX + b * 4096 + (sc - 1) * 256; }
__device__ __forceinline__ int sc_of_pos(int dir, int p) { return (dir == 0 || p == 0) ? p : 17 - p; }

template <int DK, bool HG>
__device__ __forceinline__ void gla_pass1_item(Frame& F, int b, int h, int dir, int p) {
    const bf16_t* P = (const bf16_t*)(F.ws + WS_P);
    constexpr int NDT = DK / 16, E = DK * 128;
    const int sc = sc_of_pos(dir, p), r0 = sc_r0(b, sc);
    bf16_t* ST = (bf16_t*)(F.ws + (HG ? WS_GST : WS_GST2)) + ((size_t)((b * 4 + h) * 2 + dir) * NSC + sc) * E;
    float* DEC = (float*)(F.ws + WS_GDEC) + (HG ? 0 : 4 * 4 * 2 * NSC * 128) + ((size_t)((b * 4 + h) * 2 + dir) * NSC + sc) * DK;
    f32x4 S[NDT];
#pragma unroll
    for (int i = 0; i < NDT; ++i) S[i] = (f32x4){0.f, 0.f, 0.f, 0.f};
    float gtot = 0.f;
    const int gcf = MixCols<HG>::g(h, 0), gcb = MixCols<HG>::g(h, 1), kc = MixCols<HG>::k(h), vc = MixCols<HG>::v(h);
    ChunkIn<DK, HG, false> N;
    gla_load<DK, HG, false>(F, P, r0, 0, dir, 0, dir == 0 ? gcf : gcb, kc, vc, N); gla_stage<DK, HG, false>(F, N); __syncthreads();
#ifdef PROBE_SPLIT
    const int pmode_ = F.ap->qsel >> 4;
    for (int c = 0; c < 8; ++c) gla_chunk<DK, HG, false>(F, P, N, c < 7 && !(pmode_ & 1), r0, c + 1, dir, c, dir, 0, gcf, gcb, kc, vc, S, gtot);
    if (pmode_ & 1) return;
#else
    for (int c = 0; c < 8; ++c) gla_chunk<DK, HG, false>(F, P, N, c < 7, r0, c + 1, dir, c, dir, 0, gcf, gcb, kc, vc, S, gtot);
#endif
#pragma unroll
    for (int dt = 0; dt < NDT; ++dt)
#pragma unroll
        for (int i = 0; i < 4; ++i) ST[((F.wave * NDT + dt) * 4 + i) * 64 + F.lane] = (bf16_t)f2bf(S[dt][i]);
    if (F.tid < DK) DEC[F.tid] = __expf(gtot);
}
template <int DK, bool HG, int VAR = 0>
__device__ __forceinline__ void gla_pass3_item(Frame& F, int l, int b, int h, int sc) {
    const bf16_t* P = (const bf16_t*)(F.ws + WS_P); bf16_t* Y = (bf16_t*)(F.ws + WS_Y);
    constexpr int NDT = DK / 16, E = DK * 128;
    const int r0 = sc_r0(b, sc);
    const int qc = MixCols<HG>::q(h), gcf = MixCols<HG>::g(h, 0), gcb = MixCols<HG>::g(h, 1), kc = MixCols<HG>::k(h), vc = MixCols<HG>::v(h);
    ChunkIn<DK, HG, true> N;
    if (F.tid == 0) { volatile LAS unsigned* FLAG = (volatile LAS unsigned*)(F.lds + ML_FLAG); FLAG[0] = 0u; FLAG[1] = 0u; }
    gla_load<DK, HG, true>(F, P, r0, 0, 0, qc, gcf, kc, vc, N); gla_stage<DK, HG, true>(F, N); __syncthreads();
    for (int dir = 0; dir < 2; ++dir) {
        const bf16_t* ST = (const bf16_t*)(F.ws + (HG ? WS_GST : WS_GST2)) + ((size_t)((b * 4 + h) * 2 + dir) * NSC + sc) * E;
        f32x4 S[NDT];
#pragma unroll
        for (int dt = 0; dt < NDT; ++dt)
#pragma unroll
            for (int i = 0; i < 4; ++i) S[dt][i] = bf2f(ST[((F.wave * NDT + dt) * 4 + i) * 64 + F.lane]);
        float gtot = 0.f;
        for (int c = 0; c < 8; ++c) { const bool hn = !(dir == 1 && c == 7); const int nc = c < 7 ? c + 1 : 0, nd = c < 7 ? dir : 1;
            gla_chunk<DK, HG, true, VAR>(F, P, N, hn, r0, nc, nd, c, dir, qc, gcf, gcb, kc, vc, S, gtot); }
    }
    {
        const LAS bf16_t* OS = (const LAS bf16_t*)(F.lds + ML_OS);
        const int n = F.tid >> 1, hf = F.tid & 1; float o[64]; float ss = 0.f;
#pragma unroll
        for (int j = 0; j < 8; ++j) { float t8[8]; epi::unpack8(*(const LAS u32x4*)(OS + n * 128 + hf * 64 + j * 8), t8);
#pragma unroll
            for (int e = 0; e < 8; ++e) { o[j * 8 + e] = t8[e]; ss += t8[e] * t8[e]; } }
        ss += __shfl_xor(ss, 1);
        const float rstd = 1.0f / sqrtf(ss * (1.0f / 128.0f) + EPS);
        const float* gain = F.ap->in[HG ? I_HGNG : I_GLNG] + l * 512 + h * 128 + hf * 64;
        const bf16_t* og = P + (size_t)(r0 + n) * LDP + MixCols<HG>::og(h) + hf * 64;
        bf16_t* yo = Y + (size_t)(r0 + n) * 1536 + (HG ? 0 : 512) + h * 128 + hf * 64;
#pragma unroll
        for (int j = 0; j < 8; ++j) { float gt[8], v[8]; epi::unpack8(*(const u32x4*)(og + j * 8), gt);
#pragma unroll
            for (int e = 0; e < 8; ++e) v[e] = o[j * 8 + e] * rstd * gain[j * 8 + e] * gt[e];
            *(u32x4*)(yo + j * 8) = epi::pack8(v); }
    }
    __syncthreads();
}
__device__ __forceinline__ void gla_carry(Frame& F) {
    const size_t gt = (size_t)F.c * NTHREADS + F.tid, NTT = (size_t)F.G * NTHREADS;
    constexpr size_t EH = 16384, EG = 8192, NH = 32 * EH, NGL = 32 * EG;
    for (size_t t = gt; t < NH + NGL; t += NTT) {
        const bool hg = t < NH; const size_t tt = hg ? t : t - NH; const int E = hg ? (int)EH : (int)EG, DK = hg ? 128 : 64, NDT = DK / 16;
        const int chain = (int)(tt / E), e = (int)(tt % E), dir = chain & 1;
        const int ln = e & 63, i = (e >> 6) & 3, dt = (e >> 8) % NDT, dd = 16 * dt + 4 * (ln >> 4) + i;
        bf16_t* ST = (bf16_t*)(F.ws + (hg ? WS_GST : WS_GST2)) + (size_t)chain * NSC * E + e;
        const float* DEC = (const float*)(F.ws + WS_GDEC) + (hg ? 0 : 4 * 4 * 2 * NSC * 128) + (size_t)chain * NSC * DK + dd;
        float loc[16], dec[16];
#pragma unroll
        for (int p = 0; p < 16; ++p) { const int sc = sc_of_pos(dir, p); loc[p] = bf2f(ST[(size_t)sc * E]); dec[p] = DEC[sc * DK]; }
        float S = 0.f;
#pragma unroll
        for (int p = 0; p < 16; ++p) { const int sc = sc_of_pos(dir, p); ST[(size_t)sc * E] = (bf16_t)f2bf(S); S = dec[p] * S + loc[p]; }
        ST[(size_t)sc_of_pos(dir, 16) * E] = (bf16_t)f2bf(S);
    }
}
__device__ __forceinline__ void s5_carry(Frame& F, int l) {
    const float* SL = (const float*)(F.ws + WS_SLOC); bf16_t* UG = (bf16_t*)(F.ws + WS_UG); const float* PW = (const float*)(F.ws + WS_S5PW);
    LAS float* EX = (LAS float*)F.lds;
    const int n = F.lane, j = F.wave;
    for (int it = F.c; it < NB * 32 * 2; it += F.G) {
        const int dir = it & 1, g = (it >> 1) & 31, b = it >> 6, ldg = (l * 2 + dir) * 32 + g;
        const cplx a = {PW[((size_t)ldg * 33 + 32) * 128 + n * 2], PW[((size_t)ldg * 33 + 32) * 128 + n * 2 + 1]};
        float lre[17], lim[17]; size_t rbs[17];
#pragma unroll
        for (int i = 0; i < 17; ++i) { const int p = 17 * j + i; int ck;
            if (p < 8) ck = 8 * b + (dir == 0 ? p : 7 - p); else ck = 32 + 128 * b + (dir == 0 ? p - 8 : 135 - p);
            rbs[i] = (size_t)(g * S5ROWS + ck); lre[i] = SL[rbs[i] * 256 + 128 * dir + n]; lim[i] = SL[rbs[i] * 256 + 128 * dir + 64 + n]; }
        float pre_re[17], pre_im[17]; cplx s = {0.f, 0.f};
#pragma unroll
        for (int i = 0; i < 17; ++i) { pre_re[i] = s.re; pre_im[i] = s.im; const cplx t = cmul(a, s); s.re = t.re + lre[i]; s.im = t.im + lim[i]; }
        __syncthreads();
        EX[(j * 64 + n) * 2] = s.re; EX[(j * 64 + n) * 2 + 1] = s.im;
        __syncthreads();
        cplx a2 = cmul(a, a), a4 = cmul(a2, a2), a8 = cmul(a4, a4), a16 = cmul(a8, a8), a17 = cmul(a16, a);
        cplx cin = {0.f, 0.f};
        for (int jj = 0; jj < j; ++jj) { const cplx t = cmul(a17, cin); cin.re = t.re + EX[(jj * 64 + n) * 2]; cin.im = t.im + EX[(jj * 64 + n) * 2 + 1]; }
        cplx wv = {1.f, 0.f};
#pragma unroll
        for (int i = 0; i < 17; ++i) { const cplx t = cmul(wv, cin); const float sre = pre_re[i] + t.re, sim = pre_im[i] + t.im;
            UG[rbs[i] * S5K + 512 + 128 * dir + n] = (bf16_t)f2bf(sre); UG[rbs[i] * S5K + 512 + 128 * dir + 64 + n] = (bf16_t)f2bf(sim);
            wv = cmul(wv, a); }
    }
    __syncthreads();
}
namespace pg8 {
__device__ __forceinline__ int xcd_order(int L, int n) { const int q = n >> 3, r = n & 7, x = L & 7, off = L >> 3; return (x < r ? x * (q + 1) : r * (q + 1) + (x - r) * q) + off; }
struct S5LocSched { static constexpr bool GATHER = false; const char* UG; const char* VT; int G, c;
    __device__ __forceinline__ bool next(int i, GUnit& u) const { const int L = i * G + c; if (L >= 96) return false; const int g = L / 3, mt = L % 3;
        u.A = UG + ((size_t)(g * S5ROWS + mt * 256)) * (S5K * 2); u.B = VT + (size_t)g * 256 * 1024; u.i0 = g; u.i1 = mt; u.i2 = 0; u.i3 = 0; return true; } };
struct S5OutSched { static constexpr bool GATHER = false; const char* UG; const char* BC; int G, c;
    __device__ __forceinline__ bool next(int i, GUnit& u) const { const int L = i * G + c; if (L >= 192) return false; const int g = L / 6, rem = L % 6, mt = rem >> 1, pn = rem & 1;
        u.A = UG + ((size_t)(g * S5ROWS + mt * 256)) * (S5K * 2); u.B = BC + ((size_t)(g * 512 + pn * 256)) * (S5K * 2); u.i0 = g; u.i1 = mt; u.i2 = pn; u.i3 = 0; return true; } };
struct MergeSched { static constexpr bool GATHER = false; const char* Y; const char* WB; int nM, pm0, G, c, lim;
    __device__ __forceinline__ bool next(int i, GUnit& u) const { const int L0 = (i / 3) * G + c, k = i % 3; if (L0 >= lim) return false; const int Lt = xcd_order(L0, lim); const int pm = pm0 + (Lt >> 2), pn = Lt & 3;
        u.A = Y + (size_t)pm * 256 * 3072 + k * 1024; u.B = WB + ((size_t)(k * 1024 + pn * 256)) * 1024; u.i0 = pm; u.i1 = pn; u.i2 = k; u.i3 = 0; return true; } };
struct MergeTailSched { static constexpr bool GATHER = false; const char* Y; const char* WB; int nM, pm0, first, c;
    __device__ __forceinline__ bool next(int i, GUnit& u) const { if (i > 0) return false; const int Lt = first + c / 6, k = (c % 6) >> 1, hf = c & 1; if (Lt >= nM * 4) return false; const int pm = pm0 + (Lt >> 2), pn = Lt & 3;
        u.A = Y + (size_t)pm * 256 * 3072 + k * 1024 + hf * 512; u.B = WB + ((size_t)(k * 1024 + pn * 256)) * 1024 + hf * 512; u.i0 = pm; u.i1 = pn; u.i2 = c; u.i3 = k; return true; } };
struct GateEarlySched { static constexpr bool GATHER = false; const char* H; const char* W; int G, c;
    __device__ __forceinline__ bool next(int i, GUnit& u) const { if (c < 80 || G <= 80) return false; const int g = i * (G - 80) + c - 80; if (g >= 176) return false; const int pn = g < 128 ? 11 - (g >> 6) : 9, pm = 4 + (g < 128 ? (g & 63) : g - 128);
        u.A = H + (size_t)pm * 256 * 2048; u.B = W + (size_t)pn * 256 * 2048; u.i0 = pm; u.i1 = pn; u.i2 = 0; u.i3 = 0; return true; } };
struct GateCtxSched { static constexpr bool GATHER = false; const char* H; const char* W; int G, c;
    __device__ __forceinline__ bool next(int i, GUnit& u) const { const int w0 = G >= 144 ? 96 : 0; const int g = i * (G - w0) + c - w0; if (c < w0 || g >= 48) return false; const int pm = g / 12, pn = g % 12;
        u.A = H + (size_t)pm * 256 * 2048; u.B = W + (size_t)pn * 256 * 2048; u.i0 = pm; u.i1 = pn; u.i2 = 0; u.i3 = 0; return true; } };
struct GateEarly2Sched { static constexpr bool GATHER = false; const char* H; const char* W; int G, c;
    __device__ __forceinline__ bool next(int i, GUnit& u) const { const int w0 = G >= 176 ? 96 : 0; const int g = i * (G - w0) + c - w0; if (c < w0 || g >= 80) return false; const int pn = g < 16 ? 9 : 8, pm = g < 16 ? 52 + g : 4 + (g - 16);
        u.A = H + (size_t)pm * 256 * 2048; u.B = W + (size_t)pn * 256 * 2048; u.i0 = pm; u.i1 = pn; u.i2 = 0; u.i3 = 0; return true; } };
struct MoeUpSched { static constexpr bool GATHER = true; const char* H; const char* W; const int* perm; int ntiles, ts[NE + 1], G, c;
    __device__ __forceinline__ bool next(int i, GUnit& u) const { const int L = i * G + c; if (L >= ntiles * 28) return false; const int tile = L / 28, pn = L % 28; int e = 0;
#pragma unroll
        for (int k = 1; k < NE; ++k) e += (tile >= ts[k]) ? 1 : 0;
        u.A = H; u.B = W + ((size_t)(e * 7168 + pn * 256)) * 2048; u.i0 = tile; u.i1 = pn; u.i2 = e; u.i3 = 0; return true; }
    __device__ __forceinline__ const int* rowtab(const GUnit& u) const { int t0 = 0;
#pragma unroll
        for (int k = 1; k < NE; ++k) t0 = (u.i2 == k) ? ts[k] : t0;
        return perm + u.i2 * 16384 + (u.i0 - t0) * 256; } };
struct MoeDownSched { static constexpr bool GATHER = false; const char* HID; const char* W; int ntiles, ts[NE + 1], G, c, lim;
    __device__ __forceinline__ bool next(int i, GUnit& u) const { const int L0 = i * G + c; if (L0 >= lim) return false; const int L = xcd_order(L0, lim); const int tile = ntiles - 1 - (L >> 2), pn = L & 3; int e = 0;
#pragma unroll
        for (int k = 1; k < NE; ++k) e += (tile >= ts[k]) ? 1 : 0;
        u.A = HID + (size_t)tile * 256 * 7168; u.B = W + ((size_t)(e * 1024 + pn * 256)) * 7168; u.i0 = tile; u.i1 = pn; u.i2 = e; u.i3 = 0; return true; } };
struct MoeDownTailSched { static constexpr bool GATHER = false; const char* HID; const char* W; int ntiles, ts[NE + 1], first, c, S, kb;
    __device__ __forceinline__ bool next(int i, GUnit& u) const { if (i > 0) return false; const int L = first + c / S, ks = c % S; if (L >= ntiles * 4) return false; const int tile = ntiles - 1 - (L >> 2), pn = L & 3; int e = 0;
#pragma unroll
        for (int k = 1; k < NE; ++k) e += (tile >= ts[k]) ? 1 : 0;
        u.A = HID + (size_t)tile * 256 * 7168 + ks * kb; u.B = W + ((size_t)(e * 1024 + pn * 256)) * 7168 + ks * kb; u.i0 = tile; u.i1 = pn; u.i2 = c; u.i3 = ks; return true; } };
}

constexpr size_t WS_SLB_G = WS_BIG + 128 * MiB;
constexpr size_t WS_SLB_F = WS_BIG + 104 * MiB;
constexpr size_t WS_GSP = WS_BIG + 343 * MiB;
static_assert(WS_GSP + 32 * MiB <= WS_END, "ws");
constexpr size_t WS_SLB_M = WS_H;
__device__ __forceinline__ void combine_resid(Frame& F, const pg8::DenseSched& S, int first, int R, int SPL, const bf16_t* slab, const float* modacc, const float* adab) {
    bf16_t* XW = (bf16_t*)(F.ws + WS_XW);
    for (int t = F.c * NTHREADS + F.tid; t < R * 16384; t += F.G * NTHREADS) { const int r = t >> 14, e = t & 16383, row = e >> 6, c4 = (e & 63) * 4; int pm, pn; S.tile_of(first + r, pm, pn);
        f32x4 sum = (f32x4){0.f, 0.f, 0.f, 0.f};
        for (int ks = 0; ks < SPL; ++ks) sum += xw_ld4(slab + (size_t)(r * SPL + ks) * 65536 + row * 256 + c4);
        const int bidx = pm < 4 ? 4 : ((pm - 4) >> 4), gcol = pn * 256 + c4; const f32x4 g = *(const f32x4*)(modacc + bidx * 6144 + gcol) + *(const f32x4*)(adab + gcol);
        bf16_t* xp = XW + (size_t)(pm * 256 + row) * 1024 + gcol; xw_st4(xp, xw_ld4(xp) + g * sum); }
}
__device__ __forceinline__ void combine_merge(Frame& F, int nM, int pm0, int first, const bf16_t* slab) {
    const epi::gate_t* GT = (const epi::gate_t*)(F.ws + WS_P); bf16_t* MG = (bf16_t*)(F.ws + WS_H); const int R = nM * 4 - first;
    for (int t = F.c * NTHREADS + F.tid; t < R * 8192; t += F.G * NTHREADS) { const int r = t >> 13, e = t & 8191, row = e >> 5, c8 = (e & 31) * 8; const int Lt = first + r, pm = pm0 + (Lt >> 2), pn = Lt & 3;
        const size_t grow = (size_t)(pm * 256 + row); const int gcol = pn * 256 + c8; float v[8];
#pragma unroll
        for (int j = 0; j < 8; ++j) v[j] = 0.f;
#pragma unroll
        for (int k = 0; k < 3; ++k) { float gt[8]; epi::gate_unpack8(*(const u32x2*)(GT + (size_t)(pm * 12 + k * 4 + pn) * 65536 + row * 256 + c8), gt); const bf16_t* sp = slab + (size_t)(r * 6 + 2 * k) * 65536 + row * 256 + c8;
            float s0[8], s1[8]; epi::unpack8(*(const u32x4*)sp, s0); epi::unpack8(*(const u32x4*)(sp + 65536), s1);
            const f32x4 a = (f32x4){s0[0] + s1[0], s0[1] + s1[1], s0[2] + s1[2], s0[3] + s1[3]}, b = (f32x4){s0[4] + s1[4], s0[5] + s1[5], s0[6] + s1[6], s0[7] + s1[7]};
#pragma unroll
            for (int j = 0; j < 4; ++j) { v[j] += gt[j] * a[j]; v[4 + j] += gt[4 + j] * b[j]; } }
        *(u32x4*)(MG + grow * 1024 + gcol) = epi::pack8(v); }
}
__device__ __forceinline__ void combine_moe(Frame& F, int first, int R, const bf16_t* slab, const int S, const int ntiles) {
    bf16_t* SL = (bf16_t*)(F.ws + WS_SLAB);
    for (int t = F.c * NTHREADS + F.tid; t < R * 8192; t += F.G * NTHREADS) { const int r = t >> 13, e = t & 8191, row = e >> 5, c8 = (e & 31) * 8; const int L = first + r, tile = ntiles - 1 - (L >> 2), pn = L & 3; float v[8];
#pragma unroll
        for (int j = 0; j < 8; ++j) v[j] = 0.f;
        for (int ks = 0; ks < S; ++ks) { const bf16_t* sp = slab + (size_t)(r * S + ks) * 65536 + row * 256 + c8; float s8[8]; epi::unpack8(*(const u32x4*)sp, s8); const f32x4 a = (f32x4){s8[0], s8[1], s8[2], s8[3]}, b = (f32x4){s8[4], s8[5], s8[6], s8[7]};
#pragma unroll
            for (int j = 0; j < 4; ++j) { v[j] += a[j]; v[4 + j] += b[j]; } }
        *(u32x4*)(SL + (size_t)(tile * 256 + row) * 1024 + pn * 256 + c8) = epi::pack8(v); }
}

__device__ __forceinline__ int wq_pull(Frame& F, unsigned* head) {
    volatile LAS unsigned* slot = (volatile LAS unsigned*)(F.lds + LDS_MISC + 64);
    __syncthreads();
    if (F.tid == 0) slot[0] = __hip_atomic_fetch_add(head, 1u, __ATOMIC_RELAXED, __HIP_MEMORY_SCOPE_AGENT);
    __syncthreads();
    return (int)slot[0];
}
__device__ __forceinline__ bool launder(Frame& F) { unsigned char* w = F.ws; ArgsP a = F.ap; asm volatile("" : "+s"(w), "+s"(a)); F.ws = w; F.ap = a; F.ctl = (unsigned*)(w + WS_CTL); return true; }
constexpr int NPHASE = 26;
#define IN(k) (lo <= (k) && (k) < hi && launder(F))
#define SEAM(k) do { if ((k) + 1 < hi) xcd_barrier(bar); } while (0)
#if defined(PROBE_SPLIT)
#define DUP_BEGIN(k) { const int rep_ = 0; (void)rep_;
#define DUP_END }
#define WQ_SEL(k) (F.ap->qsel ? (F.ap->qsel & 15) : (k))
#elif defined(PROBE_DUP)
#define DUP_BEGIN(k) { const int nrep_ = (PROBE_DUP == (k)) ? 1 + PROBE_DUPN : 1; for (int rep_ = 0; rep_ < nrep_; ++rep_) { if (rep_) xcd_barrier(bar);
#define DUP_END } }
#define WQ_SEL(k) (rep_ ? 8 + rep_ : (k))
#else
#define DUP_BEGIN(k) { const int rep_ = 0; (void)rep_;
#define DUP_END }
#define WQ_SEL(k) (k)
#endif
template <int l>
__device__ __forceinline__ void layer_phases(Frame& F, const XcdBarrier& bar, const int lo, const int hi) {
    const int G = F.G, c = F.c; LAS unsigned char* lds = F.lds;
    constexpr int pb = 1 + 12 * l;

        const int pm0 = l == 0 ? 0 : 4, nM = l == 0 ? 68 : 64;
        const float* modacc = (const float*)(F.ctl + CW_MOD) + (size_t)l * 5 * 6144; const float* adab = F.ap->in[I_ADAB] + (size_t)l * 6144;
        if (IN(pb + 0)) { if (l == 0) { if (c & 1) phase_pre2(F); norm_rows<0>(F, 0, 0, F.ap->in[I_N1G]); if (!(c & 1)) phase_pre2(F); } else norm_rows<1>(F, 1, 0, F.ap->in[I_N1G] + D); SEAM(pb + 0); }
        if (IN(pb + 1)) {
            pg8::DenseSched S; S.init(F.ws + WS_H, F.ws + WS_WMIX + (size_t)l * NMIX * D * 2, 2048, 2048, 68, 20, 0, G, c);
            const float* lbp = (const float*)(F.ctl + CW_LB);
            epi::EpiWin E{(bf16_t*)(F.ws + WS_P), (bf16_t*)(F.ws + WS_UG), lbp + 512 * l, lbp + 1024 + 512 * l, F.ap->in[I_GB] + l * 512, l == 0};
#ifdef PROBE_SPLIT
            E.pmode = F.ap->qsel >> 4;
#endif
            pg8::gemm_phase(lds, S, E, 2048, 2048, 16);
            if (l == 0) { bg_drain<1>(F); bg_s5fill<0>(F); }
            else { pg8::GateEarlySched T{(const char*)(F.ws + WS_H), (const char*)(F.ws + WS_WGATE + (size_t)NGATE * D * 2), G, c}; epi::EpiGate EG{{(epi::gate_t*)(F.ws + WS_P), (epi::gate_t*)(F.ws + WS_GSP), 1}};
                pg8::gemm_phase(lds, T, EG, 2048, 2048, 16); }
            SEAM(pb + 1); }
        if (IN(pb + 2)) {
            DUP_BEGIN(pb + 2)
            { pg8::S5LocSched S{(const char*)(F.ws + WS_UG), (const char*)(F.ws + WS_S5V), G, c}; epi::EpiS5Loc E{(float*)(F.ws + WS_SLOC)}; pg8::gemm_phase(lds, S, E, S5K * 2, 1024, 8); }
            if (l == 0) { pg8::GateCtxSched T{(const char*)(F.ws + WS_H), (const char*)(F.ws + WS_WGATE), G, c}; epi::EpiGate EG{{(epi::gate_t*)(F.ws + WS_P), (epi::gate_t*)(F.ws + WS_GSP), 0}}; pg8::gemm_phase(lds, T, EG, 2048, 2048, 16); }
            else { pg8::GateEarly2Sched T{(const char*)(F.ws + WS_H), (const char*)(F.ws + WS_WGATE + (size_t)NGATE * D * 2), G, c}; epi::EpiGate EG{{(epi::gate_t*)(F.ws + WS_P), (epi::gate_t*)(F.ws + WS_GSP), 1}}; pg8::gemm_phase(lds, T, EG, 2048, 2048, 16); }
            __syncthreads();
            for (;;) { const int it = wq_pull(F, F.ctl + CW_WQ + 64 * WQ_SEL(2 * l)); if (it >= 1024) break;
                const int br = it >> 9, r = it & 511, p = r & 15, dir = (r >> 4) & 1, h = (r >> 5) & 3, b = r >> 7;
                if (br == 0) gla_pass1_item<128, true>(F, b, h, dir, p); else gla_pass1_item<64, false>(F, b, h, dir, p); }
            DUP_END
            SEAM(pb + 2); }
        if (IN(pb + 3)) { if (c & 1) s5_carry(F, l); gla_carry(F); if (!(c & 1)) s5_carry(F, l); SEAM(pb + 3); }
        if (IN(pb + 4)) {
            DUP_BEGIN(pb + 4)
            { pg8::S5OutSched S{(const char*)(F.ws + WS_UG), (const char*)(F.ws + WS_S5C), G, (c + G - 64) % G}; epi::EpiS5Out E{(bf16_t*)(F.ws + WS_YPRE)}; pg8::gemm_phase(lds, S, E, S5K * 2, S5K * 2, 12); }
            __syncthreads();
            const int nsc = l == 0 ? 17 : 16, nit = 16 * nsc;
            for (;;) { const int q = wq_pull(F, F.ctl + CW_WQ + 64 * WQ_SEL(2 * l + 1)); if (q >= 2 * nit) break;
                const int br = q >= nit, it = br ? q - nit : q, sc = (it % nsc) + (l == 0 ? 0 : 1), h = (it / nsc) & 3, b = it / (nsc * 4);
                if (br == 0) gla_pass3_item<128, true>(F, l, b, h, sc); else gla_pass3_item<64, false>(F, l, b, h, sc); }
            DUP_END
            SEAM(pb + 4); }
        if (IN(pb + 5)) {
            if (l == 0) { pg8::DenseSched S; S.init(F.ws + WS_H, F.ws + WS_WGATE, 2048, 2048, 64, 12, 4, G, c); epi::EpiGate E{{(epi::gate_t*)(F.ws + WS_P), (epi::gate_t*)(F.ws + WS_GSP), 0}}; pg8::gemm_phase(lds, S, E, 2048, 2048, 16); }
            else { pg8::DenseSched S; S.init(F.ws + WS_H, F.ws + WS_WGATE + (size_t)NGATE * D * 2, 2048, 2048, 64, 8, 4, G, c); epi::EpiGate E{{(epi::gate_t*)(F.ws + WS_P), (epi::gate_t*)(F.ws + WS_GSP), 1}}; pg8::gemm_phase(lds, S, E, 2048, 2048, 16); }
            { pg8::DenseSched S; S.init(F.ws + WS_YPRE, F.ws + WS_WGLU + (size_t)l * 512 * 512 * 2, 1024, 1024, nM, 2, pm0, G, (c + G - (l == 0 ? 768 : 512) % G) % G); epi::EpiGlu E{(const bf16_t*)(F.ws + WS_YPRE), (bf16_t*)(F.ws + WS_Y)}; pg8::gemm_phase(lds, S, E, 1024, 1024, 8); }
            if (l == 0) bg_drain<2>(F);
            else bg_drain<4>(F);
            SEAM(pb + 5); }
        if (IN(pb + 6)) {
            const int nT = nM * 4, fullT = (nT / G) * G; const bool split = (hi - lo > 1) && nT > fullT && (nT - fullT) * 6 <= G;
            pg8::MergeSched S{(const char*)(F.ws + WS_Y), (const char*)(F.ws + WS_WBR + (size_t)l * 3 * D * 512 * 2), nM, pm0, G, c, split ? fullT : nT}; epi::EpiMerge E{{(epi::gate_t*)(F.ws + WS_P), (epi::gate_t*)(F.ws + WS_GSP), l}, (bf16_t*)(F.ws + WS_H)};
#ifdef PROBE_MERGE
            E.pmode = (hi - lo == 1) ? PROBE_MERGE : 0;
#endif
            pg8::gemm_phase(lds, S, E, 3072, 1024, 8);
            if (l == 0 && !split) bg_wgtasks<0>(F);
            if (split) { pg8::MergeTailSched T{(const char*)(F.ws + WS_Y), (const char*)(F.ws + WS_WBR + (size_t)l * 3 * D * 512 * 2), nM, pm0, fullT, c}; epi::EpiSlab ES{(bf16_t*)(F.ws + WS_SLB_F)};
                pg8::gemm_phase(lds, T, ES, 3072, 1024, 4); if (l == 0) bg_wgtasks<0>(F);
                xcd_barrier(bar); combine_merge(F, nM, pm0, fullT, (const bf16_t*)(F.ws + WS_SLB_F)); }
            SEAM(pb + 6); }
        if (IN(pb + 7)) {
            pg8::DenseSched S; S.init(F.ws + WS_H, F.ws + WS_WOUT + (size_t)l * D * D * 2, 2048, 2048, nM, 4, pm0, G, c); epi::EpiResid E{(bf16_t*)(F.ws + WS_XW), modacc + 2048, adab + 2048};
            const int full = (S.nwg / G) * G; const bool split = (hi - lo > 1) && S.nwg > full && (S.nwg - full) * 4 <= G;
            if (split) S.lim = full;
            pg8::gemm_phase(lds, S, E, 2048, 2048, 16);
            if (split) { pg8::SplitSched T{S, full, 4, 512, c}; epi::EpiSlab ES{(bf16_t*)(F.ws + WS_SLB_G)}; pg8::gemm_phase(lds, T, ES, 2048, 2048, 4); xcd_barrier(bar);
                combine_resid(F, S, full, S.nwg - full, 4, (const bf16_t*)(F.ws + WS_SLB_G), modacc + 2048, adab + 2048); }
            SEAM(pb + 7); }
        if (IN(pb + 8)) { if (l == 0) norm_rows<1>(F, 0, 3072, F.ap->in[I_N2G]); else {
            if (c & 1) moe_convert(F);
            norm_rows<2>(F, 1, 3072, F.ap->in[I_N2G] + D);
            if (!(c & 1)) moe_convert(F);
            } SEAM(pb + 8); }
        if (IN(pb + 10)) {
            if (l == 0) { pg8::DenseSched S; S.init(F.ws + WS_H, F.ws + WS_W13, 2048, 2048, 68, 28, 0, G, c); epi::EpiSwiglu E{(bf16_t*)(F.ws + WS_HID)}; pg8::gemm_phase(lds, S, E, 2048, 2048, 16); bg_wgtasks<1>(F); bg_s5fill<1>(F); }
            else { MoeSeg sg; moe_seg(F, sg); pg8::MoeUpSched S; S.H = (const char*)(F.ws + WS_H) + (size_t)MCTX * 2048; S.W = (const char*)(F.ws + WS_MW13); S.perm = (const int*)(F.ctl + CW_PERM2); S.ntiles = sg.tstart[NE]; S.G = G; S.c = c;
#pragma unroll
                for (int e = 0; e <= NE; ++e) S.ts[e] = sg.tstart[e];
                epi::EpiSwiglu E{(bf16_t*)(F.ws + WS_MHID)}; pg8::gemm_phase(lds, S, E, 2048, 2048, 16);
                bg_drain<3>(F); }
            SEAM(pb + 10); }
        if (IN(pb + 11)) {
            if (l == 0) { pg8::DenseSched S; S.init(F.ws + WS_HID, F.ws + WS_W2, 7168, 7168, 68, 4, 0, G, c); epi::EpiResid E{(bf16_t*)(F.ws + WS_XW), modacc + 5120, adab + 5120};
                const int full = (S.nwg / G) * G; const bool split = (hi - lo > 1) && S.nwg > full && (S.nwg - full) * 14 <= G;
                if (split) S.lim = full;
                pg8::gemm_phase(lds, S, E, 7168, 7168, 56);
                if (split) { pg8::SplitSched T{S, full, 14, 512, c}; epi::EpiSlab ES{(bf16_t*)(F.ws + WS_SLB_G)}; pg8::gemm_phase(lds, T, ES, 7168, 7168, 4); xcd_barrier(bar);
                    combine_resid(F, S, full, S.nwg - full, 14, (const bf16_t*)(F.ws + WS_SLB_G), modacc + 5120, adab + 5120); } }
            else { MoeSeg sg; moe_seg(F, sg); pg8::MoeDownSched S; S.HID = (const char*)(F.ws + WS_MHID); S.W = (const char*)(F.ws + WS_MW2); S.ntiles = sg.tstart[NE]; S.G = G; S.c = c;
#pragma unroll
                for (int e = 0; e <= NE; ++e) S.ts[e] = sg.tstart[e];
                const int nU = sg.tstart[NE] * 4, full = (nU / G) * G; const bool split = (hi - lo > 1) && nU > full && (nU - full) * 4 <= G;
                const int nsl = (nU - full) * 7 <= G && (nU - full) <= 24 ? 7 : 4; const bf16_t* slb = (const bf16_t*)(F.ws + (nsl == 7 ? WS_BIG + 68 * MiB : WS_SLB_M));
                S.lim = split ? full : nU;
                epi::EpiStoreBf16 E{(bf16_t*)(F.ws + WS_SLAB), 1024}; pg8::gemm_phase(lds, S, E, 7168, 7168, 56);
                if (split) { pg8::MoeDownTailSched T; T.HID = S.HID; T.W = S.W; T.ntiles = S.ntiles; T.first = full; T.c = c; T.S = nsl; T.kb = 7168 / nsl;
#pragma unroll
                    for (int e = 0; e <= NE; ++e) T.ts[e] = sg.tstart[e];
                    epi::EpiSlab ES{(bf16_t*)slb}; pg8::gemm_phase(lds, T, ES, 7168, 7168, 56 / nsl); xcd_barrier(bar); combine_moe(F, full, nU - full, slb, nsl, S.ntiles); } }
            SEAM(pb + 11); }
    }

__global__ void __launch_bounds__(NTHREADS, 2) fwd_kernel(Args args) {
    extern __shared__ __attribute__((aligned(16))) unsigned char lds_raw[];
    Frame F;
    F.lds = (LAS unsigned char*)lds_raw; F.ws = args.ws; F.ctl = (unsigned*)(args.ws + WS_CTL);
    F.tid = threadIdx.x; F.lane = F.tid & 63; F.wave = __builtin_amdgcn_readfirstlane(F.tid >> 6); F.G = gridDim.x; F.c = blockIdx.x;
    F.ap = (ArgsP)__builtin_amdgcn_kernarg_segment_ptr();
    volatile LAS unsigned* MISC = (volatile LAS unsigned*)(F.lds + LDS_MISC);
    for (int u = F.tid; u < (LDS_BYTES - LDS_MISC) / 4; u += NTHREADS) MISC[u] = 0u;
    __syncthreads();
    XcdBarrier bar; bar.bar = F.ctl + CW_BAR; bar.x = 0; bar.st = nullptr;
    const int lo = args.ph_lo, hi = args.ph_hi;
    if (hi - lo > 1) bar = xcd_barrier_post(F.ctl + CW_BAR, MISC + 8);

    if (IN(0)) { phase_pre(F); SEAM(0); }

    layer_phases<0>(F, bar, lo, hi);
    layer_phases<1>(F, bar, lo, hi);
    if (IN(25)) phase_final(F);
#ifdef PROBE_GEMM
    if (IN(40)) { pg8::DenseSched S; S.init(F.ws + PROBE_A, F.ws + PROBE_B, PROBE_LD, PROBE_LD, 68, 28, 0, F.G, F.c); S.lim = PROBE_LIM; PROBE_EPI; pg8::gemm_phase(F.lds, S, E, PROBE_LD, PROBE_LD, PROBE_NT); }
#endif
#ifdef PROBE_VARIANTS
#define PV_ITEMS(V) do { for (int it = F.c; it < 272; it += F.G) { const int sc = it % 17, h = (it / 17) & 3, b = it / 68; gla_pass3_item<128, true, V>(F, 0, b, h, sc); } \
        if (F.c >= 16) for (int it = F.c - 16; it < 272; it += 240) { const int sc = it % 17, h = (it / 17) & 3, b = it / 68; gla_pass3_item<64, false, V>(F, 0, b, h, sc); } } while (0)
    if (IN(30)) PV_ITEMS(0);
    if (IN(31)) PV_ITEMS(1);
    if (IN(32)) PV_ITEMS(2);
    if (IN(33)) PV_ITEMS(3);
    if (IN(34)) PV_ITEMS(4);
    if (IN(35)) PV_ITEMS(5);
#endif

#undef IN
#undef SEAM
}

extern "C" void kernel_launch(void* const* d_in, const int* in_sizes, int n_in, void* d_out, int out_size, void* d_ws, size_t ws_size, hipStream_t stream) {
    static int grid = 0;
    if (grid == 0) {
        if (n_in != 33 || ws_size < WS_END) { fprintf(stderr, "kernel_launch: need 33 inputs and %zu bytes of workspace (got %d, %zu)\n", (size_t)WS_END, n_in, ws_size); grid = -1; return; }
        int dev = 0, cus = 0, per_cu = 0;
        if (hipGetDevice(&dev) != hipSuccess || hipDeviceGetAttribute(&cus, hipDeviceAttributeMultiprocessorCount, dev) != hipSuccess) { grid = -1; return; }
        if (hipFuncSetAttribute((const void*)fwd_kernel, hipFuncAttributeMaxDynamicSharedMemorySize, LDS_BYTES) != hipSuccess) { fprintf(stderr, "kernel_launch: hipFuncSetAttribute failed\n"); grid = -1; return; }
        if (hipOccupancyMaxActiveBlocksPerMultiprocessor(&per_cu, (const void*)fwd_kernel, NTHREADS, LDS_BYTES) != hipSuccess || per_cu < 1) fprintf(stderr, "kernel_launch: occupancy query says %d\n", per_cu);
        (void)hipGetLastError();
        grid = cus;
    }
    if (grid < 0) return;
    (void)hipMemsetAsync((char*)d_ws + WS_CTL, 0, CTL_BYTES, stream);
    Args a{};
    for (int i = 0; i < 33; ++i) a.in[i] = (const float*)d_in[i];
    a.out = (float*)d_out; a.ws = (unsigned char*)d_ws;
#if MK_N_LAUNCHES == 1
#ifdef PROBE_SPLIT
    a.ph_lo = 0; a.ph_hi = PROBE_SPLIT + 1;
    hipLaunchKernelGGL(fwd_kernel, dim3(grid), dim3(NTHREADS), LDS_BYTES, stream, a);
    for (int k = 0; k < PROBE_DUPN; ++k) { a.ph_lo = PROBE_SPLIT; a.ph_hi = PROBE_SPLIT + 1; a.qsel = 11 + k + 16 * (k + 1 < PROBE_DUPN ? PROBE_MODE : 0); hipLaunchKernelGGL(fwd_kernel, dim3(grid), dim3(NTHREADS), LDS_BYTES, stream, a); }
    (void)hipMemsetAsync((char*)d_ws + WS_CTL + (size_t)CW_BAR * 4, 0, 4096 * 4, stream);
    a.qsel = 0; a.ph_lo = PROBE_SPLIT + 1; a.ph_hi = NPHASE;
    hipLaunchKernelGGL(fwd_kernel, dim3(grid), dim3(NTHREADS), LDS_BYTES, stream, a);
#else
    a.ph_lo = 0; a.ph_hi = NPHASE;
    hipLaunchKernelGGL(fwd_kernel, dim3(grid), dim3(NTHREADS), LDS_BYTES, stream, a);
#endif
#ifdef PROBE_PHASES
    { const int pl[] = {PROBE_PHASES}; for (int k : pl) { a.ph_lo = k; a.ph_hi = k + 1; hipLaunchKernelGGL(fwd_kernel, dim3(grid), dim3(NTHREADS), LDS_BYTES, stream, a); } }
#endif
#else
    for (int k = 0; k < NPHASE; ++k) { if (k == 10) continue; a.ph_lo = k; a.ph_hi = k + 1; hipLaunchKernelGGL(fwd_kernel, dim3(grid), dim3(NTHREADS), LDS_BYTES, stream, a); }
#endif
}
```
